# Optimizing an MI355X kernel written in HIP

```python
import jax, jax.numpy as jnp
from jax import lax
import numpy as np

D_MODEL = 4096
BATCH = 4
SEQ = 2048
DEPTH = 4
DEC_BATCH = 8
DEC_SEQ = 1
PAST_LEN = 8192
PAGE_SIZE = 128

N_A_LAYERS = DEPTH // 2
N_B_LAYERS = DEPTH - N_A_LAYERS
D_RNN = D_MODEL
LRU_HEADS = 16
LRU_BLOCK = D_RNN // LRU_HEADS
CONV_W = 4
LRU_C = 8.0
HEAD_DIM = 128
N_SLOTS = 16
KV_HEADS = 4
GQA = N_SLOTS // KV_HEADS
WINDOWS = (128, 512, 2048)
DILATIONS = (1, 4, 16)
N_GROUPS = 3
BAND = 128
ATTN_W = N_SLOTS * HEAD_DIM
Q_W = N_GROUPS * ATTN_W
KV_W = N_GROUPS * 2 * KV_HEADS * HEAD_DIM
N_BUCKETS = 32
MAX_EXACT = 16
MAX_DIST = 2048
EPS = 1e-6

kernel_name = "yoco_rglru_dilated_swa_decoder_step"


def rmsnorm(x, g):
    xf = x.astype(jnp.float32)
    y = xf * lax.rsqrt(jnp.mean(xf * xf, axis=-1, keepdims=True) + EPS)
    return (y * g.astype(jnp.float32)).astype(x.dtype)


def rel_bucket(dist):
    dist = np.asarray(dist)
    d = np.maximum(dist, 1).astype(np.float32)
    large = MAX_EXACT + (np.log(d / MAX_EXACT) / np.log(MAX_DIST / MAX_EXACT)
                         * (N_BUCKETS - MAX_EXACT)).astype(np.int32)
    large = np.minimum(large, N_BUCKETS - 1)
    return np.where(dist < MAX_EXACT, dist, large).astype(np.int32)


def _lru_combine(left, right):
    a1, b1 = left
    a2, b2 = right
    return a1 * a2, a2 * b1 + b2


def rglru_mixer(u, conv_buf, h0, w_in, conv_w, conv_b, w_ga, b_ga, w_gx, b_gx, lam, w_out):
    n, t, _ = u.shape
    f32 = jnp.float32
    proj = u @ w_in
    xb, gate = proj[..., :D_RNN], proj[..., D_RNN:]
    xc = jnp.concatenate([conv_buf.astype(xb.dtype), xb], axis=1)
    xconv = conv_b
    for k in range(CONV_W):
        xconv = xconv + xc[:, k:k + t] * conv_w[k]
    new_conv = xc[:, xc.shape[1] - (CONV_W - 1):]
    xf = xconv.astype(f32)
    xh = xf.reshape(n, t, LRU_HEADS, LRU_BLOCK)
    r = jax.nn.sigmoid(jnp.einsum('nthi,hij->nthj', xh, w_ga.astype(f32)) + b_ga.astype(f32)).reshape(n, t, D_RNN)
    i = jax.nn.sigmoid(jnp.einsum('nthi,hij->nthj', xh, w_gx.astype(f32)) + b_gx.astype(f32)).reshape(n, t, D_RNN)
    log_a = -LRU_C * jax.nn.softplus(-lam.astype(f32)) * r
    a = jnp.exp(log_a)
    b = jnp.sqrt(-jnp.expm1(2.0 * log_a)) * (i * xf)
    b = b.at[:, 0].add(a[:, 0] * h0.astype(f32))
    _, h = lax.associative_scan(_lru_combine, (a, b), axis=1)
    y = (h.astype(u.dtype) * jax.nn.silu(gate)) @ w_out
    return y, new_conv, h[:, -1]


def dilated_prompt(q, k, v, r, table_g):
    n, t = q.shape[:2]
    f32 = jnp.float32
    win = r * BAND
    t_pad = -(-t // win) * win
    j = t_pad // r
    nb = j // BAND

    def to_band(a):
        h = a.shape[2]
        a = jnp.pad(a, ((0, 0), (0, t_pad - t), (0, 0), (0, 0))).reshape(n, j, r, h, HEAD_DIM)
        return a.transpose(0, 2, 1, 3, 4).reshape(n, r, nb, BAND, h, HEAD_DIM)

    def with_prev(a):
        prev = jnp.pad(a, ((0, 0), (0, 0), (1, 0), (0, 0), (0, 0), (0, 0)))[:, :, :-1]
        return jnp.concatenate([prev, a], axis=3)

    qb = to_band(q.astype(f32)).reshape(n, r, nb, BAND, KV_HEADS, GQA, HEAD_DIM)
    kb = with_prev(to_band(k.astype(f32)))
    vb = with_prev(to_band(v.astype(f32)))
    s = jnp.einsum('bcnqkgd,bcnpkd->bcnkgqp', qb, kb) * (HEAD_DIM ** -0.5)
    qq = np.arange(BAND)[:, None]
    kk = np.arange(2 * BAND)[None, :]
    diff = BAND + qq - kk
    in_band = (diff >= 0) & (diff <= BAND)
    bucket = rel_bucket(np.clip(diff, 0, BAND) * r)
    bias = table_g[bucket].transpose(2, 0, 1).reshape(KV_HEADS, GQA, BAND, 2 * BAND)
    mask = in_band[None] & ((np.arange(nb)[:, None, None] > 0) | (kk[None] >= BAND))
    s = jnp.where(mask[:, None, None], s + bias, -jnp.inf)
    m = jnp.max(s, axis=-1)
    p = jnp.exp(s - m[..., None])
    den = jnp.sum(p, axis=-1)
    o = jnp.einsum('bcnkgqp,bcnpkd->bcnqkgd', p, vb)
    o = o.reshape(n, r, j, N_SLOTS, HEAD_DIM).transpose(0, 2, 1, 3, 4).reshape(n, t_pad, N_SLOTS, HEAD_DIM)[:, :t]

    def stat(a):
        a = a.transpose(0, 1, 2, 5, 3, 4).reshape(n, r, j, N_SLOTS)
        return a.transpose(0, 2, 1, 3).reshape(n, t_pad, N_SLOTS)[:, :t]

    return o, stat(m), stat(den)


def dilated_sample(q, k_ext, v_ext, r, table_g):
    n, s_len = q.shape[:2]
    f32 = jnp.float32
    lb = k_ext.shape[1] - s_len
    steps = np.arange(BAND + 1)
    idx = lb + np.arange(s_len)[:, None] - steps[None, :] * r
    valid = idx >= 0
    idx = np.maximum(idx, 0)
    kg = k_ext[:, idx].astype(f32)
    vg = v_ext[:, idx].astype(f32)
    qh = q.astype(f32).reshape(n, s_len, KV_HEADS, GQA, HEAD_DIM)
    s = jnp.einsum('nskgd,nspkd->nkgsp', qh, kg) * (HEAD_DIM ** -0.5)
    bias = table_g[rel_bucket(steps * r)].T.reshape(KV_HEADS, GQA, 1, BAND + 1)
    s = jnp.where(valid[None, None, None], s + bias, -jnp.inf)
    m = jnp.max(s, axis=-1)
    p = jnp.exp(s - m[..., None])
    den = jnp.sum(p, axis=-1)
    o = jnp.einsum('nkgsp,nspkd->nskgd', p, vg).reshape(n, s_len, N_SLOTS, HEAD_DIM)
    m = m.transpose(0, 3, 1, 2).reshape(n, s_len, N_SLOTS)
    den = den.transpose(0, 3, 1, 2).reshape(n, s_len, N_SLOTS)
    return o, m, den


def combine_groups(parts):
    ms = jnp.stack([p[1] for p in parts])
    mx = jnp.max(ms, axis=0)
    e = jnp.exp(ms - mx[None])
    num = sum(e[g][..., None] * parts[g][0] for g in range(len(parts)))
    den = sum(e[g] * parts[g][2] for g in range(len(parts)))
    return num / den[..., None]


def trunk(x, conv_state, h_state, kv_bufs, a_pre_g, a_w_in, a_conv_w, a_conv_b, a_w_gate_a, a_b_gate_a,
          a_w_gate_x, a_b_gate_x, a_lambda, a_w_out, a_post_g, kv_norm_g, w_kv, rel_bias,
          b_pre_g, b_w_in, b_w_out, b_post_g):
    n, t, _ = x.shape
    new_conv, new_h, new_kv, kv_groups = [], [], [], []
    for layer in range(DEPTH):
        if layer < N_A_LAYERS:
            l = layer
            y, c, h = rglru_mixer(rmsnorm(x, a_pre_g[l]), conv_state[l], h_state[l], a_w_in[l], a_conv_w[l],
                                  a_conv_b[l], a_w_gate_a[l], a_b_gate_a[l], a_w_gate_x[l], a_b_gate_x[l],
                                  a_lambda[l], a_w_out[l])
            x = x + rmsnorm(y, a_post_g[l])
            new_conv.append(c)
            new_h.append(h)
            continue
        if layer == N_A_LAYERS:
            kv = (rmsnorm(x, kv_norm_g) @ w_kv).reshape(n, t, N_GROUPS, 2, KV_HEADS, HEAD_DIM)
            for g in range(N_GROUPS):
                kvg = kv[:, :, g]
                if kv_bufs is None:
                    keep = min(WINDOWS[g], t)
                    new_kv.append(kvg[:, t - keep:])
                    kv_groups.append(kvg)
                else:
                    lb = kv_bufs[g].shape[1]
                    ext = jnp.concatenate([kv_bufs[g].astype(kvg.dtype), kvg], axis=1)
                    new_kv.append(ext[:, ext.shape[1] - lb:])
                    kv_groups.append(ext)
        l = layer - N_A_LAYERS
        proj = rmsnorm(x, b_pre_g[l]) @ b_w_in[l]
        q = proj[..., :Q_W].reshape(n, t, N_GROUPS, N_SLOTS, HEAD_DIM)
        gate = proj[..., Q_W:]
        parts = []
        for g in range(N_GROUPS):
            table_g = rel_bias[:, g * N_SLOTS:(g + 1) * N_SLOTS].astype(jnp.float32)
            kvg = kv_groups[g]
            if kv_bufs is None:
                parts.append(dilated_prompt(q[:, :, g], kvg[:, :, 0], kvg[:, :, 1], DILATIONS[g], table_g))
            else:
                parts.append(dilated_sample(q[:, :, g], kvg[:, :, 0], kvg[:, :, 1], DILATIONS[g], table_g))
        o = combine_groups(parts)
        y = (o.reshape(n, t, ATTN_W).astype(x.dtype) * jax.nn.silu(gate)) @ b_w_out[l]
        x = x + rmsnorm(y, b_post_g[l])
    return x, jnp.stack(new_conv), jnp.stack(new_h), new_kv[0], new_kv[1], new_kv[2]


def setup_inputs(seed: int = 0) -> dict:
    key = jax.random.key(seed)
    ks = jax.random.split(key, 32)
    f32 = jnp.float32
    nrm = lambda k, shape, s=1.0: (jax.random.normal(k, shape, f32) * s)
    lb = [min(w, PAST_LEN) for w in WINDOWS]
    lam_u = jax.random.uniform(ks[10], (N_A_LAYERS, D_RNN), f32, minval=0.9, maxval=0.999)
    sig = lam_u ** (1.0 / LRU_C)
    return {
        "x_prompt": nrm(ks[0], (BATCH, SEQ, D_MODEL)),
        "x_sample": nrm(ks[1], (DEC_BATCH, DEC_SEQ, D_MODEL)),
        "state_conv": nrm(ks[2], (N_A_LAYERS, DEC_BATCH, CONV_W - 1, D_RNN)),
        "state_h": nrm(ks[3], (N_A_LAYERS, DEC_BATCH, D_RNN), 0.5),
        "state_kv_w128": nrm(ks[4], (DEC_BATCH, lb[0], 2, KV_HEADS, HEAD_DIM)),
        "state_kv_w512": nrm(ks[5], (DEC_BATCH, lb[1], 2, KV_HEADS, HEAD_DIM)),
        "state_kv_w2048": nrm(ks[6], (DEC_BATCH, lb[2], 2, KV_HEADS, HEAD_DIM)),
        "a_pre_g": 1.0 + nrm(ks[7], (N_A_LAYERS, D_MODEL), 0.01),
        "a_w_in": nrm(ks[8], (N_A_LAYERS, D_MODEL, 2 * D_RNN), D_MODEL ** -0.5),
        "a_conv_w": nrm(ks[9], (N_A_LAYERS, CONV_W, D_RNN), CONV_W ** -0.5),
        "a_conv_b": nrm(ks[11], (N_A_LAYERS, D_RNN), 0.01),
        "a_w_gate_a": nrm(ks[12], (N_A_LAYERS, LRU_HEADS, LRU_BLOCK, LRU_BLOCK), LRU_BLOCK ** -0.5),
        "a_b_gate_a": nrm(ks[13], (N_A_LAYERS, LRU_HEADS, LRU_BLOCK), 0.01),
        "a_w_gate_x": nrm(ks[14], (N_A_LAYERS, LRU_HEADS, LRU_BLOCK, LRU_BLOCK), LRU_BLOCK ** -0.5),
        "a_b_gate_x": nrm(ks[15], (N_A_LAYERS, LRU_HEADS, LRU_BLOCK), 0.01),
        "a_lambda": jnp.log(sig) - jnp.log1p(-sig),
        "a_w_out": nrm(ks[16], (N_A_LAYERS, D_RNN, D_MODEL), D_RNN ** -0.5),
        "a_post_g": 1.0 + nrm(ks[17], (N_A_LAYERS, D_MODEL), 0.01),
        "kv_norm_g": 1.0 + nrm(ks[18], (D_MODEL,), 0.01),
        "w_kv": nrm(ks[19], (D_MODEL, KV_W), D_MODEL ** -0.5),
        "rel_bias": nrm(ks[20], (N_BUCKETS, N_GROUPS * N_SLOTS), 0.2),
        "b_pre_g": 1.0 + nrm(ks[21], (N_B_LAYERS, D_MODEL), 0.01),
        "b_w_in": nrm(ks[22], (N_B_LAYERS, D_MODEL, Q_W + ATTN_W), D_MODEL ** -0.5),
        "b_w_out": nrm(ks[23], (N_B_LAYERS, ATTN_W, D_MODEL), ATTN_W ** -0.5),
        "b_post_g": 1.0 + nrm(ks[24], (N_B_LAYERS, D_MODEL), 0.01),
    }


def reference(x_prompt, x_sample, state_conv, state_h, state_kv_w128, state_kv_w512, state_kv_w2048,
              a_pre_g, a_w_in, a_conv_w, a_conv_b, a_w_gate_a, a_b_gate_a, a_w_gate_x, a_b_gate_x,
              a_lambda, a_w_out, a_post_g, kv_norm_g, w_kv, rel_bias, b_pre_g, b_w_in, b_w_out, b_post_g):
    nb_p = x_prompt.shape[0]
    conv0 = jnp.zeros((N_A_LAYERS, nb_p, CONV_W - 1, D_RNN), x_prompt.dtype)
    h0 = jnp.zeros((N_A_LAYERS, nb_p, D_RNN), jnp.float32)
    y_prompt, p_conv, p_h, p_kv128, p_kv512, p_kv2048 = trunk(
        x_prompt, conv0, h0, None, a_pre_g, a_w_in, a_conv_w, a_conv_b, a_w_gate_a, a_b_gate_a,
        a_w_gate_x, a_b_gate_x, a_lambda, a_w_out, a_post_g, kv_norm_g, w_kv, rel_bias,
        b_pre_g, b_w_in, b_w_out, b_post_g)
    y_sample, s_conv, s_h, s_kv128, s_kv512, s_kv2048 = trunk(
        x_sample, state_conv, state_h, (state_kv_w128, state_kv_w512, state_kv_w2048), a_pre_g, a_w_in,
        a_conv_w, a_conv_b, a_w_gate_a, a_b_gate_a, a_w_gate_x, a_b_gate_x, a_lambda, a_w_out, a_post_g,
        kv_norm_g, w_kv, rel_bias, b_pre_g, b_w_in, b_w_out, b_post_g)
    return (y_prompt, y_sample, p_conv, p_h, p_kv128, p_kv512, p_kv2048, s_conv, s_h, s_kv128, s_kv512, s_kv2048)
```

```cpp
#include <hip/hip_runtime.h>
#include <hip/hip_cooperative_groups.h>
#include <cstdio>
namespace cg = cooperative_groups;

namespace pg8 {
#define PG8_LAS __attribute__((address_space(3)))
typedef unsigned short bf16_t;
typedef short bf16x8 __attribute__((ext_vector_type(8)));
typedef float f32x4 __attribute__((ext_vector_type(4)));
typedef unsigned u32x4 __attribute__((ext_vector_type(4)));
constexpr int BM = 256, BK = 64, HALF = 128, HTB = HALF * BK * 2, STAGE_BYTES = 8 * HTB, NXCD = 8, WGM = 8;

__host__ __device__ __forceinline__ int lds_byte(int r, int c) { const int st = (r >> 4) * 2 + (c >> 5), rr = r & 15, cc = c & 31, ob = rr * 64 + cc * 2; return st * 1024 + (ob ^ (((ob >> 9) & 1) << 5)); }
__host__ __device__ __forceinline__ void stage_rc(int b, int& R, int& C) { const int st = b / 1024, sb = b % 1024, swz = sb ^ (((sb >> 9) & 1) << 5); R = (st >> 1) * 16 + swz / 64; C = (st & 1) * 32 + (swz % 64) / 2; }
__host__ __device__ __forceinline__ int perm32(int rho) { const int n = rho >> 4, i = rho & 15; return 8 * (i >> 2) + 4 * n + (i & 3); }

struct Unit { int pm, pn; };
struct Gemm { const bf16_t* A; const bf16_t* Bt; int M, N, K; };

struct StaticOrder {
    int nM, nN, nwg, G, c;
    __host__ __device__ void init(int M, int N, int G_, int c_) { nM = M / BM; nN = N / BM; nwg = nM * nN; G = G_; c = c_; }
    __host__ __device__ bool next(int i, Unit& u) const {
        const long L = (long)i * G + c; if (L >= nwg) return false;
        int wgid = (int)L; { const int q = nwg / NXCD, r = nwg % NXCD, xcd = wgid % NXCD, off = wgid / NXCD; wgid = (xcd < r ? xcd * (q + 1) : r * (q + 1) + (xcd - r) * q) + off; }
        const int nig = WGM * nN, gid = wgid / nig, fm = gid * WGM, gsz = (nM - fm) < WGM ? (nM - fm) : WGM;
        u.pm = fm + ((wgid % nig) % gsz); u.pn = (wgid % nig) / gsz; return true;
    }
    __device__ __forceinline__ void a_ready(const Unit&) const {}
    __device__ __forceinline__ void done(const Unit&) const {}
};
template <class Epi, class Sched, bool STAMP = false>
__device__ __forceinline__ void gemm_phase(PG8_LAS unsigned char* lds, const Gemm g, const Sched& S, const Epi& E, unsigned long long* stamps) {
    int tid = threadIdx.x; asm volatile("" : "+v"(tid));
    const int wid = __builtin_amdgcn_readfirstlane(tid >> 6), lane = tid & 63, wr = wid >> 2, wc = wid & 3, fr = lane & 15, fq = lane >> 4;
    const int K = g.K, nt = K / BK;
    int ts_lo = 0, ts_hi = 0, nts = 0; const unsigned long long rt_entry = STAMP ? (unsigned long long)wall_clock64() : 0ull;
#define PG8_STAMP() do { if (STAMP && wid == 0 && nts < 64) { const unsigned long long _c = (unsigned long long)clock64(); \
        ts_lo = (lane == nts) ? (int)(unsigned)_c : ts_lo; ts_hi = (lane == nts) ? (int)(unsigned)(_c >> 32) : ts_hi; ++nts; } } while (0)
    PG8_STAMP();
    unsigned voffA[2], voffB[2];
#pragma unroll
    for (int i = 0; i < 2; ++i) { int R, C; stage_rc(tid * 16 + i * 8192, R, C); const int Rb = Epi::PERM ? ((R & ~31) + perm32(R & 31)) : R;
        voffA[i] = (unsigned)(R * K + C) * 2u; voffB[i] = (unsigned)(Rb * K + C) * 2u; }
    const size_t kstep = (size_t)(BK * 2);
    const size_t hstep = (size_t)HALF * K * 2;
    const size_t tstep = 2 * hstep;
    const unsigned ldsw = (unsigned)wid * 1024u;
    const int aoff = lds_byte(wr * 64 + fr, fq * 8), boff = lds_byte(wc * 32 + fr, fq * 8);
#define PG8_SA(b, h) (((b) * 2 + (h)) * HTB)
#define PG8_SB(b, h) ((4 + (b) * 2 + (h)) * HTB)
#define PG8_STAGE(bufoff, gbase, voff) do { _Pragma("unroll") for (int _i = 0; _i < 2; ++_i) \
        __builtin_amdgcn_global_load_lds((const unsigned*)((const char*)(gbase) + (voff)[_i]), (PG8_LAS unsigned*)(lds + (bufoff) + ldsw + _i * 8192), 16, 0, 0); } while (0)
#define PG8_LDA(dst, b, h) do { _Pragma("unroll") for (int m = 0; m < 4; ++m) _Pragma("unroll") for (int k = 0; k < 2; ++k) dst[m][k] = *(const PG8_LAS bf16x8*)(lds + PG8_SA(b, h) + aoff + m * 2048 + k * 1024); } while (0)
#define PG8_LDB(dst, b, h) do { _Pragma("unroll") for (int n = 0; n < 2; ++n) _Pragma("unroll") for (int k = 0; k < 2; ++k) dst[n][k] = *(const PG8_LAS bf16x8*)(lds + PG8_SB(b, h) + boff + n * 2048 + k * 1024); } while (0)
#define PG8_MMA(ai, bj, At, Bt) do { __builtin_amdgcn_s_setprio(1); _Pragma("unroll") for (int m = 0; m < 4; ++m) _Pragma("unroll") for (int n = 0; n < 2; ++n) _Pragma("unroll") for (int k = 0; k < 2; ++k) \
        acc[ai][bj][m][n] = __builtin_amdgcn_mfma_f32_16x16x32_bf16(Bt[n][k], At[m][k], acc[ai][bj][m][n], 0, 0, 0); __builtin_amdgcn_s_setprio(0); } while (0)
#define PG8_WAIT_V(n) asm volatile("s_waitcnt vmcnt(" #n ")" ::: "memory")
#define PG8_WAIT_L(n) asm volatile("s_waitcnt lgkmcnt(" #n ")" ::: "memory")
#define PG8_BAR __builtin_amdgcn_s_barrier()
#define PG8_SCHED __builtin_amdgcn_sched_barrier(0)
    Unit cur, nxt; int ui = 0;
    if (!S.next(0, cur)) return;
    f32x4 acc[2][2][4][2];
#pragma unroll
    for (int a = 0; a < 2; ++a)
#pragma unroll
        for (int b = 0; b < 2; ++b)
#pragma unroll
            for (int m = 0; m < 4; ++m)
#pragma unroll
                for (int n = 0; n < 2; ++n) acc[a][b][m][n] = (f32x4){0.f, 0.f, 0.f, 0.f};
    bf16x8 At[4][2], B0[2][2], B1[2][2];
    const char* cA = (const char*)g.A + (size_t)cur.pm * tstep; const char* cB = (const char*)g.Bt + (size_t)cur.pn * tstep;
    S.a_ready(cur);
    PG8_STAGE(PG8_SB(0, 0), cB, voffB); PG8_STAGE(PG8_SA(0, 0), cA, voffA); PG8_STAGE(PG8_SB(0, 1), cB + hstep, voffB); PG8_STAGE(PG8_SA(0, 1), cA + hstep, voffA);
    if (wr == 1) PG8_BAR;
    PG8_WAIT_V(4); PG8_BAR;
    PG8_STAGE(PG8_SB(1, 0), cB + kstep, voffB); PG8_STAGE(PG8_SA(1, 0), cA + kstep, voffA); PG8_STAGE(PG8_SB(1, 1), cB + hstep + kstep, voffB);
    PG8_WAIT_V(6); PG8_BAR;
    PG8_STAMP();
    for (;;) {
        const bool has_next = S.next(ui + 1, nxt);
        const char* nA = has_next ? (const char*)g.A + (size_t)nxt.pm * tstep : cA; const char* nB = has_next ? (const char*)g.Bt + (size_t)nxt.pn * tstep : cB;
        for (int t = 0; t < nt; t += 2) {
            const bool last = (t == nt - 2);
            const char* a1 = cA + (size_t)(t + 1) * kstep;
            const char* a2 = last ? nA : cA + (size_t)(t + 2) * kstep; const char* b2 = last ? nB : cB + (size_t)(t + 2) * kstep;
            const char* a3 = a2 + kstep; const char* b3 = b2 + kstep;
            if (last && has_next) S.a_ready(nxt);
            PG8_LDB(B0, 0, 0); PG8_SCHED; PG8_LDA(At, 0, 0); PG8_STAGE(PG8_SA(1, 1), a1 + hstep, voffA);
            PG8_WAIT_L(8); PG8_BAR; PG8_WAIT_L(0); PG8_MMA(0, 0, At, B0); PG8_BAR; PG8_SCHED;
            PG8_LDB(B1, 0, 1); PG8_STAGE(PG8_SB(0, 0), b2, voffB);
            PG8_BAR; PG8_WAIT_L(0); PG8_MMA(0, 1, At, B1); PG8_BAR;
            PG8_LDA(At, 0, 1); PG8_STAGE(PG8_SA(0, 0), a2, voffA);
            PG8_BAR; PG8_WAIT_L(0); PG8_MMA(1, 0, At, B0); PG8_BAR; PG8_SCHED;
            PG8_STAGE(PG8_SB(0, 1), b2 + hstep, voffB);
            PG8_WAIT_V(6); PG8_BAR; PG8_MMA(1, 1, At, B1); PG8_BAR;
            PG8_LDB(B0, 1, 0); PG8_SCHED; PG8_LDA(At, 1, 0); PG8_STAGE(PG8_SA(0, 1), a2 + hstep, voffA);
            PG8_WAIT_L(8); PG8_BAR; PG8_WAIT_L(0); PG8_MMA(0, 0, At, B0); PG8_BAR; PG8_SCHED;
            PG8_LDB(B1, 1, 1); PG8_STAGE(PG8_SB(1, 0), b3, voffB);
            PG8_BAR; PG8_WAIT_L(0); PG8_MMA(0, 1, At, B1); PG8_BAR;
            PG8_LDA(At, 1, 1); PG8_STAGE(PG8_SA(1, 0), a3, voffA);
            PG8_BAR; PG8_WAIT_L(0); PG8_MMA(1, 0, At, B0); PG8_BAR; PG8_SCHED;
            PG8_STAGE(PG8_SB(1, 1), b3 + hstep, voffB);
            PG8_WAIT_V(6); PG8_BAR; PG8_MMA(1, 1, At, B1); PG8_BAR;
        }
        PG8_STAMP();
        if constexpr (!Epi::AFTER_DRAIN) { E(acc, cur, wr, wc, fr, fq); S.done(cur); }
        PG8_STAMP();
        if (!has_next) break;
#pragma unroll
        for (int a = 0; a < 2; ++a)
#pragma unroll
            for (int b = 0; b < 2; ++b)
#pragma unroll
                for (int m = 0; m < 4; ++m)
#pragma unroll
                    for (int n = 0; n < 2; ++n) acc[a][b][m][n] = (f32x4){0.f, 0.f, 0.f, 0.f};
        cur = nxt; cA = nA; cB = nB; ++ui;
    }
    PG8_WAIT_V(0);
    if (wr == 0) PG8_BAR;
    PG8_BAR;
    if constexpr (Epi::AFTER_DRAIN) { E.fused(acc, cur, wr, wc, fr, fq, lds, wid, lane); S.done(cur); }
    PG8_STAMP();
    if (STAMP && wid == 0) { stamps[lane] = lane < nts ? (((unsigned long long)(unsigned)ts_hi << 32) | (unsigned)ts_lo) : 0ull;
        if (lane == 62) stamps[62] = rt_entry; if (lane == 63) stamps[63] = (unsigned long long)wall_clock64(); }
#undef PG8_STAMP
#undef PG8_SA
#undef PG8_SB
#undef PG8_STAGE
#undef PG8_LDA
#undef PG8_LDB
#undef PG8_MMA
#undef PG8_WAIT_V
#undef PG8_WAIT_L
#undef PG8_BAR
#undef PG8_SCHED
}}

using pg8::bf16_t; using pg8::bf16x8; using pg8::f32x4; using pg8::u32x4;
typedef short s16x4 __attribute__((ext_vector_type(4)));
typedef float f32x16 __attribute__((ext_vector_type(16)));
typedef float f32x2 __attribute__((ext_vector_type(2)));
typedef unsigned u32x2 __attribute__((ext_vector_type(2)));
typedef unsigned long long u64;
#define LAS __attribute__((address_space(3)))
#define LDS_WAIT() asm volatile("s_waitcnt lgkmcnt(0)" ::: "memory")

constexpr int DM = 4096, SEQ = 2048, TP = 8192, RP = 8448;
constexpr size_t MiB = (size_t)1 << 20;
constexpr size_t O_BT1 = 0, O_BT2 = O_BT1 + 128 * MiB, O_BT3 = O_BT2 + 64 * MiB, O_BT4 = O_BT3 + 88 * MiB, O_BT5 = O_BT4 + 64 * MiB, O_WG = O_BT5 + 32 * MiB,
                 O_XBF = O_WG + 8 * MiB, O_POOL = O_XBF + 66 * MiB, O_Y = O_POOL + 198 * MiB, O_SG2 = O_Y + 66 * MiB, O_OG = O_SG2 + 33 * MiB, O_KVB = O_OG + 33 * MiB,
                 O_RS = O_KVB + 48 * MiB, O_SSQP = O_RS + 1 * MiB, O_LSE = O_SSQP + 2 * MiB, O_GRAN = O_LSE + 2 * MiB, O_PART = O_GRAN + 8 * MiB, O_END = O_PART + 3 * MiB;
constexpr size_t P_XB = O_POOL, P_SG = O_POOL + 66 * MiB, P_HG = O_POOL + 132 * MiB, P_Q = O_POOL, P_ON = O_POOL + 99 * MiB;
constexpr size_t OUT_YP = 0, OUT_YS = 33554432, OUT_PCONV = OUT_YS + 32768, OUT_PH = OUT_PCONV + 98304, OUT_PKV0 = OUT_PH + 32768, OUT_PKV1 = OUT_PKV0 + 524288, OUT_PKV2 = OUT_PKV1 + 2097152,
                 OUT_SCONV = OUT_PKV2 + 8388608, OUT_SH = OUT_SCONV + 196608, OUT_SKV0 = OUT_SH + 65536, OUT_SKV1 = OUT_SKV0 + 1048576, OUT_SKV2 = OUT_SKV1 + 4194304;
constexpr int LDS_BYTES = 159744;
constexpr float EPSN = 1e-6f;

struct Params { const float* in[25]; float* out; unsigned char* ws; };

__device__ __forceinline__ unsigned pk2(float a, float b) { typedef __bf16 bf2 __attribute__((ext_vector_type(2))); bf2 v; v[0] = (__bf16)a; v[1] = (__bf16)b; return __builtin_bit_cast(unsigned, v); }
__device__ __forceinline__ float bflo(unsigned u) { return __uint_as_float(u << 16); }
__device__ __forceinline__ float bfhi(unsigned u) { return __uint_as_float(u & 0xffff0000u); }
__device__ __forceinline__ float bf2f(bf16_t h) { return __uint_as_float(((unsigned)h) << 16); }
__device__ __forceinline__ float silu_f(float v) { return v * __builtin_amdgcn_rcpf(1.0f + __expf(-v)); }
__device__ __forceinline__ float sigm_f(float v) { return __builtin_amdgcn_rcpf(1.0f + __expf(-v)); }
__device__ __forceinline__ float wave_sum(float v) {
#pragma unroll
    for (int o = 1; o < 64; o <<= 1) v += __shfl_xor(v, o);
    return v;
}
__device__ __forceinline__ float wave_max(float v) {
#pragma unroll
    for (int o = 1; o < 64; o <<= 1) v = fmaxf(v, __shfl_xor(v, o));
    return v;
}
__device__ __forceinline__ int crow(int reg, int h) { return (reg & 3) + 8 * (reg >> 2) + 4 * h; }
__device__ __forceinline__ int rel_bucket(int dd) {
    if (dd < 16) return dd;
    const float d = (float)dd;
    int large = 16 + (int)(logf(d * (1.0f / 16.0f)) / logf(128.0f) * 16.0f);
    return large < 31 ? large : 31;
}
#define MFMA32(a, b, c) __builtin_amdgcn_mfma_f32_32x32x16_bf16((a), (b), (c), 0, 0, 0)

struct Epi {
    static constexpr bool PERM = true, AFTER_DRAIN = false;
    int mode;
    const float* rs; bf16_t* o0; bf16_t* o1; bf16_t* o2; float* ssqp; float* outp;
    __device__ __forceinline__ void operator()(const f32x4 (&acc)[2][2][4][2], const pg8::Unit& u, int wr, int wc, int fr, int fq) const {
        const int row0 = u.pm * 256 + wr * 64 + fr, colt = u.pn * 256, cw = wc * 32 + 8 * fq;
        if (mode == 1) {
#pragma unroll
            for (int ai = 0; ai < 2; ++ai)
#pragma unroll
                for (int m = 0; m < 4; ++m) {
                    const int row = row0 + ai * 128 + m * 16; float ss = 0.f;
#pragma unroll
                    for (int bj = 0; bj < 2; ++bj) {
                        const f32x4 v0 = acc[ai][bj][m][0], v1 = acc[ai][bj][m][1];
                        ss += (v0[0] * v0[0] + v0[1] * v0[1]) + (v0[2] * v0[2] + v0[3] * v0[3]) + (v1[0] * v1[0] + v1[1] * v1[1]) + (v1[2] * v1[2] + v1[3] * v1[3]);
                        u32x4 w; w.x = pk2(v0[0], v0[1]); w.y = pk2(v0[2], v0[3]); w.z = pk2(v1[0], v1[1]); w.w = pk2(v1[2], v1[3]);
                        *(u32x4*)(o0 + (size_t)row * 4096 + colt + bj * 128 + cw) = w;
                    }
                    ss += __shfl_xor(ss, 16); ss += __shfl_xor(ss, 32);
                    if (fq == 0) ssqp[(size_t)row * 64 + u.pn * 4 + wc] = ss;
                }
            return;
        }
        bf16_t* dst; int ld, col; bool act = false, kv = false;
        if (mode == 0) { ld = 4096; if (colt < 4096) { dst = o0; col = colt; } else { dst = o1; col = colt - 4096; act = true; } }
        else { if (colt < 6144) { dst = o0; ld = 6144; col = colt; } else if (colt < 8192) { dst = o1; ld = 2048; col = colt - 6144; act = true; } else { dst = o2; ld = 3072; col = colt - 8192; kv = true; } }
#pragma unroll
        for (int ai = 0; ai < 2; ++ai)
#pragma unroll
            for (int m = 0; m < 4; ++m) {
                const int row = row0 + ai * 128 + m * 16; const float r = rs[row];
#pragma unroll
                for (int bj = 0; bj < 2; ++bj) {
                    f32x4 v0 = acc[ai][bj][m][0] * r, v1 = acc[ai][bj][m][1] * r;
                    if (act) {
#pragma unroll
                        for (int j = 0; j < 4; ++j) { v0[j] = silu_f(v0[j]); v1[j] = silu_f(v1[j]); }
                    }
                    u32x4 w; w.x = pk2(v0[0], v0[1]); w.y = pk2(v0[2], v0[3]); w.z = pk2(v1[0], v1[1]); w.w = pk2(v1[2], v1[3]);
                    const int cc = col + bj * 128 + cw;
                    *(u32x4*)(dst + (size_t)row * ld + cc) = w;
                    if (kv) {
                        const int g = cc >> 10, rem = cc & 1023, keep = 128 << (2 * g), n = row >> 11, t = row & 2047;
                        if (t >= 2048 - keep) {
                            const size_t ob = (g == 0 ? OUT_PKV0 : (g == 1 ? OUT_PKV1 : OUT_PKV2)) + ((size_t)(n * keep + (t - (2048 - keep))) * 1024 + rem);
                            *(f32x4*)(outp + ob) = v0; *(f32x4*)(outp + ob + 4) = v1;
                        }
                    }
                }
            }
    }
};

__device__ __forceinline__ void transpose_item(const float* W, int K, int N, bf16_t* WT, const float* gain, LAS float* scr, int item, int lane) {
    const int nblk = N / 32, kb = item / nblk, nb = item % nblk, k0 = 64 * kb, n0 = 32 * nb;
#pragma unroll 8
    for (int i = 0; i < 32; ++i) { const int kk = 2 * i + (lane >> 5); float v = W[(size_t)(k0 + kk) * N + n0 + (lane & 31)]; if (gain) v *= gain[k0 + kk]; scr[kk * 33 + (lane & 31)] = v; }
    LDS_WAIT();
    const int c = lane & 7;
#pragma unroll
    for (int j = 0; j < 4; ++j) { const int n = (lane >> 3) + 8 * j; const LAS float* s = scr + (8 * c) * 33 + n;
        u32x4 o; o.x = pk2(s[0 * 33], s[1 * 33]); o.y = pk2(s[2 * 33], s[3 * 33]); o.z = pk2(s[4 * 33], s[5 * 33]); o.w = pk2(s[6 * 33], s[7 * 33]);
        *(u32x4*)(WT + (size_t)(n0 + n) * K + k0 + 8 * c) = o; }
    LDS_WAIT();
}

__device__ __forceinline__ void prep_phase(const Params& P, LAS unsigned char* lds) {
    int tid = threadIdx.x; asm volatile("" : "+v"(tid));
    const int lane = tid & 63, w = __builtin_amdgcn_readfirstlane(tid >> 6);
    const int gw = blockIdx.x * 8 + w, NGW = gridDim.x * 8;
    unsigned char* ws = P.ws;
    { u64* gr = (u64*)(ws + O_GRAN); const size_t n = (8 * MiB) / 8; for (size_t i = (size_t)blockIdx.x * 512 + tid; i < n; i += (size_t)gridDim.x * 512) gr[i] = 0ull; }
    { bf16_t* XBF = (bf16_t*)(ws + O_XBF); float* RS = (float*)(ws + O_RS);
      for (int row = gw; row < TP + 8; row += NGW) {
          const float* xr = row < TP ? P.in[0] + (size_t)row * DM : P.in[1] + (size_t)(row - TP) * DM;
          const f32x4* x4 = (const f32x4*)xr + lane; f32x4 v[16]; float s = 0.f;
#pragma unroll
          for (int j = 0; j < 16; ++j) { v[j] = x4[64 * j]; s += (v[j].x * v[j].x + v[j].y * v[j].y) + (v[j].z * v[j].z + v[j].w * v[j].w); }
          s = wave_sum(s);
          u32x2* o = (u32x2*)(XBF + (size_t)row * DM) + lane;
#pragma unroll
          for (int j = 0; j < 16; ++j) { u32x2 q; q.x = pk2(v[j].x, v[j].y); q.y = pk2(v[j].z, v[j].w); o[64 * j] = q; }
          if (lane == 0) RS[row] = rsqrtf(s * (1.0f / DM) + EPSN);
      } }
    for (int g = 0; g < 3; ++g) {
        const int lb = 128 << (2 * g); const size_t per = (size_t)(lb - 1) * 256, tot = 8 * per;
        const f32x4* src = (const f32x4*)P.in[4 + g]; f32x4* dst = (f32x4*)(P.out + (g == 0 ? OUT_SKV0 : (g == 1 ? OUT_SKV1 : OUT_SKV2)));
        for (size_t i = (size_t)blockIdx.x * 512 + tid; i < tot; i += (size_t)gridDim.x * 512) { const size_t b = i / per, o = i - b * per; dst[b * (size_t)lb * 256 + o] = src[b * (size_t)lb * 256 + 256 + o]; }
    }
    LAS float* scr = (LAS float*)(lds + w * 8448);
    constexpr int I_AIN = 64 * 256, I_AOUT = 64 * 128, I_KV = 64 * 96, I_BOUT = 32 * 128, I_G = 32;
    constexpr int NITEMS = 2 * I_AIN + 2 * I_AOUT + I_AIN + I_KV + I_AIN + 2 * I_BOUT + 64 * I_G;
    for (int it = gw; it < NITEMS; it += NGW) {
        int r = it;
        if (r < 2 * I_AIN) { const int l = r / I_AIN; transpose_item(P.in[8] + (size_t)l * 4096 * 8192, 4096, 8192, (bf16_t*)(ws + O_BT1) + (size_t)l * 8192 * 4096, P.in[7] + l * 4096, scr, r % I_AIN, lane); continue; } r -= 2 * I_AIN;
        if (r < 2 * I_AOUT) { const int l = r / I_AOUT; transpose_item(P.in[16] + (size_t)l * 4096 * 4096, 4096, 4096, (bf16_t*)(ws + O_BT2) + (size_t)l * 4096 * 4096, nullptr, scr, r % I_AOUT, lane); continue; } r -= 2 * I_AOUT;
        if (r < I_AIN) { transpose_item(P.in[22], 4096, 8192, (bf16_t*)(ws + O_BT3), P.in[21], scr, r, lane); continue; } r -= I_AIN;
        if (r < I_KV) { transpose_item(P.in[19], 4096, 3072, (bf16_t*)(ws + O_BT3) + (size_t)8192 * 4096, P.in[18], scr, r, lane); continue; } r -= I_KV;
        if (r < I_AIN) { transpose_item(P.in[22] + (size_t)4096 * 8192, 4096, 8192, (bf16_t*)(ws + O_BT4), P.in[21] + 4096, scr, r, lane); continue; } r -= I_AIN;
        if (r < 2 * I_BOUT) { const int l = r / I_BOUT; transpose_item(P.in[23] + (size_t)l * 2048 * 4096, 2048, 4096, (bf16_t*)(ws + O_BT5) + (size_t)l * 4096 * 2048, nullptr, scr, r % I_BOUT, lane); continue; } r -= 2 * I_BOUT;
        { const int mat = r / I_G, gate = mat & 1, lh = mat >> 1;
          transpose_item((gate ? P.in[13] : P.in[11]) + (size_t)lh * 65536, 256, 256, (bf16_t*)(ws + O_WG) + (size_t)(lh * 2 + gate) * 65536, nullptr, scr, r % I_G, lane); }
    }
}

__device__ __forceinline__ void skinny_phase(const bf16_t* A, const bf16_t* Bt, int N, int K, float* part) {
    int tid = threadIdx.x; asm volatile("" : "+v"(tid));
    const int lane = tid & 63, w = __builtin_amdgcn_readfirstlane(tid >> 6), fr = lane & 15, fq = lane >> 4;
    const int gw = blockIdx.x * 8 + w, NGW = gridDim.x * 8;
    const int nitems = (N / 16) * 8, kspan = K / 8;
    for (int it = gw; it < nitems; it += NGW) {
        const int grp = it >> 3, ks = it & 7, n0 = grp * 16, k0 = ks * kspan;
        const bf16_t* ap = A + (size_t)(fr & 7) * K + k0 + fq * 8; const bf16_t* bp = Bt + (size_t)(n0 + fr) * K + k0 + fq * 8;
        f32x4 acc = {0.f, 0.f, 0.f, 0.f};
#pragma unroll 4
        for (int kk = 0; kk < kspan; kk += 32) {
            bf16x8 a = *(const bf16x8*)(ap + kk); const bf16x8 b = *(const bf16x8*)(bp + kk);
            if (fr >= 8) a = (bf16x8){0, 0, 0, 0, 0, 0, 0, 0};
            acc = __builtin_amdgcn_mfma_f32_16x16x32_bf16(a, b, acc, 0, 0, 0);
        }
        if (fq < 2) {
#pragma unroll
            for (int i = 0; i < 4; ++i) part[(size_t)(ks * 8 + fq * 4 + i) * N + n0 + fr] = acc[i];
        }
    }
}
__device__ __forceinline__ float part_sum(const float* part, int N, int b, int col) {
    float s = 0.f;
#pragma unroll
    for (int ks = 0; ks < 8; ++ks) s += part[(size_t)(ks * 8 + b) * N + col];
    return s;
}

constexpr int SROW = 528;
__device__ __forceinline__ void scan_tile(const Params& P, LAS unsigned char* lds, int l, int tile) {
    int tid = threadIdx.x; asm volatile("" : "+v"(tid));
    const int lane = tid & 63, w = __builtin_amdgcn_readfirstlane(tid >> 6), hh = lane >> 5, l32 = lane & 31;
    LAS unsigned char* RAW = lds;
    LAS unsigned char* AT = lds + 35840;
    unsigned char* ws = P.ws;
    const bf16_t* XB = (const bf16_t*)(ws + P_XB); const bf16_t* SG = (const bf16_t*)(ws + P_SG); bf16_t* HG = (bf16_t*)(ws + P_HG);
    const float* PART = (const float*)(ws + O_PART); const float* RS = (const float*)(ws + O_RS);
    const bool is_s = tile < 16;
    int head, n = 0, sp = 0;
    if (is_s) head = tile; else { const int idx = tile - 16; sp = idx >> 6; n = (idx >> 4) & 3; head = idx & 15; }
    const int r0 = n * 2048 + sp * 64, gc0 = head * 256;
    const float* cwp = P.in[9] + (size_t)l * 4 * 4096; const float* cbp = P.in[10] + (size_t)l * 4096;
    __syncthreads();
    if (is_s) {
        const int b = tid >> 6, ch = (tid & 63) * 4; const float rsb = RS[TP + b];
        float xc[4][4];
#pragma unroll
        for (int e = 0; e < 4; ++e) {
            const int gc = gc0 + ch + e;
#pragma unroll
            for (int k = 0; k < 3; ++k) xc[k][e] = P.in[2][((size_t)(l * 8 + b) * 3 + k) * 4096 + gc];
            xc[3][e] = rsb * part_sum(PART, 8192, b, gc);
        }
        float o[4];
#pragma unroll
        for (int e = 0; e < 4; ++e) {
            const int gc = gc0 + ch + e; float v = cbp[gc];
#pragma unroll
            for (int k = 0; k < 4; ++k) v += xc[k][e] * cwp[k * 4096 + gc];
            o[e] = v;
#pragma unroll
            for (int k = 0; k < 3; ++k) P.out[OUT_SCONV + ((size_t)(l * 8 + b) * 3 + k) * 4096 + gc] = xc[k + 1][e];
        }
        u32x2 q; q.x = pk2(o[0], o[1]); q.y = pk2(o[2], o[3]);
        *(LAS u32x2*)(AT + b * SROW + ch * 2) = q;
    } else {
#pragma unroll
        for (int j = 0; j < 5; ++j) {
            const int id = tid + 512 * j, i = id >> 5, c8 = id & 31;
            if (i < 67) {
                u32x4 v = {0u, 0u, 0u, 0u};
                if (!(sp == 0 && i < 3)) v = *(const u32x4*)(XB + (size_t)(r0 - 3 + i) * 4096 + gc0 + c8 * 8);
                *(LAS u32x4*)(RAW + i * SROW + c8 * 16) = v;
            }
        }
        __syncthreads();
        const int c8 = tid & 31; float wk[4][8], bb[8];
#pragma unroll
        for (int e = 0; e < 8; ++e) { bb[e] = cbp[gc0 + c8 * 8 + e];
#pragma unroll
            for (int k = 0; k < 4; ++k) wk[k][e] = cwp[k * 4096 + gc0 + c8 * 8 + e]; }
#pragma unroll
        for (int j = 0; j < 4; ++j) {
            const int i = (tid >> 5) + 16 * j;
            float o[8];
#pragma unroll
            for (int e = 0; e < 8; ++e) o[e] = bb[e];
            u32x4 last;
#pragma unroll
            for (int k = 0; k < 4; ++k) {
                const u32x4 v = *(const LAS u32x4*)(RAW + (i + k) * SROW + c8 * 16); last = v;
                o[0] += bflo(v.x) * wk[k][0]; o[1] += bfhi(v.x) * wk[k][1]; o[2] += bflo(v.y) * wk[k][2]; o[3] += bfhi(v.y) * wk[k][3];
                o[4] += bflo(v.z) * wk[k][4]; o[5] += bfhi(v.z) * wk[k][5]; o[6] += bflo(v.w) * wk[k][6]; o[7] += bfhi(v.w) * wk[k][7];
            }
            u32x4 q; q.x = pk2(o[0], o[1]); q.y = pk2(o[2], o[3]); q.z = pk2(o[4], o[5]); q.w = pk2(o[6], o[7]);
            *(LAS u32x4*)(AT + i * SROW + c8 * 16) = q;
            if (sp == 31 && i >= 61) {
                float* d = P.out + OUT_PCONV + ((size_t)(l * 4 + n) * 3 + (i - 61)) * 4096 + gc0 + c8 * 8;
                f32x4 a = {bflo(last.x), bfhi(last.x), bflo(last.y), bfhi(last.y)}, b = {bflo(last.z), bfhi(last.z), bflo(last.w), bfhi(last.w)};
                *(f32x4*)d = a; *(f32x4*)(d + 4) = b;
            }
        }
    }
    __syncthreads();
    f32x16 aR[2], aI[2];
#pragma unroll
    for (int mt = 0; mt < 2; ++mt)
#pragma unroll
        for (int e = 0; e < 16; ++e) { aR[mt][e] = 0.f; aI[mt][e] = 0.f; }
    {
        const bf16_t* wrp = (const bf16_t*)(ws + O_WG) + (size_t)((l * 16 + head) * 2) * 65536 + (size_t)(w * 32 + l32) * 256 + hh * 8;
        const bf16_t* wip = wrp + 65536;
#pragma unroll 4
        for (int ks = 0; ks < 16; ++ks) {
            const bf16x8 bR = *(const bf16x8*)(wrp + ks * 16), bI = *(const bf16x8*)(wip + ks * 16);
#pragma unroll
            for (int mt = 0; mt < 2; ++mt) {
                const bf16x8 a = *(const LAS bf16x8*)(AT + (mt * 32 + l32) * SROW + (ks * 16 + hh * 8) * 2);
                aR[mt] = MFMA32(a, bR, aR[mt]); aI[mt] = MFMA32(a, bI, aI[mt]);
            }
        }
    }
    const int ch = w * 32 + l32, gch = gc0 + ch;
    const float bga = P.in[12][(size_t)l * 4096 + gch], bgx = P.in[14][(size_t)l * 4096 + gch];
    const float lamc = -8.0f * log1pf(expf(-P.in[15][(size_t)l * 4096 + gch]));
#pragma unroll
    for (int mt = 0; mt < 2; ++mt)
#pragma unroll
        for (int reg = 0; reg < 16; ++reg) {
            const int row = mt * 32 + crow(reg, hh);
            const float r = sigm_f(aR[mt][reg] + bga), ig = sigm_f(aI[mt][reg] + bgx);
            const float la = lamc * r, a = __expf(la), t2 = 2.0f * la;
            const float em = t2 > -0.05f ? -t2 * (1.0f + t2 * (0.5f + t2 * (0.16666667f + t2 * 0.041666668f))) : 1.0f - __expf(t2);
            const float xf = bf2f(*(const LAS bf16_t*)(AT + row * SROW + ch * 2));
            aR[mt][reg] = a; aI[mt][reg] = __builtin_amdgcn_sqrtf(em) * ig * xf;
            if ((reg & 3) == 3) __builtin_amdgcn_sched_barrier(0);
        }
    if (is_s) {
#pragma unroll
        for (int j = 0; j < 4; ++j) {
            const int b = j + 4 * hh;
            const float h0 = P.in[3][(size_t)(l * 8 + b) * 4096 + gch];
            const float h = aR[0][j] * h0 + aI[0][j];
            P.out[OUT_SH + (size_t)(l * 8 + b) * 4096 + gch] = h;
            const float sg = silu_f(RS[TP + b] * part_sum(PART, 8192, b, 4096 + gch));
            HG[(size_t)(TP + b) * 4096 + gch] = (bf16_t)(pk2(h * sg, 0.f) & 0xffffu);
        }
        return;
    }
    float Pp = 1.f, Cc = 0.f;
#pragma unroll
    for (int mt = 0; mt < 2; ++mt)
#pragma unroll
        for (int g = 0; g < 4; ++g) {
            float A = aR[mt][4 * g], H = aI[mt][4 * g];
#pragma unroll
            for (int j = 1; j < 4; ++j) { const float a = aR[mt][4 * g + j], b = aI[mt][4 * g + j]; H = a * H + b; A = A * a; aR[mt][4 * g + j] = A; aI[mt][4 * g + j] = H; }
            const float pA = __shfl_xor(A, 32), pH = __shfl_xor(H, 32);
            const float s0a = hh ? pA : A, s0b = hh ? pH : H, s1a = hh ? A : pA, s1b = hh ? H : pH;
            const float P1 = Pp * s0a, C1 = s0a * Cc + s0b;
            const float Pm = hh ? P1 : Pp, Cm = hh ? C1 : Cc;
#pragma unroll
            for (int j = 0; j < 4; ++j) { aI[mt][4 * g + j] += aR[mt][4 * g + j] * Cm; aR[mt][4 * g + j] *= Pm; }
            Pp = P1 * s1a; Cc = s1a * C1 + s1b;
        }
    u64* gr = (u64*)(ws + O_GRAN) + ((((size_t)l * 4 + n) * 32 + sp) * 16 + head) * 256 + ch;
    const unsigned tag = 1u + (unsigned)l;
    float H0 = 0.f;
    if (sp > 0) {
        const u64* pg = gr - 16 * 256; u64 x = 0; unsigned spins = 0;
        for (;;) {
            x = __hip_atomic_load(pg, __ATOMIC_RELAXED, __HIP_MEMORY_SCOPE_AGENT);
            if (__all((unsigned)(x >> 32) == tag)) break;
            if (++spins > (1u << 22)) break;
            __builtin_amdgcn_s_sleep(1);
        }
        H0 = __uint_as_float((unsigned)x);
    }
    const float hend = Cc + Pp * H0;
    if (hh == 0) {
        __hip_atomic_store(gr, ((u64)tag << 32) | (u64)__float_as_uint(hend), __ATOMIC_RELAXED, __HIP_MEMORY_SCOPE_AGENT);
        if (sp == 31) P.out[OUT_PH + (size_t)(l * 4 + n) * 4096 + gch] = hend;
    }
    __syncthreads();
#pragma unroll
    for (int mt = 0; mt < 2; ++mt)
#pragma unroll
        for (int reg = 0; reg < 16; ++reg) {
            const int row = mt * 32 + crow(reg, hh);
            const float h = aI[mt][reg] + aR[mt][reg] * H0;
            *(LAS bf16_t*)(AT + row * SROW + ch * 2) = (bf16_t)(pk2(h, 0.f) & 0xffffu);
        }
    __syncthreads();
    {
        const int c8 = tid & 31;
#pragma unroll
        for (int j = 0; j < 4; ++j) {
            const int i = (tid >> 5) + 16 * j;
            const u32x4 hv = *(const LAS u32x4*)(AT + i * SROW + c8 * 16);
            const size_t go = (size_t)(r0 + i) * 4096 + gc0 + c8 * 8;
            const u32x4 sv = *(const u32x4*)(SG + go);
            u32x4 q; q.x = pk2(bflo(hv.x) * bflo(sv.x), bfhi(hv.x) * bfhi(sv.x)); q.y = pk2(bflo(hv.y) * bflo(sv.y), bfhi(hv.y) * bfhi(sv.y));
            q.z = pk2(bflo(hv.z) * bflo(sv.z), bfhi(hv.z) * bfhi(sv.z)); q.w = pk2(bflo(hv.w) * bflo(sv.w), bfhi(hv.w) * bfhi(sv.w));
            *(u32x4*)(HG + go) = q;
        }
    }
}

__device__ __forceinline__ void post_phase(const Params& P, int L) {
    int tid = threadIdx.x; asm volatile("" : "+v"(tid));
    const int lane = tid & 63, w = __builtin_amdgcn_readfirstlane(tid >> 6);
    const int gw = blockIdx.x * 8 + w, NGW = gridDim.x * 8;
    unsigned char* ws = P.ws;
    const float* gain = L < 2 ? P.in[17] + (size_t)L * 4096 : P.in[24] + (size_t)(L - 2) * 4096;
    const bf16_t* Y = (const bf16_t*)(ws + O_Y); const float* SSQP = (const float*)(ws + O_SSQP); const float* PART = (const float*)(ws + O_PART);
    bf16_t* XBF = (bf16_t*)(ws + O_XBF); float* RS = (float*)(ws + O_RS);
    for (int row = gw; row < TP + 8; row += NGW) {
        if (row < TP) {
            const float* xin = (L == 0 ? P.in[0] : P.out + OUT_YP) + (size_t)row * 4096; float* xout = P.out + OUT_YP + (size_t)row * 4096;
            const float rsn = rsqrtf(wave_sum(SSQP[(size_t)row * 64 + lane]) * (1.0f / 4096.0f) + EPSN);
            float acc = 0.f;
#pragma unroll
            for (int j = 0; j < 8; ++j) {
                const int col = j * 512 + lane * 8;
                const u32x4 yv = *(const u32x4*)(Y + (size_t)row * 4096 + col);
                const f32x4 x0 = *(const f32x4*)(xin + col), x1 = *(const f32x4*)(xin + col + 4), g0 = *(const f32x4*)(gain + col), g1 = *(const f32x4*)(gain + col + 4);
                f32x4 y0 = {bflo(yv.x), bfhi(yv.x), bflo(yv.y), bfhi(yv.y)}, y1 = {bflo(yv.z), bfhi(yv.z), bflo(yv.w), bfhi(yv.w)};
                const f32x4 n0 = x0 + y0 * rsn * g0, n1 = x1 + y1 * rsn * g1;
                acc += (n0.x * n0.x + n0.y * n0.y) + (n0.z * n0.z + n0.w * n0.w) + (n1.x * n1.x + n1.y * n1.y) + (n1.z * n1.z + n1.w * n1.w);
                *(f32x4*)(xout + col) = n0; *(f32x4*)(xout + col + 4) = n1;
                u32x4 q; q.x = pk2(n0.x, n0.y); q.y = pk2(n0.z, n0.w); q.z = pk2(n1.x, n1.y); q.w = pk2(n1.z, n1.w);
                *(u32x4*)(XBF + (size_t)row * 4096 + col) = q;
            }
            acc = wave_sum(acc);
            if (lane == 0) RS[row] = rsqrtf(acc * (1.0f / 4096.0f) + EPSN);
        } else {
            const int b = row - TP;
            const float* xin = (L == 0 ? P.in[1] : P.out + OUT_YS) + (size_t)b * 4096; float* xout = P.out + OUT_YS + (size_t)b * 4096;
            float ss = 0.f;
            for (int j = 0; j < 8; ++j)
#pragma unroll
                for (int e = 0; e < 8; ++e) { const float y = part_sum(PART, 4096, b, j * 512 + lane * 8 + e); ss += y * y; }
            const float rsn = rsqrtf(wave_sum(ss) * (1.0f / 4096.0f) + EPSN);
            float acc = 0.f;
            for (int j = 0; j < 8; ++j) {
                const int col = j * 512 + lane * 8; float nv[8];
#pragma unroll
                for (int e = 0; e < 8; ++e) { const float y = part_sum(PART, 4096, b, col + e); nv[e] = xin[col + e] + y * rsn * gain[col + e]; acc += nv[e] * nv[e]; xout[col + e] = nv[e]; }
                u32x4 q; q.x = pk2(nv[0], nv[1]); q.y = pk2(nv[2], nv[3]); q.z = pk2(nv[4], nv[5]); q.w = pk2(nv[6], nv[7]);
                *(u32x4*)(XBF + (size_t)row * 4096 + col) = q;
            }
            acc = wave_sum(acc);
            if (lane == 0) RS[row] = rsqrtf(acc * (1.0f / 4096.0f) + EPSN);
        }
    }
}

constexpr int KROW = 272, VROW = 320, OFF_VS = 69632, OFF_BI = OFF_VS + 81920, OFF_SW = OFF_BI + 2112;
__device__ __forceinline__ void attn_item(const Params& P, LAS unsigned char* lds, int item) {
    int tid = threadIdx.x; asm volatile("" : "+v"(tid));
    const int lane = tid & 63, w = __builtin_amdgcn_readfirstlane(tid >> 6), hh = lane >> 5, l32 = lane & 31;
    unsigned char* ws = P.ws;
    const bf16_t* Q = (const bf16_t*)(ws + P_Q); const bf16_t* KVB = (const bf16_t*)(ws + O_KVB); bf16_t* ON = (bf16_t*)(ws + P_ON); float* LSE = (float*)(ws + O_LSE);
    const int g = item >> 8, rem = item & 255, n = rem >> 6, kvh = rem & 3, cb = (rem >> 2) & 15;
    const int r = 1 << (2 * g), nb = 16 >> (2 * g), c = cb / nb, nbi = cb % nb;
    LAS unsigned char* Ks = lds; LAS unsigned char* Vs = lds + OFF_VS; LAS float* BI = (LAS float*)(lds + OFF_BI);
    __syncthreads();
#pragma unroll
    for (int j = 0; j < 8; ++j) {
        const int id = tid + 512 * j, kk = id >> 4, chk = id & 15, pos = (nbi - 1) * 128 + kk;
        u32x4 kv = {0u, 0u, 0u, 0u}, vv = {0u, 0u, 0u, 0u};
        if (pos >= 0) { const bf16_t* src = KVB + (size_t)(n * 2048 + pos * r + c) * 3072 + g * 1024 + kvh * 128 + chk * 8; kv = *(const u32x4*)src; vv = *(const u32x4*)(src + 512); }
        *(LAS u32x4*)(Ks + kk * KROW + chk * 16) = kv; *(LAS u32x4*)(Vs + kk * VROW + chk * 16) = vv;
    }
    for (int e = tid; e < 516; e += 512) { const int hl = e / 129, dist = e % 129; BI[hl * 132 + dist] = P.in[20][rel_bucket(dist * r) * 48 + g * 16 + kvh * 4 + hl]; }
    __syncthreads();
    const float scale = 0.08838834764831845f;
    for (int pp = 0; pp < 2; ++pp) {
        const int pair = w + 8 * pp, hl = pair >> 2, qc = pair & 3, slot = kvh * 4 + hl;
        const int qq = qc * 32 + l32, qrow = n * 2048 + (nbi * 128 + qq) * r + c;
        bf16x8 Qf[8];
        { const bf16_t* qp = Q + (size_t)qrow * 6144 + g * 2048 + slot * 128 + hh * 8;
#pragma unroll
          for (int s = 0; s < 8; ++s) Qf[s] = *(const bf16x8*)(qp + s * 16); }
        f32x16 S[5];
#pragma unroll
        for (int kt = 0; kt < 5; ++kt) {
#pragma unroll
            for (int e = 0; e < 16; ++e) S[kt][e] = 0.f;
#pragma unroll
            for (int s = 0; s < 8; ++s) {
                const bf16x8 a = *(const LAS bf16x8*)(Ks + (qc * 32 + kt * 32 + l32) * KROW + (s * 16 + hh * 8) * 2);
                S[kt] = MFMA32(a, Qf[s], S[kt]);
            }
            __builtin_amdgcn_sched_barrier(0);
        }
        float m = -INFINITY;
#pragma unroll
        for (int kt = 0; kt < 5; ++kt)
#pragma unroll
            for (int reg = 0; reg < 16; ++reg) {
                const int kk = qc * 32 + kt * 32 + crow(reg, hh), dist = 128 + qq - kk;
                const bool valid = dist >= 0 && dist <= 128 && (nbi > 0 || kk >= 128);
                const int dcl = dist < 0 ? 0 : (dist > 128 ? 128 : dist);
                const float sv = valid ? S[kt][reg] * scale + BI[hl * 132 + dcl] : -INFINITY;
                S[kt][reg] = sv; m = fmaxf(m, sv);
                if ((reg & 3) == 3) __builtin_amdgcn_sched_barrier(0);
            }
        m = fmaxf(m, __shfl_xor(m, 32));
        float den = 0.f;
#pragma unroll
        for (int kt = 0; kt < 5; ++kt)
#pragma unroll
            for (int reg = 0; reg < 16; ++reg) { const float p = __expf(S[kt][reg] - m); S[kt][reg] = p; den += p; }
        den += __shfl_xor(den, 32);
        f32x16 O[4];
#pragma unroll
        for (int dt = 0; dt < 4; ++dt)
#pragma unroll
            for (int e = 0; e < 16; ++e) O[dt][e] = 0.f;
        const int q_ = (lane & 15) >> 2, p_ = lane & 3, cg16 = (lane >> 4) & 1;
#pragma unroll
        for (int kt = 0; kt < 5; ++kt)
#pragma unroll
            for (int s2 = 0; s2 < 2; ++s2) {
                u32x4 pw; pw.x = pk2(S[kt][8 * s2 + 0], S[kt][8 * s2 + 1]); pw.y = pk2(S[kt][8 * s2 + 2], S[kt][8 * s2 + 3]); pw.z = pk2(S[kt][8 * s2 + 4], S[kt][8 * s2 + 5]); pw.w = pk2(S[kt][8 * s2 + 6], S[kt][8 * s2 + 7]);
                const bf16x8 pf = __builtin_bit_cast(bf16x8, pw);
                const int R0 = qc * 32 + kt * 32 + 16 * s2 + 4 * hh;
#pragma unroll
                for (int dt = 0; dt < 4; ++dt) {
                    LAS unsigned char* ad = Vs + (R0 + q_) * VROW + (dt * 32 + 16 * cg16 + 4 * p_) * 2;
                    const s16x4 lo = __builtin_amdgcn_ds_read_tr16_b64_v4i16((LAS s16x4*)ad), hi = __builtin_amdgcn_ds_read_tr16_b64_v4i16((LAS s16x4*)(ad + 8 * VROW));
                    bf16x8 a; a[0] = lo[0]; a[1] = lo[1]; a[2] = lo[2]; a[3] = lo[3]; a[4] = hi[0]; a[5] = hi[1]; a[6] = hi[2]; a[7] = hi[3];
                    O[dt] = MFMA32(a, pf, O[dt]);
                }
                __builtin_amdgcn_sched_barrier(0);
            }
        const float inv = 1.0f / den;
        bf16_t* op = ON + ((size_t)g * RP + qrow) * 2048 + slot * 128 + 4 * hh;
#pragma unroll
        for (int dt = 0; dt < 4; ++dt)
#pragma unroll
            for (int g4 = 0; g4 < 4; ++g4) {
                u32x2 q; q.x = pk2(O[dt][4 * g4] * inv, O[dt][4 * g4 + 1] * inv); q.y = pk2(O[dt][4 * g4 + 2] * inv, O[dt][4 * g4 + 3] * inv);
                *(u32x2*)(op + dt * 32 + 8 * g4) = q;
            }
        if (hh == 0) LSE[((size_t)g * RP + qrow) * 16 + slot] = m + __logf(den);
    }
}

__device__ __forceinline__ void sample_attn(const Params& P, LAS unsigned char* lds, int si, int lbi, int wv) {
    int tid = threadIdx.x; asm volatile("" : "+v"(tid));
    const int lane = tid & 63;
    unsigned char* ws = P.ws;
    const float* PART = (const float*)(ws + O_PART); const float* RS = (const float*)(ws + O_RS); bf16_t* ON = (bf16_t*)(ws + P_ON); float* LSE = (float*)(ws + O_LSE);
    const int b = si / 48, rem = si % 48, g = rem >> 4, slot = rem & 15, kvh = slot >> 2, r = 1 << (2 * g), lbuf = 128 << (2 * g);
    const int N = lbi == 0 ? 11264 : 8192;
    const float* state = P.in[4 + g]; float* skv = P.out + (g == 0 ? OUT_SKV0 : (g == 1 ? OUT_SKV1 : OUT_SKV2));
    LAS float* qs = (LAS float*)(lds + OFF_SW + wv * 2064); LAS float* pw = qs + 128; LAS float* kn = qs + 260; LAS float* vn = qs + 388;
    const float rsb = RS[TP + b];
#pragma unroll
    for (int e = 0; e < 2; ++e) {
        const int d = lane * 2 + e;
        qs[d] = rsb * part_sum(PART, N, b, g * 2048 + slot * 128 + d);
        float kvl, vvl;
        if (lbi == 0) { kvl = rsb * part_sum(PART, N, b, 8192 + g * 1024 + kvh * 128 + d); vvl = rsb * part_sum(PART, N, b, 8192 + g * 1024 + 512 + kvh * 128 + d);
            if ((slot & 3) == 0) { float* dst = skv + ((size_t)(b * lbuf + lbuf - 1) * 2) * 512 + kvh * 128 + d; dst[0] = kvl; dst[512] = vvl; } }
        else { const float* srcp = skv + ((size_t)(b * lbuf + lbuf - 1) * 2) * 512 + kvh * 128 + d; kvl = srcp[0]; vvl = srcp[512]; }
        kn[d] = kvl; vn[d] = vvl;
    }
    LDS_WAIT();
    const float scale = 0.08838834764831845f;
    float sc[3]; float m = -INFINITY;
#pragma unroll
    for (int rd = 0; rd < 3; ++rd) {
        const int step = lane + 64 * rd; float s = -INFINITY;
        if (step <= 128) {
            float dot = 0.f;
            if (step == 0) {
#pragma unroll 4
                for (int d = 0; d < 128; ++d) dot += qs[d] * kn[d]; }
            else { const f32x4* kr = (const f32x4*)(state + ((size_t)(b * lbuf + lbuf - step * r) * 2) * 512 + kvh * 128);
#pragma unroll 4
                for (int d4 = 0; d4 < 32; ++d4) { const f32x4 kv = kr[d4]; const f32x4 qv = *(const LAS f32x4*)(qs + d4 * 4); dot += (kv.x * qv.x + kv.y * qv.y) + (kv.z * qv.z + kv.w * qv.w); } }
            s = dot * scale + P.in[20][rel_bucket(step * r) * 48 + g * 16 + slot];
        }
        sc[rd] = s; m = fmaxf(m, s);
    }
    m = wave_max(m);
    float den = 0.f;
#pragma unroll
    for (int rd = 0; rd < 3; ++rd) { const int step = lane + 64 * rd; const float p = __expf(sc[rd] - m); den += p; if (step <= 128) pw[step] = p; }
    den = wave_sum(den);
    LDS_WAIT();
    float o0 = pw[0] * vn[lane * 2], o1 = pw[0] * vn[lane * 2 + 1];
#pragma unroll 4
    for (int step = 1; step <= 128; ++step) {
        const f32x2 v = *(const f32x2*)(state + ((size_t)(b * lbuf + lbuf - step * r) * 2 + 1) * 512 + kvh * 128 + lane * 2);
        const float p = pw[step]; o0 += p * v.x; o1 += p * v.y;
    }
    const float inv = 1.0f / den;
    *(unsigned*)(ON + ((size_t)g * RP + TP + b) * 2048 + slot * 128 + lane * 2) = pk2(o0 * inv, o1 * inv);
    if (lane == 0) LSE[((size_t)g * RP + TP + b) * 16 + slot] = m + __logf(den);
    LDS_WAIT();
}

__device__ __forceinline__ void combine_phase(const Params& P, int lbi) {
    int tid = threadIdx.x; asm volatile("" : "+v"(tid));
    const int lane = tid & 63, w = __builtin_amdgcn_readfirstlane(tid >> 6);
    const int gw = blockIdx.x * 8 + w, NGW = gridDim.x * 8;
    unsigned char* ws = P.ws;
    const bf16_t* ON = (const bf16_t*)(ws + P_ON); const float* LSE = (const float*)(ws + O_LSE); const bf16_t* SG2 = (const bf16_t*)(ws + O_SG2); bf16_t* OG = (bf16_t*)(ws + O_OG);
    const float* PART = (const float*)(ws + O_PART); const float* RS = (const float*)(ws + O_RS);
    const int N = lbi == 0 ? 11264 : 8192;
    for (int row = gw; row < TP + 8; row += NGW) {
#pragma unroll
        for (int cch = 0; cch < 4; ++cch) {
            const int col = cch * 512 + lane * 8, slot = col >> 7;
            const float l0 = LSE[((size_t)0 * RP + row) * 16 + slot], l1 = LSE[((size_t)1 * RP + row) * 16 + slot], l2 = LSE[((size_t)2 * RP + row) * 16 + slot];
            const float mx = fmaxf(l0, fmaxf(l1, l2)); float w0 = __expf(l0 - mx), w1 = __expf(l1 - mx), w2 = __expf(l2 - mx);
            const float iw = 1.0f / (w0 + w1 + w2); w0 *= iw; w1 *= iw; w2 *= iw;
            const u32x4 a0 = *(const u32x4*)(ON + ((size_t)0 * RP + row) * 2048 + col), a1 = *(const u32x4*)(ON + ((size_t)1 * RP + row) * 2048 + col), a2 = *(const u32x4*)(ON + ((size_t)2 * RP + row) * 2048 + col);
            float gt[8];
            if (row < TP) { const u32x4 sv = *(const u32x4*)(SG2 + (size_t)row * 2048 + col);
                gt[0] = bflo(sv.x); gt[1] = bfhi(sv.x); gt[2] = bflo(sv.y); gt[3] = bfhi(sv.y); gt[4] = bflo(sv.z); gt[5] = bfhi(sv.z); gt[6] = bflo(sv.w); gt[7] = bfhi(sv.w); }
            else { const int b = row - TP; const float rsb = RS[row];
#pragma unroll
                for (int e = 0; e < 8; ++e) gt[e] = silu_f(rsb * part_sum(PART, N, b, 6144 + col + e)); }
            float o[8];
            o[0] = w0 * bflo(a0.x) + w1 * bflo(a1.x) + w2 * bflo(a2.x); o[1] = w0 * bfhi(a0.x) + w1 * bfhi(a1.x) + w2 * bfhi(a2.x);
            o[2] = w0 * bflo(a0.y) + w1 * bflo(a1.y) + w2 * bflo(a2.y); o[3] = w0 * bfhi(a0.y) + w1 * bfhi(a1.y) + w2 * bfhi(a2.y);
            o[4] = w0 * bflo(a0.z) + w1 * bflo(a1.z) + w2 * bflo(a2.z); o[5] = w0 * bfhi(a0.z) + w1 * bfhi(a1.z) + w2 * bfhi(a2.z);
            o[6] = w0 * bflo(a0.w) + w1 * bflo(a1.w) + w2 * bflo(a2.w); o[7] = w0 * bfhi(a0.w) + w1 * bfhi(a1.w) + w2 * bfhi(a2.w);
            u32x4 q; q.x = pk2(o[0] * gt[0], o[1] * gt[1]); q.y = pk2(o[2] * gt[2], o[3] * gt[3]); q.z = pk2(o[4] * gt[4], o[5] * gt[5]); q.w = pk2(o[6] * gt[6], o[7] * gt[7]);
            *(u32x4*)(OG + (size_t)row * 2048 + col) = q;
        }
    }
}

__global__ __launch_bounds__(512, 2) void yoco_mega(Params P) {
    extern __shared__ __attribute__((aligned(16))) unsigned char shm[];
    LAS unsigned char* lds = (LAS unsigned char*)shm;
    cg::grid_group grid = cg::this_grid();
    unsigned char* ws = P.ws;
    const int w = threadIdx.x >> 6;
    prep_phase(P, lds);
    grid.sync();
    for (int L = 0; L < 4; ++L) {
        for (int half = 0; half < 2; ++half) {
            pg8::Gemm gm; Epi E; gm.M = TP;
            E.rs = (const float*)(ws + O_RS); E.ssqp = (float*)(ws + O_SSQP); E.outp = P.out; E.o2 = (bf16_t*)(ws + O_KVB);
            if (half == 0) {
                gm.A = (const bf16_t*)(ws + O_XBF); gm.K = 4096;
                if (L < 2) { gm.Bt = (const bf16_t*)(ws + O_BT1) + (size_t)L * 8192 * 4096; gm.N = 8192; E.mode = 0; E.o0 = (bf16_t*)(ws + P_XB); E.o1 = (bf16_t*)(ws + P_SG); }
                else { gm.Bt = (const bf16_t*)(ws + (L == 2 ? O_BT3 : O_BT4)); gm.N = L == 2 ? 11264 : 8192; E.mode = 2; E.o0 = (bf16_t*)(ws + P_Q); E.o1 = (bf16_t*)(ws + O_SG2); }
            } else {
                E.mode = 1; E.o0 = (bf16_t*)(ws + O_Y); E.o1 = E.o0; gm.N = 4096;
                if (L < 2) { gm.A = (const bf16_t*)(ws + P_HG); gm.Bt = (const bf16_t*)(ws + O_BT2) + (size_t)L * 4096 * 4096; gm.K = 4096; }
                else { gm.A = (const bf16_t*)(ws + O_OG); gm.Bt = (const bf16_t*)(ws + O_BT5) + (size_t)(L - 2) * 4096 * 2048; gm.K = 2048; }
            }
            pg8::StaticOrder S; S.init(gm.M, gm.N, (int)gridDim.x, (int)blockIdx.x);
            pg8::gemm_phase<Epi, pg8::StaticOrder, false>(lds, gm, S, E, nullptr);
            skinny_phase(gm.A + (size_t)TP * gm.K, gm.Bt, gm.N, gm.K, (float*)(ws + O_PART));
            grid.sync();
            if (half == 0) {
                if (L < 2) {
                    for (int t = blockIdx.x; t < 16 + 2048; t += gridDim.x) scan_tile(P, lds, L, t);
                } else {
                    for (int wv = 0; wv < 2; ++wv) { const int si = wv * 256 + (int)blockIdx.x; if (si < 384 && w == wv && gridDim.x >= 256) sample_attn(P, lds, si, L - 2, wv); }
                    if (gridDim.x < 256 && w < 2) for (int si = blockIdx.x * 2 + w; si < 384; si += gridDim.x * 2) sample_attn(P, lds, si, L - 2, w);
                    for (int it = blockIdx.x; it < 768; it += gridDim.x) attn_item(P, lds, it);
                    grid.sync();
                    combine_phase(P, L - 2);
                }
            } else {
                post_phase(P, L);
            }
            if (!(L == 3 && half == 1)) grid.sync();
        }
    }
}

extern "C" void kernel_launch(void* const* d_in, const int* in_sizes, int n_in, void* d_out, int out_size, void* d_ws, size_t ws_size, hipStream_t stream) {
    static int grid_blocks = 0;
    if (!grid_blocks) {
        int dev = 0, cus = 0, per_cu = 0;
        hipGetDevice(&dev);
        hipDeviceGetAttribute(&cus, hipDeviceAttributeMultiprocessorCount, dev);
        hipFuncSetAttribute((const void*)yoco_mega, hipFuncAttributeMaxDynamicSharedMemorySize, LDS_BYTES);
        if (hipOccupancyMaxActiveBlocksPerMultiprocessor(&per_cu, (const void*)yoco_mega, 512, LDS_BYTES) != hipSuccess || per_cu < 1) per_cu = 1;
        (void)hipGetLastError();
        grid_blocks = cus * per_cu;
        if (ws_size < O_END) fprintf(stderr, "kernel_launch: workspace too small: %zu < %zu\n", ws_size, (size_t)O_END);
    }
    Params p{};
    for (int i = 0; i < 25; ++i) p.in[i] = (const float*)d_in[i];
    p.out = (float*)d_out; p.ws = (unsigned char*)d_ws;
    void* args[] = {&p};
    hipError_t e = hipLaunchCooperativeKernel((const void*)yoco_mega, dim3(grid_blocks), dim3(512), args, LDS_BYTES, stream);
    if (e != hipSuccess) fprintf(stderr, "cooperative launch failed: %s (grid %d)\n", hipGetErrorString(e), grid_blocks);
}
```

```cpp
#include <hip/hip_runtime.h>
#include <hip/hip_cooperative_groups.h>
#include <cstdio>
namespace cg = cooperative_groups;

namespace pg8 {
#define PG8_LAS __attribute__((address_space(3)))
typedef unsigned short bf16_t;
typedef short bf16x8 __attribute__((ext_vector_type(8)));
typedef float f32x4 __attribute__((ext_vector_type(4)));
typedef unsigned u32x4 __attribute__((ext_vector_type(4)));
constexpr int BM = 256, BK = 64, HALF = 128, HTB = HALF * BK * 2, STAGE_BYTES = 8 * HTB, NXCD = 8, WGM = 8;

__host__ __device__ __forceinline__ int lds_byte(int r, int c) { const int st = (r >> 4) * 2 + (c >> 5), rr = r & 15, cc = c & 31, ob = rr * 64 + cc * 2; return st * 1024 + (ob ^ (((ob >> 9) & 1) << 5)); }
__host__ __device__ __forceinline__ void stage_rc(int b, int& R, int& C) { const int st = b / 1024, sb = b % 1024, swz = sb ^ (((sb >> 9) & 1) << 5); R = (st >> 1) * 16 + swz / 64; C = (st & 1) * 32 + (swz % 64) / 2; }
__host__ __device__ __forceinline__ int perm32(int rho) { const int n = rho >> 4, i = rho & 15; return 8 * (i >> 2) + 4 * n + (i & 3); }

struct Unit { int pm, pn; };
struct Gemm { const bf16_t* A; const bf16_t* Bt; int M, N, K; };

struct StaticOrder {
    int nM, nN, nwg, G, c;
    __host__ __device__ void init(int M, int N, int G_, int c_) { nM = M / BM; nN = N / BM; nwg = nM * nN; G = G_; c = c_; }
    __host__ __device__ bool next(int i, Unit& u) const {
        const long L = (long)i * G + c; if (L >= nwg) return false;
        int wgid = (int)L; { const int q = nwg / NXCD, r = nwg % NXCD, xcd = wgid % NXCD, off = wgid / NXCD; wgid = (xcd < r ? xcd * (q + 1) : r * (q + 1) + (xcd - r) * q) + off; }
        const int nig = WGM * nN, gid = wgid / nig, fm = gid * WGM, gsz = (nM - fm) < WGM ? (nM - fm) : WGM;
        u.pm = fm + ((wgid % nig) % gsz); u.pn = (wgid % nig) / gsz; return true;
    }
    __device__ __forceinline__ void a_ready(const Unit&) const {}
    __device__ __forceinline__ void done(const Unit&) const {}
};
template <class Epi, class Sched, bool STAMP = false>
__device__ __forceinline__ void gemm_phase(PG8_LAS unsigned char* lds, const Gemm g, const Sched& S, const Epi& E, unsigned long long* stamps) {
    int tid = threadIdx.x; asm volatile("" : "+v"(tid));
    const int wid = __builtin_amdgcn_readfirstlane(tid >> 6), lane = tid & 63, wr = wid >> 2, wc = wid & 3, fr = lane & 15, fq = lane >> 4;
    const int K = g.K, nt = K / BK;
    int ts_lo = 0, ts_hi = 0, nts = 0; const unsigned long long rt_entry = STAMP ? (unsigned long long)wall_clock64() : 0ull;
#define PG8_STAMP() do { if (STAMP && wid == 0 && nts < 64) { const unsigned long long _c = (unsigned long long)clock64(); \
        ts_lo = (lane == nts) ? (int)(unsigned)_c : ts_lo; ts_hi = (lane == nts) ? (int)(unsigned)(_c >> 32) : ts_hi; ++nts; } } while (0)
    PG8_STAMP();
    unsigned voffA[2], voffB[2];
#pragma unroll
    for (int i = 0; i < 2; ++i) { int R, C; stage_rc(tid * 16 + i * 8192, R, C); const int Rb = Epi::PERM ? ((R & ~31) + perm32(R & 31)) : R;
        voffA[i] = (unsigned)(R * K + C) * 2u; voffB[i] = (unsigned)(Rb * K + C) * 2u; }
    const size_t kstep = (size_t)(BK * 2);
    const size_t hstep = (size_t)HALF * K * 2;
    const size_t tstep = 2 * hstep;
    const unsigned ldsw = (unsigned)wid * 1024u;
    const int aoff = lds_byte(wr * 64 + fr, fq * 8), boff = lds_byte(wc * 32 + fr, fq * 8);
#define PG8_SA(b, h) (((b) * 2 + (h)) * HTB)
#define PG8_SB(b, h) ((4 + (b) * 2 + (h)) * HTB)
#define PG8_STAGE(bufoff, gbase, voff) do { _Pragma("unroll") for (int _i = 0; _i < 2; ++_i) \
        __builtin_amdgcn_global_load_lds((const unsigned*)((const char*)(gbase) + (voff)[_i]), (PG8_LAS unsigned*)(lds + (bufoff) + ldsw + _i * 8192), 16, 0, 0); } while (0)
#define PG8_LDA(dst, b, h) do { _Pragma("unroll") for (int m = 0; m < 4; ++m) _Pragma("unroll") for (int k = 0; k < 2; ++k) dst[m][k] = *(const PG8_LAS bf16x8*)(lds + PG8_SA(b, h) + aoff + m * 2048 + k * 1024); } while (0)
#define PG8_LDB(dst, b, h) do { _Pragma("unroll") for (int n = 0; n < 2; ++n) _Pragma("unroll") for (int k = 0; k < 2; ++k) dst[n][k] = *(const PG8_LAS bf16x8*)(lds + PG8_SB(b, h) + boff + n * 2048 + k * 1024); } while (0)
#define PG8_MMA(ai, bj, At, Bt) do { __builtin_amdgcn_s_setprio(1); _Pragma("unroll") for (int m = 0; m < 4; ++m) _Pragma("unroll") for (int n = 0; n < 2; ++n) _Pragma("unroll") for (int k = 0; k < 2; ++k) \
        acc[ai][bj][m][n] = __builtin_amdgcn_mfma_f32_16x16x32_bf16(Bt[n][k], At[m][k], acc[ai][bj][m][n], 0, 0, 0); __builtin_amdgcn_s_setprio(0); } while (0)
#define PG8_WAIT_V(n) asm volatile("s_waitcnt vmcnt(" #n ")" ::: "memory")
#define PG8_WAIT_L(n) asm volatile("s_waitcnt lgkmcnt(" #n ")" ::: "memory")
#define PG8_BAR __builtin_amdgcn_s_barrier()
#define PG8_SCHED __builtin_amdgcn_sched_barrier(0)
    Unit cur, nxt; int ui = 0;
    if (!S.next(0, cur)) return;
    f32x4 acc[2][2][4][2];
#pragma unroll
    for (int a = 0; a < 2; ++a)
#pragma unroll
        for (int b = 0; b < 2; ++b)
#pragma unroll
            for (int m = 0; m < 4; ++m)
#pragma unroll
                for (int n = 0; n < 2; ++n) acc[a][b][m][n] = (f32x4){0.f, 0.f, 0.f, 0.f};
    bf16x8 At[4][2], B0[2][2], B1[2][2];
    const char* cA = (const char*)g.A + (size_t)cur.pm * tstep; const char* cB = (const char*)g.Bt + (size_t)cur.pn * tstep;
    S.a_ready(cur);
    PG8_STAGE(PG8_SB(0, 0), cB, voffB); PG8_STAGE(PG8_SA(0, 0), cA, voffA); PG8_STAGE(PG8_SB(0, 1), cB + hstep, voffB); PG8_STAGE(PG8_SA(0, 1), cA + hstep, voffA);
    if (wr == 1) PG8_BAR;
    PG8_WAIT_V(4); PG8_BAR;
    PG8_STAGE(PG8_SB(1, 0), cB + kstep, voffB); PG8_STAGE(PG8_SA(1, 0), cA + kstep, voffA); PG8_STAGE(PG8_SB(1, 1), cB + hstep + kstep, voffB);
    PG8_WAIT_V(6); PG8_BAR;
    PG8_STAMP();
    for (;;) {
        const bool has_next = S.next(ui + 1, nxt);
        const char* nA = has_next ? (const char*)g.A + (size_t)nxt.pm * tstep : cA; const char* nB = has_next ? (const char*)g.Bt + (size_t)nxt.pn * tstep : cB;
        for (int t = 0; t < nt; t += 2) {
            const bool last = (t == nt - 2);
            const char* a1 = cA + (size_t)(t + 1) * kstep;
            const char* a2 = last ? nA : cA + (size_t)(t + 2) * kstep; const char* b2 = last ? nB : cB + (size_t)(t + 2) * kstep;
            const char* a3 = a2 + kstep; const char* b3 = b2 + kstep;
            if (last && has_next) S.a_ready(nxt);
            PG8_LDB(B0, 0, 0); PG8_SCHED; PG8_LDA(At, 0, 0); PG8_STAGE(PG8_SA(1, 1), a1 + hstep, voffA);
            PG8_WAIT_L(8); PG8_BAR; PG8_WAIT_L(0); PG8_MMA(0, 0, At, B0); PG8_BAR; PG8_SCHED;
            PG8_LDB(B1, 0, 1); PG8_STAGE(PG8_SB(0, 0), b2, voffB);
            PG8_BAR; PG8_WAIT_L(0); PG8_MMA(0, 1, At, B1); PG8_BAR;
            PG8_LDA(At, 0, 1); PG8_STAGE(PG8_SA(0, 0), a2, voffA);
            PG8_BAR; PG8_WAIT_L(0); PG8_MMA(1, 0, At, B0); PG8_BAR; PG8_SCHED;
            PG8_STAGE(PG8_SB(0, 1), b2 + hstep, voffB);
            PG8_WAIT_V(6); PG8_BAR; PG8_MMA(1, 1, At, B1); PG8_BAR;
            PG8_LDB(B0, 1, 0); PG8_SCHED; PG8_LDA(At, 1, 0); PG8_STAGE(PG8_SA(0, 1), a2 + hstep, voffA);
            PG8_WAIT_L(8); PG8_BAR; PG8_WAIT_L(0); PG8_MMA(0, 0, At, B0); PG8_BAR; PG8_SCHED;
            PG8_LDB(B1, 1, 1); PG8_STAGE(PG8_SB(1, 0), b3, voffB);
            PG8_BAR; PG8_WAIT_L(0); PG8_MMA(0, 1, At, B1); PG8_BAR;
            PG8_LDA(At, 1, 1); PG8_STAGE(PG8_SA(1, 0), a3, voffA);
            PG8_BAR; PG8_WAIT_L(0); PG8_MMA(1, 0, At, B0); PG8_BAR; PG8_SCHED;
            PG8_STAGE(PG8_SB(1, 1), b3 + hstep, voffB);
            PG8_WAIT_V(6); PG8_BAR; PG8_MMA(1, 1, At, B1); PG8_BAR;
        }
        PG8_STAMP();
        if constexpr (!Epi::AFTER_DRAIN) { E(acc, cur, wr, wc, fr, fq); S.done(cur); }
        PG8_STAMP();
        if (!has_next) break;
#pragma unroll
        for (int a = 0; a < 2; ++a)
#pragma unroll
            for (int b = 0; b < 2; ++b)
#pragma unroll
                for (int m = 0; m < 4; ++m)
#pragma unroll
                    for (int n = 0; n < 2; ++n) acc[a][b][m][n] = (f32x4){0.f, 0.f, 0.f, 0.f};
        cur = nxt; cA = nA; cB = nB; ++ui;
    }
    PG8_WAIT_V(0);
    if (wr == 0) PG8_BAR;
    PG8_BAR;
    if constexpr (Epi::AFTER_DRAIN) { E.fused(acc, cur, wr, wc, fr, fq, lds, wid, lane); S.done(cur); }
    PG8_STAMP();
    if (STAMP && wid == 0) { stamps[lane] = lane < nts ? (((unsigned long long)(unsigned)ts_hi << 32) | (unsigned)ts_lo) : 0ull;
        if (lane == 62) stamps[62] = rt_entry; if (lane == 63) stamps[63] = (unsigned long long)wall_clock64(); }
#undef PG8_STAMP
#undef PG8_SA
#undef PG8_SB
#undef PG8_STAGE
#undef PG8_LDA
#undef PG8_LDB
#undef PG8_MMA
#undef PG8_WAIT_V
#undef PG8_WAIT_L
#undef PG8_BAR
#undef PG8_SCHED
}}

using pg8::bf16_t; using pg8::bf16x8; using pg8::f32x4; using pg8::u32x4;
typedef short s16x4 __attribute__((ext_vector_type(4)));
typedef float f32x16 __attribute__((ext_vector_type(16)));
typedef float f32x2 __attribute__((ext_vector_type(2)));
typedef unsigned u32x2 __attribute__((ext_vector_type(2)));
typedef unsigned long long u64;
#define LAS __attribute__((address_space(3)))
#define LDS_WAIT() asm volatile("s_waitcnt lgkmcnt(0)" ::: "memory")
#define XB_TMO      128
#define XB_XCNT(j)  (256  + 64 * (j))
#define XB_XSUB(j)  (1280 + 64 * (j))
#define XB_XGEN(j)  (2304 + 64 * (j))
#define XB_TOP      3328
#define XB_TOPGEN   3392
#define XCD_BAR_WORDS 3456
#define XB_SPIN_CAP (1u << 18)

__device__ __forceinline__ unsigned xb_ld(unsigned* p)              { return __hip_atomic_load(p, __ATOMIC_RELAXED, __HIP_MEMORY_SCOPE_AGENT); }
__device__ __forceinline__ unsigned xb_add(unsigned* p, unsigned v) { return __hip_atomic_fetch_add(p, v, __ATOMIC_RELAXED, __HIP_MEMORY_SCOPE_AGENT); }
__device__ __forceinline__ unsigned xb_xcc_id() { return (unsigned)__builtin_amdgcn_s_getreg((3 << 11) | 20) & 0xFu; }
#define XB_SPIN(cond, bar) do { unsigned _sp = 0; while (cond) { __builtin_amdgcn_s_sleep(1); \
    if ((++_sp & 255u) == 0u) { if (xb_ld(&(bar)[XB_TMO])) break; if (_sp > XB_SPIN_CAP) { atomicAdd(&(bar)[XB_TMO], 1u); break; } } } } while (0)

struct XcdBarrier {
    unsigned* bar; unsigned x;
    volatile LAS unsigned* st;
};

__device__ __forceinline__ XcdBarrier xcd_barrier_post(unsigned* bar, volatile LAS unsigned* st) {
    XcdBarrier b; b.bar = bar; b.x = xb_xcc_id(); b.st = st;
    if (threadIdx.x == 0) (void)xb_add(&bar[XB_XCNT(b.x)], 1u);
    return b;
}
__device__ __forceinline__ void xcd_barrier_complete(unsigned* bar, unsigned x, unsigned& nloc, unsigned& nx) {
    const unsigned G = gridDim.x * gridDim.y * gridDim.z;
    unsigned sum, cnt, mine, sp = 0u;
    for (;;) {
        sum = 0u; cnt = 0u; mine = 0u;
#pragma unroll
        for (unsigned j = 0; j < 16; ++j) { const unsigned c = xb_ld(&bar[XB_XCNT(j)]); sum += c; cnt += (c > 0u) ? 1u : 0u; mine = (j == x) ? c : mine; }
        if (sum == G) break;
        __builtin_amdgcn_s_sleep(1);
        if ((++sp & 255u) == 0u) { if (xb_ld(&bar[XB_TMO])) break; if (sp > XB_SPIN_CAP) { atomicAdd(&bar[XB_TMO], 1u); break; } }
    }
    nloc = mine > 0u ? mine : 1u; nx = cnt > 0u ? cnt : 1u;
}

__device__ __forceinline__ void xcd_barrier(const XcdBarrier& b) {
    asm volatile("s_waitcnt vmcnt(0)" ::: "memory");
    __syncthreads();
    if (threadIdx.x == 0) {
        unsigned* bar = b.bar;
        __builtin_amdgcn_s_waitcnt(0);
        unsigned nloc = b.st[0], nx = b.st[1];
        if (nloc == 0u) { xcd_barrier_complete(bar, b.x, nloc, nx); b.st[0] = nloc; b.st[1] = nx; }
        const unsigned old = xb_add(&bar[XB_XSUB(b.x)], 1u);
        const unsigned gen = old / nloc;
        if (old + 1u == (gen + 1u) * nloc) {
            __builtin_amdgcn_fence(__ATOMIC_RELEASE, "agent");
            asm volatile("s_waitcnt vmcnt(0)" ::: "memory");
            const unsigned og = xb_add(&bar[XB_TOP], 1u);
            const unsigned tg = og / nx;
            if (og + 1u == (tg + 1u) * nx) xb_add(&bar[XB_TOPGEN], 1u);
            else XB_SPIN(xb_ld(&bar[XB_TOPGEN]) == tg, bar);
            __builtin_amdgcn_fence(__ATOMIC_ACQUIRE, "agent");
            xb_add(&bar[XB_XGEN(b.x)], 1u);
            asm volatile("s_waitcnt vmcnt(0)" ::: "memory");
        } else {
            XB_SPIN(xb_ld(&bar[XB_XGEN(b.x)]) == gen, bar);
            __builtin_amdgcn_fence(__ATOMIC_ACQUIRE, "agent");
            asm volatile("s_waitcnt vmcnt(0)" ::: "memory");
        }
    }
    __syncthreads();
}


constexpr int DM = 4096, SEQ = 2048, TP = 8192, RP = 8448;
constexpr size_t MiB = (size_t)1 << 20;
constexpr size_t O_BT1 = 0, O_BT2 = O_BT1 + 128 * MiB, O_BT3 = O_BT2 + 64 * MiB, O_BT4 = O_BT3 + 88 * MiB, O_BT5 = O_BT4 + 64 * MiB, O_WG = O_BT5 + 32 * MiB,
                 O_XBF = O_WG + 8 * MiB, O_POOL = O_XBF + 66 * MiB, O_Y = O_POOL + 198 * MiB, O_SG2 = O_Y + 66 * MiB, O_OG = O_SG2 + 33 * MiB, O_KVB = O_OG + 33 * MiB,
                 O_RS = O_KVB + 48 * MiB, O_SSQP = O_RS + 1 * MiB, O_LSE = O_SSQP + 2 * MiB, O_GRAN = O_LSE + 2 * MiB, O_PART = O_GRAN + 8 * MiB, O_BAR = O_PART + 3 * MiB, O_END = O_BAR + 1 * MiB;
constexpr size_t P_XB = O_POOL, P_SG = O_POOL + 66 * MiB, P_HG = O_POOL + 132 * MiB, P_Q = O_POOL, P_ON = O_POOL + 99 * MiB;
constexpr size_t OUT_YP = 0, OUT_YS = 33554432, OUT_PCONV = OUT_YS + 32768, OUT_PH = OUT_PCONV + 98304, OUT_PKV0 = OUT_PH + 32768, OUT_PKV1 = OUT_PKV0 + 524288, OUT_PKV2 = OUT_PKV1 + 2097152,
                 OUT_SCONV = OUT_PKV2 + 8388608, OUT_SH = OUT_SCONV + 196608, OUT_SKV0 = OUT_SH + 65536, OUT_SKV1 = OUT_SKV0 + 1048576, OUT_SKV2 = OUT_SKV1 + 4194304;
constexpr int LDS_BYTES = 159744, OFF_XB = 157824;
constexpr float EPSN = 1e-6f;

struct Params { const float* in[25]; float* out; unsigned char* ws; };
typedef const Params __attribute__((address_space(4))) * KParams;
__device__ __forceinline__ KParams kparams() { KParams p = (KParams)__builtin_amdgcn_kernarg_segment_ptr(); asm volatile("" : "+s"(p)); return p; }
#define PLOCAL const KParams Pk = kparams(); (void)P;


__device__ __forceinline__ unsigned pk2(float a, float b) { typedef __bf16 bf2 __attribute__((ext_vector_type(2))); bf2 v; v[0] = (__bf16)a; v[1] = (__bf16)b; return __builtin_bit_cast(unsigned, v); }
__device__ __forceinline__ float bflo(unsigned u) { return __uint_as_float(u << 16); }
__device__ __forceinline__ float bfhi(unsigned u) { return __uint_as_float(u & 0xffff0000u); }
__device__ __forceinline__ float bf2f(bf16_t h) { return __uint_as_float(((unsigned)h) << 16); }
__device__ __forceinline__ float silu_f(float v) { return v * __builtin_amdgcn_rcpf(1.0f + __expf(-v)); }
__device__ __forceinline__ float sigm_f(float v) { return __builtin_amdgcn_rcpf(1.0f + __expf(-v)); }
__device__ __forceinline__ float wave_sum(float v) {
#pragma unroll
    for (int o = 1; o < 64; o <<= 1) v += __shfl_xor(v, o);
    return v;
}
__device__ __forceinline__ float wave_max(float v) {
#pragma unroll
    for (int o = 1; o < 64; o <<= 1) v = fmaxf(v, __shfl_xor(v, o));
    return v;
}
__device__ __forceinline__ int crow(int reg, int h) { return (reg & 3) + 8 * (reg >> 2) + 4 * h; }
__device__ __forceinline__ int rel_bucket(int dd) {
    if (dd < 16) return dd;
    const float d = (float)dd;
    int large = 16 + (int)(logf(d * (1.0f / 16.0f)) / logf(128.0f) * 16.0f);
    return large < 31 ? large : 31;
}
#define MFMA32(a, b, c) __builtin_amdgcn_mfma_f32_32x32x16_bf16((a), (b), (c), 0, 0, 0)

struct Epi {
    static constexpr bool PERM = true, AFTER_DRAIN = false;
    int mode;
    const float* rs; bf16_t* o0; bf16_t* o1; bf16_t* o2; float* ssqp; float* outp;
    __device__ __forceinline__ void operator()(const f32x4 (&acc)[2][2][4][2], const pg8::Unit& u, int wr, int wc, int fr, int fq) const {
        const int row0 = u.pm * 256 + wr * 64 + fr, colt = u.pn * 256, cw = wc * 32 + 8 * fq;
        if (mode == 1) {
#pragma unroll
            for (int ai = 0; ai < 2; ++ai)
#pragma unroll
                for (int m = 0; m < 4; ++m) {
                    const int row = row0 + ai * 128 + m * 16; float ss = 0.f;
#pragma unroll
                    for (int bj = 0; bj < 2; ++bj) {
                        const f32x4 v0 = acc[ai][bj][m][0], v1 = acc[ai][bj][m][1];
                        ss += (v0[0] * v0[0] + v0[1] * v0[1]) + (v0[2] * v0[2] + v0[3] * v0[3]) + (v1[0] * v1[0] + v1[1] * v1[1]) + (v1[2] * v1[2] + v1[3] * v1[3]);
                        u32x4 w; w.x = pk2(v0[0], v0[1]); w.y = pk2(v0[2], v0[3]); w.z = pk2(v1[0], v1[1]); w.w = pk2(v1[2], v1[3]);
                        *(u32x4*)(o0 + (size_t)row * 4096 + colt + bj * 128 + cw) = w;
                    }
                    ss += __shfl_xor(ss, 16); ss += __shfl_xor(ss, 32);
                    if (fq == 0) ssqp[(size_t)row * 64 + u.pn * 4 + wc] = ss;
                }
            return;
        }
        bf16_t* dst; int ld, col; bool act = false, kv = false;
        if (mode == 0) { ld = 4096; if (colt < 4096) { dst = o0; col = colt; } else { dst = o1; col = colt - 4096; act = true; } }
        else { if (colt < 6144) { dst = o0; ld = 6144; col = colt; } else if (colt < 8192) { dst = o1; ld = 2048; col = colt - 6144; act = true; } else { dst = o2; ld = 3072; col = colt - 8192; kv = true; } }
#pragma unroll
        for (int ai = 0; ai < 2; ++ai)
#pragma unroll
            for (int m = 0; m < 4; ++m) {
                const int row = row0 + ai * 128 + m * 16; const float r = rs[row];
#pragma unroll
                for (int bj = 0; bj < 2; ++bj) {
                    f32x4 v0 = acc[ai][bj][m][0] * r, v1 = acc[ai][bj][m][1] * r;
                    if (act) {
#pragma unroll
                        for (int j = 0; j < 4; ++j) { v0[j] = silu_f(v0[j]); v1[j] = silu_f(v1[j]); }
                    }
                    u32x4 w; w.x = pk2(v0[0], v0[1]); w.y = pk2(v0[2], v0[3]); w.z = pk2(v1[0], v1[1]); w.w = pk2(v1[2], v1[3]);
                    const int cc = col + bj * 128 + cw;
                    *(u32x4*)(dst + (size_t)row * ld + cc) = w;
                    if (kv) {
                        const int g = cc >> 10, rem = cc & 1023, keep = 128 << (2 * g), n = row >> 11, t = row & 2047;
                        if (t >= 2048 - keep) {
                            const size_t ob = (g == 0 ? OUT_PKV0 : (g == 1 ? OUT_PKV1 : OUT_PKV2)) + ((size_t)(n * keep + (t - (2048 - keep))) * 1024 + rem);
                            *(f32x4*)(outp + ob) = v0; *(f32x4*)(outp + ob + 4) = v1;
                        }
                    }
                }
            }
    }
};

__device__ __forceinline__ void transpose_item(const float* W, int K, int N, bf16_t* WT, const float* gain, LAS float* scr, int item, int lane) {
    const int nblk = N / 32, kb = item / nblk, nb = item % nblk, k0 = 64 * kb, n0 = 32 * nb;
#pragma unroll 8
    for (int i = 0; i < 32; ++i) { const int kk = 2 * i + (lane >> 5); float v = W[(size_t)(k0 + kk) * N + n0 + (lane & 31)]; if (gain) v *= gain[k0 + kk]; scr[kk * 33 + (lane & 31)] = v; }
    LDS_WAIT();
    const int c = lane & 7;
#pragma unroll
    for (int j = 0; j < 4; ++j) { const int n = (lane >> 3) + 8 * j; const LAS float* s = scr + (8 * c) * 33 + n;
        u32x4 o; o.x = pk2(s[0 * 33], s[1 * 33]); o.y = pk2(s[2 * 33], s[3 * 33]); o.z = pk2(s[4 * 33], s[5 * 33]); o.w = pk2(s[6 * 33], s[7 * 33]);
        *(u32x4*)(WT + (size_t)(n0 + n) * K + k0 + 8 * c) = o; }
    LDS_WAIT();
}

__device__ __forceinline__ void prep_phase(const Params& P, LAS unsigned char* lds) {
    const KParams Pk = kparams();
    int tid = threadIdx.x; asm volatile("" : "+v"(tid));
    const int lane = tid & 63, w = __builtin_amdgcn_readfirstlane(tid >> 6);
    const int gw = blockIdx.x * 8 + w, NGW = gridDim.x * 8;
    unsigned char* ws = Pk->ws;
    { u64* gr = (u64*)(ws + O_GRAN); const size_t n = (8 * MiB) / 8; for (size_t i = (size_t)blockIdx.x * 512 + tid; i < n; i += (size_t)gridDim.x * 512) gr[i] = 0ull; }
    { bf16_t* XBF = (bf16_t*)(ws + O_XBF); float* RS = (float*)(ws + O_RS);
      for (int row = gw; row < TP + 8; row += NGW) {
          const float* xr = row < TP ? Pk->in[0] + (size_t)row * DM : Pk->in[1] + (size_t)(row - TP) * DM;
          const f32x4* x4 = (const f32x4*)xr + lane; f32x4 v[16]; float s = 0.f;
#pragma unroll
          for (int j = 0; j < 16; ++j) { v[j] = x4[64 * j]; s += (v[j].x * v[j].x + v[j].y * v[j].y) + (v[j].z * v[j].z + v[j].w * v[j].w); }
          s = wave_sum(s);
          u32x2* o = (u32x2*)(XBF + (size_t)row * DM) + lane;
#pragma unroll
          for (int j = 0; j < 16; ++j) { u32x2 q; q.x = pk2(v[j].x, v[j].y); q.y = pk2(v[j].z, v[j].w); o[64 * j] = q; }
          if (lane == 0) RS[row] = rsqrtf(s * (1.0f / DM) + EPSN);
      } }
    for (int g = 0; g < 3; ++g) {
        const int lb = 128 << (2 * g); const size_t per = (size_t)(lb - 1) * 256, tot = 8 * per;
        const f32x4* src = (const f32x4*)Pk->in[4 + g]; f32x4* dst = (f32x4*)(Pk->out + (g == 0 ? OUT_SKV0 : (g == 1 ? OUT_SKV1 : OUT_SKV2)));
        for (size_t i = (size_t)blockIdx.x * 512 + tid; i < tot; i += (size_t)gridDim.x * 512) { const size_t b = i / per, o = i - b * per; dst[b * (size_t)lb * 256 + o] = src[b * (size_t)lb * 256 + 256 + o]; }
    }
    LAS float* scr = (LAS float*)(lds + w * 8448);
    constexpr int I_AIN = 64 * 256, I_AOUT = 64 * 128, I_KV = 64 * 96, I_BOUT = 32 * 128, I_G = 32;
    constexpr int NITEMS = 2 * I_AIN + 2 * I_AOUT + I_AIN + I_KV + I_AIN + 2 * I_BOUT + 64 * I_G;
    for (int it = gw; it < NITEMS; it += NGW) {
        int r = it;
        if (r < 2 * I_AIN) { const int l = r / I_AIN; transpose_item(Pk->in[8] + (size_t)l * 4096 * 8192, 4096, 8192, (bf16_t*)(ws + O_BT1) + (size_t)l * 8192 * 4096, Pk->in[7] + l * 4096, scr, r % I_AIN, lane); continue; } r -= 2 * I_AIN;
        if (r < 2 * I_AOUT) { const int l = r / I_AOUT; transpose_item(Pk->in[16] + (size_t)l * 4096 * 4096, 4096, 4096, (bf16_t*)(ws + O_BT2) + (size_t)l * 4096 * 4096, nullptr, scr, r % I_AOUT, lane); continue; } r -= 2 * I_AOUT;
        if (r < I_AIN) { transpose_item(Pk->in[22], 4096, 8192, (bf16_t*)(ws + O_BT3), Pk->in[21], scr, r, lane); continue; } r -= I_AIN;
        if (r < I_KV) { transpose_item(Pk->in[19], 4096, 3072, (bf16_t*)(ws + O_BT3) + (size_t)8192 * 4096, Pk->in[18], scr, r, lane); continue; } r -= I_KV;
        if (r < I_AIN) { transpose_item(Pk->in[22] + (size_t)4096 * 8192, 4096, 8192, (bf16_t*)(ws + O_BT4), Pk->in[21] + 4096, scr, r, lane); continue; } r -= I_AIN;
        if (r < 2 * I_BOUT) { const int l = r / I_BOUT; transpose_item(Pk->in[23] + (size_t)l * 2048 * 4096, 2048, 4096, (bf16_t*)(ws + O_BT5) + (size_t)l * 4096 * 2048, nullptr, scr, r % I_BOUT, lane); continue; } r -= 2 * I_BOUT;
        { const int mat = r / I_G, gate = mat & 1, lh = mat >> 1;
          transpose_item((gate ? Pk->in[13] : Pk->in[11]) + (size_t)lh * 65536, 256, 256, (bf16_t*)(ws + O_WG) + (size_t)(lh * 2 + gate) * 65536, nullptr, scr, r % I_G, lane); }
    }
}

__device__ __forceinline__ void skinny_phase(const bf16_t* A, const bf16_t* Bt, int N, int K, float* part) {
    int tid = threadIdx.x; asm volatile("" : "+v"(tid));
    const int lane = tid & 63, w = __builtin_amdgcn_readfirstlane(tid >> 6), fr = lane & 15, fq = lane >> 4;
    const int gw = blockIdx.x * 8 + w, NGW = gridDim.x * 8;
    const int nitems = (N / 16) * 8, kspan = K / 8;
    for (int it = gw; it < nitems; it += NGW) {
        const int grp = it >> 3, ks = it & 7, n0 = grp * 16, k0 = ks * kspan;
        const bf16_t* ap = A + (size_t)(fr & 7) * K + k0 + fq * 8; const bf16_t* bp = Bt + (size_t)(n0 + fr) * K + k0 + fq * 8;
        f32x4 acc = {0.f, 0.f, 0.f, 0.f};
#pragma unroll 4
        for (int kk = 0; kk < kspan; kk += 32) {
            bf16x8 a = *(const bf16x8*)(ap + kk); const bf16x8 b = *(const bf16x8*)(bp + kk);
            if (fr >= 8) a = (bf16x8){0, 0, 0, 0, 0, 0, 0, 0};
            acc = __builtin_amdgcn_mfma_f32_16x16x32_bf16(a, b, acc, 0, 0, 0);
        }
        if (fq < 2) {
#pragma unroll
            for (int i = 0; i < 4; ++i) part[(size_t)(ks * 8 + fq * 4 + i) * N + n0 + fr] = acc[i];
        }
    }
}
__device__ __forceinline__ float part_sum(const float* part, int N, int b, int col) {
    float s = 0.f;
#pragma unroll
    for (int ks = 0; ks < 8; ++ks) s += part[(size_t)(ks * 8 + b) * N + col];
    return s;
}

constexpr int SROW = 528;
__device__ __forceinline__ void scan_tile(const Params& P, LAS unsigned char* lds, int l, int tile) {
    const KParams Pk = kparams();
    int tid = threadIdx.x; asm volatile("" : "+v"(tid));
    const int lane = tid & 63, w = __builtin_amdgcn_readfirstlane(tid >> 6), hh = lane >> 5, l32 = lane & 31;
    LAS unsigned char* RAW = lds;
    LAS unsigned char* AT = lds + 35840;
    unsigned char* ws = Pk->ws;
    const bf16_t* XB = (const bf16_t*)(ws + P_XB); const bf16_t* SG = (const bf16_t*)(ws + P_SG); bf16_t* HG = (bf16_t*)(ws + P_HG);
    const float* PART = (const float*)(ws + O_PART); const float* RS = (const float*)(ws + O_RS);
    const bool is_s = tile < 16;
    int head, n = 0, sp = 0;
    if (is_s) head = tile; else { const int idx = tile - 16; sp = idx >> 6; n = (idx >> 4) & 3; head = idx & 15; }
    const int r0 = n * 2048 + sp * 64, gc0 = head * 256;
    const float* cwp = Pk->in[9] + (size_t)l * 4 * 4096; const float* cbp = Pk->in[10] + (size_t)l * 4096;
    __syncthreads();
    if (is_s) {
        const int b = tid >> 6, ch = (tid & 63) * 4; const float rsb = RS[TP + b];
        float xc[4][4];
#pragma unroll
        for (int e = 0; e < 4; ++e) {
            const int gc = gc0 + ch + e;
#pragma unroll
            for (int k = 0; k < 3; ++k) xc[k][e] = Pk->in[2][((size_t)(l * 8 + b) * 3 + k) * 4096 + gc];
            xc[3][e] = rsb * part_sum(PART, 8192, b, gc);
        }
        float o[4];
#pragma unroll
        for (int e = 0; e < 4; ++e) {
            const int gc = gc0 + ch + e; float v = cbp[gc];
#pragma unroll
            for (int k = 0; k < 4; ++k) v += xc[k][e] * cwp[k * 4096 + gc];
            o[e] = v;
#pragma unroll
            for (int k = 0; k < 3; ++k) Pk->out[OUT_SCONV + ((size_t)(l * 8 + b) * 3 + k) * 4096 + gc] = xc[k + 1][e];
        }
        u32x2 q; q.x = pk2(o[0], o[1]); q.y = pk2(o[2], o[3]);
        *(LAS u32x2*)(AT + b * SROW + ch * 2) = q;
    } else {
#pragma unroll
        for (int j = 0; j < 5; ++j) {
            const int id = tid + 512 * j, i = id >> 5, c8 = id & 31;
            if (i < 67) {
                u32x4 v = {0u, 0u, 0u, 0u};
                if (!(sp == 0 && i < 3)) v = *(const u32x4*)(XB + (size_t)(r0 - 3 + i) * 4096 + gc0 + c8 * 8);
                *(LAS u32x4*)(RAW + i * SROW + c8 * 16) = v;
            }
        }
        __syncthreads();
        const int c8 = tid & 31; float wk[4][8], bb[8];
#pragma unroll
        for (int e = 0; e < 8; ++e) { bb[e] = cbp[gc0 + c8 * 8 + e];
#pragma unroll
            for (int k = 0; k < 4; ++k) wk[k][e] = cwp[k * 4096 + gc0 + c8 * 8 + e]; }
#pragma unroll
        for (int j = 0; j < 4; ++j) {
            const int i = (tid >> 5) + 16 * j;
            float o[8];
#pragma unroll
            for (int e = 0; e < 8; ++e) o[e] = bb[e];
            u32x4 last;
#pragma unroll
            for (int k = 0; k < 4; ++k) {
                const u32x4 v = *(const LAS u32x4*)(RAW + (i + k) * SROW + c8 * 16); last = v;
                o[0] += bflo(v.x) * wk[k][0]; o[1] += bfhi(v.x) * wk[k][1]; o[2] += bflo(v.y) * wk[k][2]; o[3] += bfhi(v.y) * wk[k][3];
                o[4] += bflo(v.z) * wk[k][4]; o[5] += bfhi(v.z) * wk[k][5]; o[6] += bflo(v.w) * wk[k][6]; o[7] += bfhi(v.w) * wk[k][7];
            }
            u32x4 q; q.x = pk2(o[0], o[1]); q.y = pk2(o[2], o[3]); q.z = pk2(o[4], o[5]); q.w = pk2(o[6], o[7]);
            *(LAS u32x4*)(AT + i * SROW + c8 * 16) = q;
            if (sp == 31 && i >= 61) {
                float* d = Pk->out + OUT_PCONV + ((size_t)(l * 4 + n) * 3 + (i - 61)) * 4096 + gc0 + c8 * 8;
                f32x4 a = {bflo(last.x), bfhi(last.x), bflo(last.y), bfhi(last.y)}, b = {bflo(last.z), bfhi(last.z), bflo(last.w), bfhi(last.w)};
                *(f32x4*)d = a; *(f32x4*)(d + 4) = b;
            }
        }
    }
    __syncthreads();
    f32x16 aR[2], aI[2];
#pragma unroll
    for (int mt = 0; mt < 2; ++mt)
#pragma unroll
        for (int e = 0; e < 16; ++e) { aR[mt][e] = 0.f; aI[mt][e] = 0.f; }
    {
        const bf16_t* wrp = (const bf16_t*)(ws + O_WG) + (size_t)((l * 16 + head) * 2) * 65536 + (size_t)(w * 32 + l32) * 256 + hh * 8;
        const bf16_t* wip = wrp + 65536;
#pragma unroll 4
        for (int ks = 0; ks < 16; ++ks) {
            const bf16x8 bR = *(const bf16x8*)(wrp + ks * 16), bI = *(const bf16x8*)(wip + ks * 16);
#pragma unroll
            for (int mt = 0; mt < 2; ++mt) {
                const bf16x8 a = *(const LAS bf16x8*)(AT + (mt * 32 + l32) * SROW + (ks * 16 + hh * 8) * 2);
                aR[mt] = MFMA32(a, bR, aR[mt]); aI[mt] = MFMA32(a, bI, aI[mt]);
            }
        }
    }
    const int ch = w * 32 + l32, gch = gc0 + ch;
    const float bga = Pk->in[12][(size_t)l * 4096 + gch], bgx = Pk->in[14][(size_t)l * 4096 + gch];
    const float lamc = -8.0f * log1pf(expf(-Pk->in[15][(size_t)l * 4096 + gch]));
#pragma unroll
    for (int mt = 0; mt < 2; ++mt)
#pragma unroll
        for (int reg = 0; reg < 16; ++reg) {
            const int row = mt * 32 + crow(reg, hh);
            const float r = sigm_f(aR[mt][reg] + bga), ig = sigm_f(aI[mt][reg] + bgx);
            const float la = lamc * r, a = __expf(la), t2 = 2.0f * la;
            const float em = t2 > -0.05f ? -t2 * (1.0f + t2 * (0.5f + t2 * (0.16666667f + t2 * 0.041666668f))) : 1.0f - __expf(t2);
            const float xf = bf2f(*(const LAS bf16_t*)(AT + row * SROW + ch * 2));
            aR[mt][reg] = a; aI[mt][reg] = __builtin_amdgcn_sqrtf(em) * ig * xf;
            if ((reg & 3) == 3) __builtin_amdgcn_sched_barrier(0);
        }
    if (is_s) {
#pragma unroll
        for (int j = 0; j < 4; ++j) {
            const int b = j + 4 * hh;
            const float h0 = Pk->in[3][(size_t)(l * 8 + b) * 4096 + gch];
            const float h = aR[0][j] * h0 + aI[0][j];
            Pk->out[OUT_SH + (size_t)(l * 8 + b) * 4096 + gch] = h;
            const float sg = silu_f(RS[TP + b] * part_sum(PART, 8192, b, 4096 + gch));
            HG[(size_t)(TP + b) * 4096 + gch] = (bf16_t)(pk2(h * sg, 0.f) & 0xffffu);
        }
        return;
    }
    float Pp = 1.f, Cc = 0.f;
#pragma unroll
    for (int mt = 0; mt < 2; ++mt)
#pragma unroll
        for (int g = 0; g < 4; ++g) {
            float A = aR[mt][4 * g], H = aI[mt][4 * g];
#pragma unroll
            for (int j = 1; j < 4; ++j) { const float a = aR[mt][4 * g + j], b = aI[mt][4 * g + j]; H = a * H + b; A = A * a; aR[mt][4 * g + j] = A; aI[mt][4 * g + j] = H; }
            const float pA = __shfl_xor(A, 32), pH = __shfl_xor(H, 32);
            const float s0a = hh ? pA : A, s0b = hh ? pH : H, s1a = hh ? A : pA, s1b = hh ? H : pH;
            const float P1 = Pp * s0a, C1 = s0a * Cc + s0b;
            const float Pm = hh ? P1 : Pp, Cm = hh ? C1 : Cc;
#pragma unroll
            for (int j = 0; j < 4; ++j) { aI[mt][4 * g + j] += aR[mt][4 * g + j] * Cm; aR[mt][4 * g + j] *= Pm; }
            Pp = P1 * s1a; Cc = s1a * C1 + s1b;
        }
    u64* gr = (u64*)(ws + O_GRAN) + ((((size_t)l * 4 + n) * 32 + sp) * 16 + head) * 256 + ch;
    const unsigned tag = 1u + (unsigned)l;
    float H0 = 0.f;
    if (sp > 0) {
        const u64* pg = gr - 16 * 256; u64 x = 0; unsigned spins = 0;
        for (;;) {
            x = __hip_atomic_load(pg, __ATOMIC_RELAXED, __HIP_MEMORY_SCOPE_AGENT);
            if (__all((unsigned)(x >> 32) == tag)) break;
            if (++spins > (1u << 22)) break;
            __builtin_amdgcn_s_sleep(1);
        }
        H0 = __uint_as_float((unsigned)x);
    }
    const float hend = Cc + Pp * H0;
    if (hh == 0) {
        __hip_atomic_store(gr, ((u64)tag << 32) | (u64)__float_as_uint(hend), __ATOMIC_RELAXED, __HIP_MEMORY_SCOPE_AGENT);
        if (sp == 31) Pk->out[OUT_PH + (size_t)(l * 4 + n) * 4096 + gch] = hend;
    }
    __syncthreads();
#pragma unroll
    for (int mt = 0; mt < 2; ++mt)
#pragma unroll
        for (int reg = 0; reg < 16; ++reg) {
            const int row = mt * 32 + crow(reg, hh);
            const float h = aI[mt][reg] + aR[mt][reg] * H0;
            *(LAS bf16_t*)(AT + row * SROW + ch * 2) = (bf16_t)(pk2(h, 0.f) & 0xffffu);
        }
    __syncthreads();
    {
        const int c8 = tid & 31;
#pragma unroll
        for (int j = 0; j < 4; ++j) {
            const int i = (tid >> 5) + 16 * j;
            const u32x4 hv = *(const LAS u32x4*)(AT + i * SROW + c8 * 16);
            const size_t go = (size_t)(r0 + i) * 4096 + gc0 + c8 * 8;
            const u32x4 sv = *(const u32x4*)(SG + go);
            u32x4 q; q.x = pk2(bflo(hv.x) * bflo(sv.x), bfhi(hv.x) * bfhi(sv.x)); q.y = pk2(bflo(hv.y) * bflo(sv.y), bfhi(hv.y) * bfhi(sv.y));
            q.z = pk2(bflo(hv.z) * bflo(sv.z), bfhi(hv.z) * bfhi(sv.z)); q.w = pk2(bflo(hv.w) * bflo(sv.w), bfhi(hv.w) * bfhi(sv.w));
            *(u32x4*)(HG + go) = q;
        }
    }
}

__device__ __forceinline__ void post_phase(const Params& P, int L) {
    const KParams Pk = kparams();
    int tid = threadIdx.x; asm volatile("" : "+v"(tid));
    const int lane = tid & 63, w = __builtin_amdgcn_readfirstlane(tid >> 6);
    const int gw = blockIdx.x * 8 + w, NGW = gridDim.x * 8;
    unsigned char* ws = Pk->ws;
    const float* gain = L < 2 ? Pk->in[17] + (size_t)L * 4096 : Pk->in[24] + (size_t)(L - 2) * 4096;
    const bf16_t* Y = (const bf16_t*)(ws + O_Y); const float* SSQP = (const float*)(ws + O_SSQP); const float* PART = (const float*)(ws + O_PART);
    bf16_t* XBF = (bf16_t*)(ws + O_XBF); float* RS = (float*)(ws + O_RS);
    for (int row = gw; row < TP + 8; row += NGW) {
        if (row < TP) {
            const float* xin = (L == 0 ? Pk->in[0] : Pk->out + OUT_YP) + (size_t)row * 4096; float* xout = Pk->out + OUT_YP + (size_t)row * 4096;
            const float rsn = rsqrtf(wave_sum(SSQP[(size_t)row * 64 + lane]) * (1.0f / 4096.0f) + EPSN);
            float acc = 0.f;
#pragma unroll
            for (int j = 0; j < 8; ++j) {
                const int col = j * 512 + lane * 8;
                const u32x4 yv = *(const u32x4*)(Y + (size_t)row * 4096 + col);
                const f32x4 x0 = *(const f32x4*)(xin + col), x1 = *(const f32x4*)(xin + col + 4), g0 = *(const f32x4*)(gain + col), g1 = *(const f32x4*)(gain + col + 4);
                f32x4 y0 = {bflo(yv.x), bfhi(yv.x), bflo(yv.y), bfhi(yv.y)}, y1 = {bflo(yv.z), bfhi(yv.z), bflo(yv.w), bfhi(yv.w)};
                const f32x4 n0 = x0 + y0 * rsn * g0, n1 = x1 + y1 * rsn * g1;
                acc += (n0.x * n0.x + n0.y * n0.y) + (n0.z * n0.z + n0.w * n0.w) + (n1.x * n1.x + n1.y * n1.y) + (n1.z * n1.z + n1.w * n1.w);
                *(f32x4*)(xout + col) = n0; *(f32x4*)(xout + col + 4) = n1;
                u32x4 q; q.x = pk2(n0.x, n0.y); q.y = pk2(n0.z, n0.w); q.z = pk2(n1.x, n1.y); q.w = pk2(n1.z, n1.w);
                *(u32x4*)(XBF + (size_t)row * 4096 + col) = q;
            }
            acc = wave_sum(acc);
            if (lane == 0) RS[row] = rsqrtf(acc * (1.0f / 4096.0f) + EPSN);
        } else {
            const int b = row - TP;
            const float* xin = (L == 0 ? Pk->in[1] : Pk->out + OUT_YS) + (size_t)b * 4096; float* xout = Pk->out + OUT_YS + (size_t)b * 4096;
            float ss = 0.f;
            for (int j = 0; j < 8; ++j)
#pragma unroll
                for (int e = 0; e < 8; ++e) { const float y = part_sum(PART, 4096, b, j * 512 + lane * 8 + e); ss += y * y; }
            const float rsn = rsqrtf(wave_sum(ss) * (1.0f / 4096.0f) + EPSN);
            float acc = 0.f;
            for (int j = 0; j < 8; ++j) {
                const int col = j * 512 + lane * 8; float nv[8];
#pragma unroll
                for (int e = 0; e < 8; ++e) { const float y = part_sum(PART, 4096, b, col + e); nv[e] = xin[col + e] + y * rsn * gain[col + e]; acc += nv[e] * nv[e]; xout[col + e] = nv[e]; }
                u32x4 q; q.x = pk2(nv[0], nv[1]); q.y = pk2(nv[2], nv[3]); q.z = pk2(nv[4], nv[5]); q.w = pk2(nv[6], nv[7]);
                *(u32x4*)(XBF + (size_t)row * 4096 + col) = q;
            }
            acc = wave_sum(acc);
            if (lane == 0) RS[row] = rsqrtf(acc * (1.0f / 4096.0f) + EPSN);
        }
    }
}

constexpr int KROW = 272, VROW = 320, OFF_VS = 69632, OFF_BI = OFF_VS + 81920, OFF_SW = OFF_BI + 2112;
__device__ __forceinline__ void attn_item(const Params& P, LAS unsigned char* lds, int item) {
    const KParams Pk = kparams();
    int tid = threadIdx.x; asm volatile("" : "+v"(tid));
    const int lane = tid & 63, w = __builtin_amdgcn_readfirstlane(tid >> 6), hh = lane >> 5, l32 = lane & 31;
    unsigned char* ws = Pk->ws;
    const bf16_t* Q = (const bf16_t*)(ws + P_Q); const bf16_t* KVB = (const bf16_t*)(ws + O_KVB); bf16_t* ON = (bf16_t*)(ws + P_ON); float* LSE = (float*)(ws + O_LSE);
    const int g = item >> 8, rem = item & 255, n = rem >> 6, kvh = rem & 3, cb = (rem >> 2) & 15;
    const int r = 1 << (2 * g), nb = 16 >> (2 * g), c = cb / nb, nbi = cb % nb;
    LAS unsigned char* Ks = lds; LAS unsigned char* Vs = lds + OFF_VS; LAS float* BI = (LAS float*)(lds + OFF_BI);
    __syncthreads();
#pragma unroll
    for (int j = 0; j < 8; ++j) {
        const int id = tid + 512 * j, kk = id >> 4, chk = id & 15, pos = (nbi - 1) * 128 + kk;
        u32x4 kv = {0u, 0u, 0u, 0u}, vv = {0u, 0u, 0u, 0u};
        if (pos >= 0) { const bf16_t* src = KVB + (size_t)(n * 2048 + pos * r + c) * 3072 + g * 1024 + kvh * 128 + chk * 8; kv = *(const u32x4*)src; vv = *(const u32x4*)(src + 512); }
        *(LAS u32x4*)(Ks + kk * KROW + chk * 16) = kv; *(LAS u32x4*)(Vs + kk * VROW + chk * 16) = vv;
    }
    for (int e = tid; e < 516; e += 512) { const int hl = e / 129, dist = e % 129; BI[hl * 132 + dist] = Pk->in[20][rel_bucket(dist * r) * 48 + g * 16 + kvh * 4 + hl]; }
    __syncthreads();
    const float scale = 0.08838834764831845f;
    for (int pp = 0; pp < 2; ++pp) {
        const int pair = w + 8 * pp, hl = pair >> 2, qc = pair & 3, slot = kvh * 4 + hl;
        const int qq = qc * 32 + l32, qrow = n * 2048 + (nbi * 128 + qq) * r + c;
        bf16x8 Qf[8];
        { const bf16_t* qp = Q + (size_t)qrow * 6144 + g * 2048 + slot * 128 + hh * 8;
#pragma unroll
          for (int s = 0; s < 8; ++s) Qf[s] = *(const bf16x8*)(qp + s * 16); }
        f32x16 S[5];
#pragma unroll
        for (int kt = 0; kt < 5; ++kt) {
#pragma unroll
            for (int e = 0; e < 16; ++e) S[kt][e] = 0.f;
#pragma unroll
            for (int s = 0; s < 8; ++s) {
                const bf16x8 a = *(const LAS bf16x8*)(Ks + (qc * 32 + kt * 32 + l32) * KROW + (s * 16 + hh * 8) * 2);
                S[kt] = MFMA32(a, Qf[s], S[kt]);
            }
            __builtin_amdgcn_sched_barrier(0);
        }
        float m = -INFINITY;
#pragma unroll
        for (int kt = 0; kt < 5; ++kt)
#pragma unroll
            for (int reg = 0; reg < 16; ++reg) {
                const int kk = qc * 32 + kt * 32 + crow(reg, hh), dist = 128 + qq - kk;
                const bool valid = dist >= 0 && dist <= 128 && (nbi > 0 || kk >= 128);
                const int dcl = dist < 0 ? 0 : (dist > 128 ? 128 : dist);
                const float sv = valid ? S[kt][reg] * scale + BI[hl * 132 + dcl] : -INFINITY;
                S[kt][reg] = sv; m = fmaxf(m, sv);
                if ((reg & 3) == 3) __builtin_amdgcn_sched_barrier(0);
            }
        m = fmaxf(m, __shfl_xor(m, 32));
        float den = 0.f;
#pragma unroll
        for (int kt = 0; kt < 5; ++kt)
#pragma unroll
            for (int reg = 0; reg < 16; ++reg) { const float p = __expf(S[kt][reg] - m); S[kt][reg] = p; den += p; }
        den += __shfl_xor(den, 32);
        f32x16 O[4];
#pragma unroll
        for (int dt = 0; dt < 4; ++dt)
#pragma unroll
            for (int e = 0; e < 16; ++e) O[dt][e] = 0.f;
        const int q_ = (lane & 15) >> 2, p_ = lane & 3, cg16 = (lane >> 4) & 1;
#pragma unroll
        for (int kt = 0; kt < 5; ++kt)
#pragma unroll
            for (int s2 = 0; s2 < 2; ++s2) {
                u32x4 pw; pw.x = pk2(S[kt][8 * s2 + 0], S[kt][8 * s2 + 1]); pw.y = pk2(S[kt][8 * s2 + 2], S[kt][8 * s2 + 3]); pw.z = pk2(S[kt][8 * s2 + 4], S[kt][8 * s2 + 5]); pw.w = pk2(S[kt][8 * s2 + 6], S[kt][8 * s2 + 7]);
                const bf16x8 pf = __builtin_bit_cast(bf16x8, pw);
                const int R0 = qc * 32 + kt * 32 + 16 * s2 + 4 * hh;
#pragma unroll
                for (int dt = 0; dt < 4; ++dt) {
                    LAS unsigned char* ad = Vs + (R0 + q_) * VROW + (dt * 32 + 16 * cg16 + 4 * p_) * 2;
                    const s16x4 lo = __builtin_amdgcn_ds_read_tr16_b64_v4i16((LAS s16x4*)ad), hi = __builtin_amdgcn_ds_read_tr16_b64_v4i16((LAS s16x4*)(ad + 8 * VROW));
                    bf16x8 a; a[0] = lo[0]; a[1] = lo[1]; a[2] = lo[2]; a[3] = lo[3]; a[4] = hi[0]; a[5] = hi[1]; a[6] = hi[2]; a[7] = hi[3];
                    O[dt] = MFMA32(a, pf, O[dt]);
                }
                __builtin_amdgcn_sched_barrier(0);
            }
        const float inv = 1.0f / den;
        bf16_t* op = ON + ((size_t)g * RP + qrow) * 2048 + slot * 128 + 4 * hh;
#pragma unroll
        for (int dt = 0; dt < 4; ++dt)
#pragma unroll
            for (int g4 = 0; g4 < 4; ++g4) {
                u32x2 q; q.x = pk2(O[dt][4 * g4] * inv, O[dt][4 * g4 + 1] * inv); q.y = pk2(O[dt][4 * g4 + 2] * inv, O[dt][4 * g4 + 3] * inv);
                *(u32x2*)(op + dt * 32 + 8 * g4) = q;
            }
        if (hh == 0) LSE[((size_t)g * RP + qrow) * 16 + slot] = m + __logf(den);
    }
}

__device__ __forceinline__ void sample_attn(const Params& P, LAS unsigned char* lds, int si, int lbi, int wv) {
    const KParams Pk = kparams();
    int tid = threadIdx.x; asm volatile("" : "+v"(tid));
    const int lane = tid & 63;
    unsigned char* ws = Pk->ws;
    const float* PART = (const float*)(ws + O_PART); const float* RS = (const float*)(ws + O_RS); bf16_t* ON = (bf16_t*)(ws + P_ON); float* LSE = (float*)(ws + O_LSE);
    const int b = si / 48, rem = si % 48, g = rem >> 4, slot = rem & 15, kvh = slot >> 2, r = 1 << (2 * g), lbuf = 128 << (2 * g);
    const int N = lbi == 0 ? 11264 : 8192;
    const float* state = Pk->in[4 + g]; float* skv = Pk->out + (g == 0 ? OUT_SKV0 : (g == 1 ? OUT_SKV1 : OUT_SKV2));
    LAS float* qs = (LAS float*)(lds + OFF_SW + wv * 2064); LAS float* pw = qs + 128; LAS float* kn = qs + 260; LAS float* vn = qs + 388;
    const float rsb = RS[TP + b];
#pragma unroll
    for (int e = 0; e < 2; ++e) {
        const int d = lane * 2 + e;
        qs[d] = rsb * part_sum(PART, N, b, g * 2048 + slot * 128 + d);
        float kvl, vvl;
        if (lbi == 0) { kvl = rsb * part_sum(PART, N, b, 8192 + g * 1024 + kvh * 128 + d); vvl = rsb * part_sum(PART, N, b, 8192 + g * 1024 + 512 + kvh * 128 + d);
            if ((slot & 3) == 0) { float* dst = skv + ((size_t)(b * lbuf + lbuf - 1) * 2) * 512 + kvh * 128 + d; dst[0] = kvl; dst[512] = vvl; } }
        else { const float* srcp = skv + ((size_t)(b * lbuf + lbuf - 1) * 2) * 512 + kvh * 128 + d; kvl = srcp[0]; vvl = srcp[512]; }
        kn[d] = kvl; vn[d] = vvl;
    }
    LDS_WAIT();
    const float scale = 0.08838834764831845f;
    float sc[3]; float m = -INFINITY;
#pragma unroll
    for (int rd = 0; rd < 3; ++rd) {
        const int step = lane + 64 * rd; float s = -INFINITY;
        if (step <= 128) {
            float dot = 0.f;
            if (step == 0) {
#pragma unroll 4
                for (int d = 0; d < 128; ++d) dot += qs[d] * kn[d]; }
            else { const f32x4* kr = (const f32x4*)(state + ((size_t)(b * lbuf + lbuf - step * r) * 2) * 512 + kvh * 128);
#pragma unroll 4
                for (int d4 = 0; d4 < 32; ++d4) { const f32x4 kv = kr[d4]; const f32x4 qv = *(const LAS f32x4*)(qs + d4 * 4); dot += (kv.x * qv.x + kv.y * qv.y) + (kv.z * qv.z + kv.w * qv.w); } }
            s = dot * scale + Pk->in[20][rel_bucket(step * r) * 48 + g * 16 + slot];
        }
        sc[rd] = s; m = fmaxf(m, s);
    }
    m = wave_max(m);
    float den = 0.f;
#pragma unroll
    for (int rd = 0; rd < 3; ++rd) { const int step = lane + 64 * rd; const float p = __expf(sc[rd] - m); den += p; if (step <= 128) pw[step] = p; }
    den = wave_sum(den);
    LDS_WAIT();
    float o0 = pw[0] * vn[lane * 2], o1 = pw[0] * vn[lane * 2 + 1];
#pragma unroll 4
    for (int step = 1; step <= 128; ++step) {
        const f32x2 v = *(const f32x2*)(state + ((size_t)(b * lbuf + lbuf - step * r) * 2 + 1) * 512 + kvh * 128 + lane * 2);
        const float p = pw[step]; o0 += p * v.x; o1 += p * v.y;
    }
    const float inv = 1.0f / den;
    *(unsigned*)(ON + ((size_t)g * RP + TP + b) * 2048 + slot * 128 + lane * 2) = pk2(o0 * inv, o1 * inv);
    if (lane == 0) LSE[((size_t)g * RP + TP + b) * 16 + slot] = m + __logf(den);
    LDS_WAIT();
}

__device__ __forceinline__ void combine_phase(const Params& P, int lbi) {
    const KParams Pk = kparams();
    int tid = threadIdx.x; asm volatile("" : "+v"(tid));
    const int lane = tid & 63, w = __builtin_amdgcn_readfirstlane(tid >> 6);
    const int gw = blockIdx.x * 8 + w, NGW = gridDim.x * 8;
    unsigned char* ws = Pk->ws;
    const bf16_t* ON = (const bf16_t*)(ws + P_ON); const float* LSE = (const float*)(ws + O_LSE); const bf16_t* SG2 = (const bf16_t*)(ws + O_SG2); bf16_t* OG = (bf16_t*)(ws + O_OG);
    const float* PART = (const float*)(ws + O_PART); const float* RS = (const float*)(ws + O_RS);
    const int N = lbi == 0 ? 11264 : 8192;
    for (int row = gw; row < TP + 8; row += NGW) {
#pragma unroll
        for (int cch = 0; cch < 4; ++cch) {
            const int col = cch * 512 + lane * 8, slot = col >> 7;
            const float l0 = LSE[((size_t)0 * RP + row) * 16 + slot], l1 = LSE[((size_t)1 * RP + row) * 16 + slot], l2 = LSE[((size_t)2 * RP + row) * 16 + slot];
            const float mx = fmaxf(l0, fmaxf(l1, l2)); float w0 = __expf(l0 - mx), w1 = __expf(l1 - mx), w2 = __expf(l2 - mx);
            const float iw = 1.0f / (w0 + w1 + w2); w0 *= iw; w1 *= iw; w2 *= iw;
            const u32x4 a0 = *(const u32x4*)(ON + ((size_t)0 * RP + row) * 2048 + col), a1 = *(const u32x4*)(ON + ((size_t)1 * RP + row) * 2048 + col), a2 = *(const u32x4*)(ON + ((size_t)2 * RP + row) * 2048 + col);
            float gt[8];
            if (row < TP) { const u32x4 sv = *(const u32x4*)(SG2 + (size_t)row * 2048 + col);
                gt[0] = bflo(sv.x); gt[1] = bfhi(sv.x); gt[2] = bflo(sv.y); gt[3] = bfhi(sv.y); gt[4] = bflo(sv.z); gt[5] = bfhi(sv.z); gt[6] = bflo(sv.w); gt[7] = bfhi(sv.w); }
            else { const int b = row - TP; const float rsb = RS[row];
#pragma unroll
                for (int e = 0; e < 8; ++e) gt[e] = silu_f(rsb * part_sum(PART, N, b, 6144 + col + e)); }
            float o[8];
            o[0] = w0 * bflo(a0.x) + w1 * bflo(a1.x) + w2 * bflo(a2.x); o[1] = w0 * bfhi(a0.x) + w1 * bfhi(a1.x) + w2 * bfhi(a2.x);
            o[2] = w0 * bflo(a0.y) + w1 * bflo(a1.y) + w2 * bflo(a2.y); o[3] = w0 * bfhi(a0.y) + w1 * bfhi(a1.y) + w2 * bfhi(a2.y);
            o[4] = w0 * bflo(a0.z) + w1 * bflo(a1.z) + w2 * bflo(a2.z); o[5] = w0 * bfhi(a0.z) + w1 * bfhi(a1.z) + w2 * bfhi(a2.z);
            o[6] = w0 * bflo(a0.w) + w1 * bflo(a1.w) + w2 * bflo(a2.w); o[7] = w0 * bfhi(a0.w) + w1 * bfhi(a1.w) + w2 * bfhi(a2.w);
            u32x4 q; q.x = pk2(o[0] * gt[0], o[1] * gt[1]); q.y = pk2(o[2] * gt[2], o[3] * gt[3]); q.z = pk2(o[4] * gt[4], o[5] * gt[5]); q.w = pk2(o[6] * gt[6], o[7] * gt[7]);
            *(u32x4*)(OG + (size_t)row * 2048 + col) = q;
        }
    }
}

__global__ __launch_bounds__(512, 2) void yoco_mega(Params P) {
    extern __shared__ __attribute__((aligned(16))) unsigned char shm[];
    LAS unsigned char* lds = (LAS unsigned char*)shm;
    cg::grid_group grid = cg::this_grid();
    const KParams Pk = kparams();
    unsigned char* ws = Pk->ws;
    const int w = threadIdx.x >> 6;
    if (threadIdx.x == 0) { *(LAS u32x4*)(lds + OFF_XB) = (u32x4){0u, 0u, 0u, 0u}; }
    __syncthreads();
    const XcdBarrier xb = xcd_barrier_post((unsigned*)(ws + O_BAR), (volatile LAS unsigned*)(lds + OFF_XB));
    prep_phase(P, lds);
    grid.sync();
    for (int L = 0; L < 4; ++L) {
        for (int half = 0; half < 2; ++half) {
            pg8::Gemm gm; Epi E; gm.M = TP;
            E.rs = (const float*)(ws + O_RS); E.ssqp = (float*)(ws + O_SSQP); E.outp = Pk->out; E.o2 = (bf16_t*)(ws + O_KVB);
            if (half == 0) {
                gm.A = (const bf16_t*)(ws + O_XBF); gm.K = 4096;
                if (L < 2) { gm.Bt = (const bf16_t*)(ws + O_BT1) + (size_t)L * 8192 * 4096; gm.N = 8192; E.mode = 0; E.o0 = (bf16_t*)(ws + P_XB); E.o1 = (bf16_t*)(ws + P_SG); }
                else { gm.Bt = (const bf16_t*)(ws + (L == 2 ? O_BT3 : O_BT4)); gm.N = L == 2 ? 11264 : 8192; E.mode = 2; E.o0 = (bf16_t*)(ws + P_Q); E.o1 = (bf16_t*)(ws + O_SG2); }
            } else {
                E.mode = 1; E.o0 = (bf16_t*)(ws + O_Y); E.o1 = E.o0; gm.N = 4096;
                if (L < 2) { gm.A = (const bf16_t*)(ws + P_HG); gm.Bt = (const bf16_t*)(ws + O_BT2) + (size_t)L * 4096 * 4096; gm.K = 4096; }
                else { gm.A = (const bf16_t*)(ws + O_OG); gm.Bt = (const bf16_t*)(ws + O_BT5) + (size_t)(L - 2) * 4096 * 2048; gm.K = 2048; }
            }
            pg8::StaticOrder S; S.init(gm.M, gm.N, (int)gridDim.x, (int)blockIdx.x);
            pg8::gemm_phase<Epi, pg8::StaticOrder, false>(lds, gm, S, E, nullptr);
            skinny_phase(gm.A + (size_t)TP * gm.K, gm.Bt, gm.N, gm.K, (float*)(ws + O_PART));
            xcd_barrier(xb);
            if (half == 0) {
                if (L < 2) {
                    for (int t = blockIdx.x; t < 16 + 2048; t += gridDim.x) scan_tile(P, lds, L, t);
                } else {
                    for (int wv = 0; wv < 2; ++wv) { const int si = wv * 256 + (int)blockIdx.x; if (si < 384 && w == wv && gridDim.x >= 256) sample_attn(P, lds, si, L - 2, wv); }
                    if (gridDim.x < 256 && w < 2) for (int si = blockIdx.x * 2 + w; si < 384; si += gridDim.x * 2) sample_attn(P, lds, si, L - 2, w);
                    for (int it = blockIdx.x; it < 768; it += gridDim.x) attn_item(P, lds, it);
                    xcd_barrier(xb);
                    combine_phase(P, L - 2);
                }
            } else {
                post_phase(P, L);
            }
            if (!(L == 3 && half == 1)) xcd_barrier(xb);
        }
    }
}

extern "C" void kernel_launch(void* const* d_in, const int* in_sizes, int n_in, void* d_out, int out_size, void* d_ws, size_t ws_size, hipStream_t stream) {
    static int grid_blocks = 0;
    if (!grid_blocks) {
        int dev = 0, cus = 0, per_cu = 0;
        hipGetDevice(&dev);
        hipDeviceGetAttribute(&cus, hipDeviceAttributeMultiprocessorCount, dev);
        hipFuncSetAttribute((const void*)yoco_mega, hipFuncAttributeMaxDynamicSharedMemorySize, LDS_BYTES);
        if (hipOccupancyMaxActiveBlocksPerMultiprocessor(&per_cu, (const void*)yoco_mega, 512, LDS_BYTES) != hipSuccess || per_cu < 1) per_cu = 1;
        (void)hipGetLastError();
        grid_blocks = cus * per_cu;
        if (ws_size < O_END) fprintf(stderr, "kernel_launch: workspace too small: %zu < %zu\n", ws_size, (size_t)O_END);
    }
    (void)hipMemsetAsync((unsigned char*)d_ws + O_BAR, 0, XCD_BAR_WORDS * sizeof(unsigned), stream);
    Params p{};
    for (int i = 0; i < 25; ++i) p.in[i] = (const float*)d_in[i];
    p.out = (float*)d_out; p.ws = (unsigned char*)d_ws;
    void* args[] = {&p};
    hipError_t e = hipLaunchCooperativeKernel((const void*)yoco_mega, dim3(grid_blocks), dim3(512), args, LDS_BYTES, stream);
    if (e != hipSuccess) fprintf(stderr, "cooperative launch failed: %s (grid %d)\n", hipGetErrorString(e), grid_blocks);
}
```

```cpp
#include <hip/hip_runtime.h>
#include <hip/hip_cooperative_groups.h>
#include <cstdio>
namespace cg = cooperative_groups;

namespace pg8 {
#define PG8_LAS __attribute__((address_space(3)))
typedef unsigned short bf16_t;
typedef short bf16x8 __attribute__((ext_vector_type(8)));
typedef float f32x4 __attribute__((ext_vector_type(4)));
typedef unsigned u32x4 __attribute__((ext_vector_type(4)));
constexpr int BM = 256, BK = 64, HALF = 128, HTB = HALF * BK * 2, STAGE_BYTES = 8 * HTB, NXCD = 8, WGM = 8;

__host__ __device__ __forceinline__ int lds_byte(int r, int c) { const int st = (r >> 4) * 2 + (c >> 5), rr = r & 15, cc = c & 31, ob = rr * 64 + cc * 2; return st * 1024 + (ob ^ (((ob >> 9) & 1) << 5)); }
__host__ __device__ __forceinline__ void stage_rc(int b, int& R, int& C) { const int st = b / 1024, sb = b % 1024, swz = sb ^ (((sb >> 9) & 1) << 5); R = (st >> 1) * 16 + swz / 64; C = (st & 1) * 32 + (swz % 64) / 2; }
__host__ __device__ __forceinline__ int perm32(int rho) { const int n = rho >> 4, i = rho & 15; return 8 * (i >> 2) + 4 * n + (i & 3); }

struct Unit { int pm, pn; };
struct Gemm { const bf16_t* A; const bf16_t* Bt; int M, N, K; };

struct StaticOrder {
    int nM, nN, nwg, G, c;
    __host__ __device__ void init(int M, int N, int G_, int c_) { nM = M / BM; nN = N / BM; nwg = nM * nN; G = G_; c = c_; }
    __host__ __device__ bool next(int i, Unit& u) const {
        const long L = (long)i * G + c; if (L >= nwg) return false;
        int wgid = (int)L; { const int q = nwg / NXCD, r = nwg % NXCD, xcd = wgid % NXCD, off = wgid / NXCD; wgid = (xcd < r ? xcd * (q + 1) : r * (q + 1) + (xcd - r) * q) + off; }
        const int nig = WGM * nN, gid = wgid / nig, fm = gid * WGM, gsz = (nM - fm) < WGM ? (nM - fm) : WGM;
        u.pm = fm + ((wgid % nig) % gsz); u.pn = (wgid % nig) / gsz; return true;
    }
    __device__ __forceinline__ void a_ready(const Unit&) const {}
    __device__ __forceinline__ void done(const Unit&) const {}
};
template <class Epi, class Sched, bool STAMP = false>
__device__ __forceinline__ void gemm_phase(PG8_LAS unsigned char* lds, const Gemm g, const Sched& S, const Epi& E, unsigned long long* stamps) {
    int tid = threadIdx.x; asm volatile("" : "+v"(tid));
    const int wid = __builtin_amdgcn_readfirstlane(tid >> 6), lane = tid & 63, wr = wid >> 2, wc = wid & 3, fr = lane & 15, fq = lane >> 4;
    const int K = g.K, nt = K / BK;
    int ts_lo = 0, ts_hi = 0, nts = 0; const unsigned long long rt_entry = STAMP ? (unsigned long long)wall_clock64() : 0ull;
#define PG8_STAMP() do { if (STAMP && wid == 0 && nts < 64) { const unsigned long long _c = (unsigned long long)clock64(); \
        ts_lo = (lane == nts) ? (int)(unsigned)_c : ts_lo; ts_hi = (lane == nts) ? (int)(unsigned)(_c >> 32) : ts_hi; ++nts; } } while (0)
    PG8_STAMP();
    unsigned voffA[2], voffB[2];
#pragma unroll
    for (int i = 0; i < 2; ++i) { int R, C; stage_rc(tid * 16 + i * 8192, R, C); const int Rb = Epi::PERM ? ((R & ~31) + perm32(R & 31)) : R;
        voffA[i] = (unsigned)(R * K + C) * 2u; voffB[i] = (unsigned)(Rb * K + C) * 2u; }
    const size_t kstep = (size_t)(BK * 2);
    const size_t hstep = (size_t)HALF * K * 2;
    const size_t tstep = 2 * hstep;
    const unsigned ldsw = (unsigned)wid * 1024u;
    const int aoff = lds_byte(wr * 64 + fr, fq * 8), boff = lds_byte(wc * 32 + fr, fq * 8);
#define PG8_SA(b, h) (((b) * 2 + (h)) * HTB)
#define PG8_SB(b, h) ((4 + (b) * 2 + (h)) * HTB)
#define PG8_STAGE(bufoff, gbase, voff) do { _Pragma("unroll") for (int _i = 0; _i < 2; ++_i) \
        __builtin_amdgcn_global_load_lds((const unsigned*)((const char*)(gbase) + (voff)[_i]), (PG8_LAS unsigned*)(lds + (bufoff) + ldsw + _i * 8192), 16, 0, 0); } while (0)
#define PG8_LDA(dst, b, h) do { _Pragma("unroll") for (int m = 0; m < 4; ++m) _Pragma("unroll") for (int k = 0; k < 2; ++k) dst[m][k] = *(const PG8_LAS bf16x8*)(lds + PG8_SA(b, h) + aoff + m * 2048 + k * 1024); } while (0)
#define PG8_LDB(dst, b, h) do { _Pragma("unroll") for (int n = 0; n < 2; ++n) _Pragma("unroll") for (int k = 0; k < 2; ++k) dst[n][k] = *(const PG8_LAS bf16x8*)(lds + PG8_SB(b, h) + boff + n * 2048 + k * 1024); } while (0)
#define PG8_MMA(ai, bj, At, Bt) do { __builtin_amdgcn_s_setprio(1); _Pragma("unroll") for (int m = 0; m < 4; ++m) _Pragma("unroll") for (int n = 0; n < 2; ++n) _Pragma("unroll") for (int k = 0; k < 2; ++k) \
        acc[ai][bj][m][n] = __builtin_amdgcn_mfma_f32_16x16x32_bf16(Bt[n][k], At[m][k], acc[ai][bj][m][n], 0, 0, 0); __builtin_amdgcn_s_setprio(0); } while (0)
#define PG8_WAIT_V(n) asm volatile("s_waitcnt vmcnt(" #n ")" ::: "memory")
#define PG8_WAIT_L(n) asm volatile("s_waitcnt lgkmcnt(" #n ")" ::: "memory")
#define PG8_BAR __builtin_amdgcn_s_barrier()
#define PG8_SCHED __builtin_amdgcn_sched_barrier(0)
    Unit cur, nxt; int ui = 0;
    if (!S.next(0, cur)) return;
    f32x4 acc[2][2][4][2];
#pragma unroll
    for (int a = 0; a < 2; ++a)
#pragma unroll
        for (int b = 0; b < 2; ++b)
#pragma unroll
            for (int m = 0; m < 4; ++m)
#pragma unroll
                for (int n = 0; n < 2; ++n) acc[a][b][m][n] = (f32x4){0.f, 0.f, 0.f, 0.f};
    bf16x8 At[4][2], B0[2][2], B1[2][2];
    const char* cA = (const char*)g.A + (size_t)cur.pm * tstep; const char* cB = (const char*)g.Bt + (size_t)cur.pn * tstep;
    S.a_ready(cur);
    PG8_STAGE(PG8_SB(0, 0), cB, voffB); PG8_STAGE(PG8_SA(0, 0), cA, voffA); PG8_STAGE(PG8_SB(0, 1), cB + hstep, voffB); PG8_STAGE(PG8_SA(0, 1), cA + hstep, voffA);
    if (wr == 1) PG8_BAR;
    PG8_WAIT_V(4); PG8_BAR;
    PG8_STAGE(PG8_SB(1, 0), cB + kstep, voffB); PG8_STAGE(PG8_SA(1, 0), cA + kstep, voffA); PG8_STAGE(PG8_SB(1, 1), cB + hstep + kstep, voffB);
    PG8_WAIT_V(6); PG8_BAR;
    PG8_STAMP();
    for (;;) {
        const bool has_next = S.next(ui + 1, nxt);
        const char* nA = has_next ? (const char*)g.A + (size_t)nxt.pm * tstep : cA; const char* nB = has_next ? (const char*)g.Bt + (size_t)nxt.pn * tstep : cB;
        for (int t = 0; t < nt; t += 2) {
            const bool last = (t == nt - 2);
            const char* a1 = cA + (size_t)(t + 1) * kstep;
            const char* a2 = last ? nA : cA + (size_t)(t + 2) * kstep; const char* b2 = last ? nB : cB + (size_t)(t + 2) * kstep;
            const char* a3 = a2 + kstep; const char* b3 = b2 + kstep;
            if (last && has_next) S.a_ready(nxt);
            PG8_LDB(B0, 0, 0); PG8_SCHED; PG8_LDA(At, 0, 0); PG8_STAGE(PG8_SA(1, 1), a1 + hstep, voffA);
            PG8_WAIT_L(8); PG8_BAR; PG8_WAIT_L(0); PG8_MMA(0, 0, At, B0); PG8_BAR; PG8_SCHED;
            PG8_LDB(B1, 0, 1); PG8_STAGE(PG8_SB(0, 0), b2, voffB);
            PG8_BAR; PG8_WAIT_L(0); PG8_MMA(0, 1, At, B1); PG8_BAR;
            PG8_LDA(At, 0, 1); PG8_STAGE(PG8_SA(0, 0), a2, voffA);
            PG8_BAR; PG8_WAIT_L(0); PG8_MMA(1, 0, At, B0); PG8_BAR; PG8_SCHED;
            PG8_STAGE(PG8_SB(0, 1), b2 + hstep, voffB);
            PG8_WAIT_V(6); PG8_BAR; PG8_MMA(1, 1, At, B1); PG8_BAR;
            PG8_LDB(B0, 1, 0); PG8_SCHED; PG8_LDA(At, 1, 0); PG8_STAGE(PG8_SA(0, 1), a2 + hstep, voffA);
            PG8_WAIT_L(8); PG8_BAR; PG8_WAIT_L(0); PG8_MMA(0, 0, At, B0); PG8_BAR; PG8_SCHED;
            PG8_LDB(B1, 1, 1); PG8_STAGE(PG8_SB(1, 0), b3, voffB);
            PG8_BAR; PG8_WAIT_L(0); PG8_MMA(0, 1, At, B1); PG8_BAR;
            PG8_LDA(At, 1, 1); PG8_STAGE(PG8_SA(1, 0), a3, voffA);
            PG8_BAR; PG8_WAIT_L(0); PG8_MMA(1, 0, At, B0); PG8_BAR; PG8_SCHED;
            PG8_STAGE(PG8_SB(1, 1), b3 + hstep, voffB);
            PG8_WAIT_V(6); PG8_BAR; PG8_MMA(1, 1, At, B1); PG8_BAR;
        }
        PG8_STAMP();
        if constexpr (!Epi::AFTER_DRAIN) { E(acc, cur, wr, wc, fr, fq); S.done(cur); }
        PG8_STAMP();
        if (!has_next) break;
#pragma unroll
        for (int a = 0; a < 2; ++a)
#pragma unroll
            for (int b = 0; b < 2; ++b)
#pragma unroll
                for (int m = 0; m < 4; ++m)
#pragma unroll
                    for (int n = 0; n < 2; ++n) acc[a][b][m][n] = (f32x4){0.f, 0.f, 0.f, 0.f};
        cur = nxt; cA = nA; cB = nB; ++ui;
    }
    PG8_WAIT_V(0);
    if (wr == 0) PG8_BAR;
    PG8_BAR;
    if constexpr (Epi::AFTER_DRAIN) { E.fused(acc, cur, wr, wc, fr, fq, lds, wid, lane); S.done(cur); }
    PG8_STAMP();
    if (STAMP && wid == 0) { stamps[lane] = lane < nts ? (((unsigned long long)(unsigned)ts_hi << 32) | (unsigned)ts_lo) : 0ull;
        if (lane == 62) stamps[62] = rt_entry; if (lane == 63) stamps[63] = (unsigned long long)wall_clock64(); }
#undef PG8_STAMP
#undef PG8_SA
#undef PG8_SB
#undef PG8_STAGE
#undef PG8_LDA
#undef PG8_LDB
#undef PG8_MMA
#undef PG8_WAIT_V
#undef PG8_WAIT_L
#undef PG8_BAR
#undef PG8_SCHED
}}

using pg8::bf16_t; using pg8::bf16x8; using pg8::f32x4; using pg8::u32x4;
typedef short s16x4 __attribute__((ext_vector_type(4)));
typedef float f32x16 __attribute__((ext_vector_type(16)));
typedef float f32x2 __attribute__((ext_vector_type(2)));
typedef unsigned u32x2 __attribute__((ext_vector_type(2)));
typedef unsigned long long u64;
#define LAS __attribute__((address_space(3)))
#define LDS_WAIT() asm volatile("s_waitcnt lgkmcnt(0)" ::: "memory")
#define XB_TMO      128
#define XB_XCNT(j)  (256  + 64 * (j))
#define XB_XSUB(j)  (1280 + 64 * (j))
#define XB_XGEN(j)  (2304 + 64 * (j))
#define XB_TOP      3328
#define XB_TOPGEN   3392
#define XCD_BAR_WORDS 3456
#define XB_SPIN_CAP (1u << 18)

__device__ __forceinline__ unsigned xb_ld(unsigned* p)              { return __hip_atomic_load(p, __ATOMIC_RELAXED, __HIP_MEMORY_SCOPE_AGENT); }
__device__ __forceinline__ unsigned xb_add(unsigned* p, unsigned v) { return __hip_atomic_fetch_add(p, v, __ATOMIC_RELAXED, __HIP_MEMORY_SCOPE_AGENT); }
__device__ __forceinline__ unsigned xb_xcc_id() { return (unsigned)__builtin_amdgcn_s_getreg((3 << 11) | 20) & 0xFu; }
#define XB_SPIN(cond, bar) do { unsigned _sp = 0; while (cond) { __builtin_amdgcn_s_sleep(1); \
    if ((++_sp & 255u) == 0u) { if (xb_ld(&(bar)[XB_TMO])) break; if (_sp > XB_SPIN_CAP) { atomicAdd(&(bar)[XB_TMO], 1u); break; } } } } while (0)

struct XcdBarrier {
    unsigned* bar; unsigned x;
    volatile LAS unsigned* st;
};

__device__ __forceinline__ XcdBarrier xcd_barrier_post(unsigned* bar, volatile LAS unsigned* st) {
    XcdBarrier b; b.bar = bar; b.x = xb_xcc_id(); b.st = st;
    if (threadIdx.x == 0) (void)xb_add(&bar[XB_XCNT(b.x)], 1u);
    return b;
}
__device__ __forceinline__ void xcd_barrier_complete(unsigned* bar, unsigned x, unsigned& nloc, unsigned& nx) {
    const unsigned G = gridDim.x * gridDim.y * gridDim.z;
    unsigned sum, cnt, mine, sp = 0u;
    for (;;) {
        sum = 0u; cnt = 0u; mine = 0u;
#pragma unroll
        for (unsigned j = 0; j < 16; ++j) { const unsigned c = xb_ld(&bar[XB_XCNT(j)]); sum += c; cnt += (c > 0u) ? 1u : 0u; mine = (j == x) ? c : mine; }
        if (sum == G) break;
        __builtin_amdgcn_s_sleep(1);
        if ((++sp & 255u) == 0u) { if (xb_ld(&bar[XB_TMO])) break; if (sp > XB_SPIN_CAP) { atomicAdd(&bar[XB_TMO], 1u); break; } }
    }
    nloc = mine > 0u ? mine : 1u; nx = cnt > 0u ? cnt : 1u;
}

__device__ __forceinline__ void xcd_barrier(const XcdBarrier& b) {
    asm volatile("s_waitcnt vmcnt(0)" ::: "memory");
    __syncthreads();
    if (threadIdx.x == 0) {
        unsigned* bar = b.bar;
        __builtin_amdgcn_s_waitcnt(0);
        unsigned nloc = b.st[0], nx = b.st[1];
        if (nloc == 0u) { xcd_barrier_complete(bar, b.x, nloc, nx); b.st[0] = nloc; b.st[1] = nx; }
        const unsigned old = xb_add(&bar[XB_XSUB(b.x)], 1u);
        const unsigned gen = old / nloc;
        if (old + 1u == (gen + 1u) * nloc) {
            __builtin_amdgcn_fence(__ATOMIC_RELEASE, "agent");
            asm volatile("s_waitcnt vmcnt(0)" ::: "memory");
            const unsigned og = xb_add(&bar[XB_TOP], 1u);
            const unsigned tg = og / nx;
            if (og + 1u == (tg + 1u) * nx) xb_add(&bar[XB_TOPGEN], 1u);
            else XB_SPIN(xb_ld(&bar[XB_TOPGEN]) == tg, bar);
            __builtin_amdgcn_fence(__ATOMIC_ACQUIRE, "agent");
            xb_add(&bar[XB_XGEN(b.x)], 1u);
            asm volatile("s_waitcnt vmcnt(0)" ::: "memory");
        } else {
            XB_SPIN(xb_ld(&bar[XB_XGEN(b.x)]) == gen, bar);
            __builtin_amdgcn_fence(__ATOMIC_ACQUIRE, "agent");
            asm volatile("s_waitcnt vmcnt(0)" ::: "memory");
        }
    }
    __syncthreads();
}


constexpr int DM = 4096, SEQ = 2048, TP = 8192, RP = 8448;
constexpr size_t MiB = (size_t)1 << 20;
constexpr size_t O_BT1 = 0, O_BT2 = O_BT1 + 128 * MiB, O_BT3 = O_BT2 + 64 * MiB, O_BT4 = O_BT3 + 88 * MiB, O_BT5 = O_BT4 + 64 * MiB, O_WG = O_BT5 + 32 * MiB,
                 O_XBF = O_WG + 8 * MiB, O_POOL = O_XBF + 66 * MiB, O_Y = O_POOL + 198 * MiB, O_SG2 = O_Y + 66 * MiB, O_OG = O_SG2 + 33 * MiB, O_KVB = O_OG + 33 * MiB,
                 O_RS = O_KVB + 48 * MiB, O_SSQP = O_RS + 1 * MiB, O_LSE = O_SSQP + 2 * MiB, O_GRAN = O_LSE + 2 * MiB, O_PART = O_GRAN + 8 * MiB, O_BAR = O_PART + 3 * MiB, O_END = O_BAR + 1 * MiB;
constexpr size_t P_XB = O_POOL, P_SG = O_POOL + 66 * MiB, P_HG = O_POOL + 132 * MiB, P_Q = O_POOL, P_ON = O_POOL + 99 * MiB;
constexpr size_t OUT_YP = 0, OUT_YS = 33554432, OUT_PCONV = OUT_YS + 32768, OUT_PH = OUT_PCONV + 98304, OUT_PKV0 = OUT_PH + 32768, OUT_PKV1 = OUT_PKV0 + 524288, OUT_PKV2 = OUT_PKV1 + 2097152,
                 OUT_SCONV = OUT_PKV2 + 8388608, OUT_SH = OUT_SCONV + 196608, OUT_SKV0 = OUT_SH + 65536, OUT_SKV1 = OUT_SKV0 + 1048576, OUT_SKV2 = OUT_SKV1 + 4194304;
constexpr int LDS_BYTES = 159744, OFF_XB = 157824;
constexpr float EPSN = 1e-6f;

struct Params { const float* in[25]; float* out; unsigned char* ws; };
typedef const Params __attribute__((address_space(4))) * KParams;
__device__ __forceinline__ KParams kparams() { KParams p = (KParams)__builtin_amdgcn_kernarg_segment_ptr(); asm volatile("" : "+s"(p)); return p; }
#define PLOCAL const KParams Pk = kparams(); (void)P;


__device__ __forceinline__ unsigned pk2(float a, float b) { typedef __bf16 bf2 __attribute__((ext_vector_type(2))); bf2 v; v[0] = (__bf16)a; v[1] = (__bf16)b; return __builtin_bit_cast(unsigned, v); }
__device__ __forceinline__ float bflo(unsigned u) { return __uint_as_float(u << 16); }
__device__ __forceinline__ float bfhi(unsigned u) { return __uint_as_float(u & 0xffff0000u); }
__device__ __forceinline__ float bf2f(bf16_t h) { return __uint_as_float(((unsigned)h) << 16); }
__device__ __forceinline__ float silu_f(float v) { return v * __builtin_amdgcn_rcpf(1.0f + __expf(-v)); }
__device__ __forceinline__ float sigm_f(float v) { return __builtin_amdgcn_rcpf(1.0f + __expf(-v)); }
__device__ __forceinline__ float wave_sum(float v) {
#pragma unroll
    for (int o = 1; o < 64; o <<= 1) v += __shfl_xor(v, o);
    return v;
}
__device__ __forceinline__ float wave_max(float v) {
#pragma unroll
    for (int o = 1; o < 64; o <<= 1) v = fmaxf(v, __shfl_xor(v, o));
    return v;
}
__device__ __forceinline__ int crow(int reg, int h) { return (reg & 3) + 8 * (reg >> 2) + 4 * h; }
__device__ __forceinline__ int rel_bucket(int dd) {
    if (dd < 16) return dd;
    const float d = (float)dd;
    int large = 16 + (int)(logf(d * (1.0f / 16.0f)) / logf(128.0f) * 16.0f);
    return large < 31 ? large : 31;
}
#define MFMA32(a, b, c) __builtin_amdgcn_mfma_f32_32x32x16_bf16((a), (b), (c), 0, 0, 0)

struct Epi {
    static constexpr bool PERM = true, AFTER_DRAIN = false;
    int mode;
    const float* rs; bf16_t* o0; bf16_t* o1; bf16_t* o2; float* ssqp; float* outp;
    __device__ __forceinline__ void operator()(const f32x4 (&acc)[2][2][4][2], const pg8::Unit& u, int wr, int wc, int fr, int fq) const {
        const int row0 = u.pm * 256 + wr * 64 + fr, colt = u.pn * 256, cw = wc * 32 + 8 * fq;
        if (mode == 1) {
#pragma unroll
            for (int ai = 0; ai < 2; ++ai)
#pragma unroll
                for (int m = 0; m < 4; ++m) {
                    const int row = row0 + ai * 128 + m * 16; float ss = 0.f;
#pragma unroll
                    for (int bj = 0; bj < 2; ++bj) {
                        const f32x4 v0 = acc[ai][bj][m][0], v1 = acc[ai][bj][m][1];
                        ss += (v0[0] * v0[0] + v0[1] * v0[1]) + (v0[2] * v0[2] + v0[3] * v0[3]) + (v1[0] * v1[0] + v1[1] * v1[1]) + (v1[2] * v1[2] + v1[3] * v1[3]);
                        u32x4 w; w.x = pk2(v0[0], v0[1]); w.y = pk2(v0[2], v0[3]); w.z = pk2(v1[0], v1[1]); w.w = pk2(v1[2], v1[3]);
                        *(u32x4*)(o0 + (size_t)row * 4096 + colt + bj * 128 + cw) = w;
                    }
                    ss += __shfl_xor(ss, 16); ss += __shfl_xor(ss, 32);
                    if (fq == 0) ssqp[(size_t)row * 64 + u.pn * 4 + wc] = ss;
                }
            return;
        }
        bf16_t* dst; int ld, col; bool act = false, kv = false;
        if (mode == 0) { ld = 4096; if (colt < 4096) { dst = o0; col = colt; } else { dst = o1; col = colt - 4096; act = true; } }
        else { if (colt < 6144) { dst = o0; ld = 6144; col = colt; } else if (colt < 8192) { dst = o1; ld = 2048; col = colt - 6144; act = true; } else { dst = o2; ld = 3072; col = colt - 8192; kv = true; } }
#pragma unroll
        for (int ai = 0; ai < 2; ++ai)
#pragma unroll
            for (int m = 0; m < 4; ++m) {
                const int row = row0 + ai * 128 + m * 16; const float r = rs[row];
#pragma unroll
                for (int bj = 0; bj < 2; ++bj) {
                    f32x4 v0 = acc[ai][bj][m][0] * r, v1 = acc[ai][bj][m][1] * r;
                    if (act) {
#pragma unroll
                        for (int j = 0; j < 4; ++j) { v0[j] = silu_f(v0[j]); v1[j] = silu_f(v1[j]); }
                    }
                    u32x4 w; w.x = pk2(v0[0], v0[1]); w.y = pk2(v0[2], v0[3]); w.z = pk2(v1[0], v1[1]); w.w = pk2(v1[2], v1[3]);
                    const int cc = col + bj * 128 + cw;
                    *(u32x4*)(dst + (size_t)row * ld + cc) = w;
                    if (kv) {
                        const int g = cc >> 10, rem = cc & 1023, keep = 128 << (2 * g), n = row >> 11, t = row & 2047;
                        if (t >= 2048 - keep) {
                            const size_t ob = (g == 0 ? OUT_PKV0 : (g == 1 ? OUT_PKV1 : OUT_PKV2)) + ((size_t)(n * keep + (t - (2048 - keep))) * 1024 + rem);
                            *(f32x4*)(outp + ob) = v0; *(f32x4*)(outp + ob + 4) = v1;
                        }
                    }
                }
            }
    }
};

__device__ __forceinline__ void transpose_item(const float* W, int K, int N, bf16_t* WT, const float* gain, LAS float* scr, int item, int lane) {
    const int nblk = N / 32, kb = item / nblk, nb = item % nblk, k0 = 64 * kb, n0 = 32 * nb;
#pragma unroll 8
    for (int i = 0; i < 32; ++i) { const int kk = 2 * i + (lane >> 5); float v = W[(size_t)(k0 + kk) * N + n0 + (lane & 31)]; if (gain) v *= gain[k0 + kk]; scr[kk * 33 + (lane & 31)] = v; }
    LDS_WAIT();
    const int c = lane & 7;
#pragma unroll
    for (int j = 0; j < 4; ++j) { const int n = (lane >> 3) + 8 * j; const LAS float* s = scr + (8 * c) * 33 + n;
        u32x4 o; o.x = pk2(s[0 * 33], s[1 * 33]); o.y = pk2(s[2 * 33], s[3 * 33]); o.z = pk2(s[4 * 33], s[5 * 33]); o.w = pk2(s[6 * 33], s[7 * 33]);
        *(u32x4*)(WT + (size_t)(n0 + n) * K + k0 + 8 * c) = o; }
    LDS_WAIT();
}

__device__ __forceinline__ void prep_phase(const Params& P, LAS unsigned char* lds) {
    const KParams Pk = kparams();
    int tid = threadIdx.x; asm volatile("" : "+v"(tid));
    const int lane = tid & 63, w = __builtin_amdgcn_readfirstlane(tid >> 6);
    const int gw = blockIdx.x * 8 + w, NGW = gridDim.x * 8;
    unsigned char* ws = Pk->ws;
    { u64* gr = (u64*)(ws + O_GRAN); const size_t n = (8 * MiB) / 8; for (size_t i = (size_t)blockIdx.x * 512 + tid; i < n; i += (size_t)gridDim.x * 512) gr[i] = 0ull; }
    { bf16_t* XBF = (bf16_t*)(ws + O_XBF); float* RS = (float*)(ws + O_RS);
      for (int row = gw; row < TP + 8; row += NGW) {
          const float* xr = row < TP ? Pk->in[0] + (size_t)row * DM : Pk->in[1] + (size_t)(row - TP) * DM;
          const f32x4* x4 = (const f32x4*)xr + lane; f32x4 v[16]; float s = 0.f;
#pragma unroll
          for (int j = 0; j < 16; ++j) { v[j] = x4[64 * j]; s += (v[j].x * v[j].x + v[j].y * v[j].y) + (v[j].z * v[j].z + v[j].w * v[j].w); }
          s = wave_sum(s);
          u32x2* o = (u32x2*)(XBF + (size_t)row * DM) + lane;
#pragma unroll
          for (int j = 0; j < 16; ++j) { u32x2 q; q.x = pk2(v[j].x, v[j].y); q.y = pk2(v[j].z, v[j].w); o[64 * j] = q; }
          if (lane == 0) RS[row] = rsqrtf(s * (1.0f / DM) + EPSN);
      } }
    for (int g = 0; g < 3; ++g) {
        const int lb = 128 << (2 * g); const size_t per = (size_t)(lb - 1) * 256, tot = 8 * per;
        const f32x4* src = (const f32x4*)Pk->in[4 + g]; f32x4* dst = (f32x4*)(Pk->out + (g == 0 ? OUT_SKV0 : (g == 1 ? OUT_SKV1 : OUT_SKV2)));
        for (size_t i = (size_t)blockIdx.x * 512 + tid; i < tot; i += (size_t)gridDim.x * 512) { const size_t b = i / per, o = i - b * per; dst[b * (size_t)lb * 256 + o] = src[b * (size_t)lb * 256 + 256 + o]; }
    }
    LAS float* scr = (LAS float*)(lds + w * 8448);
    constexpr int I_AIN = 64 * 256, I_AOUT = 64 * 128, I_KV = 64 * 96, I_BOUT = 32 * 128, I_G = 32;
    constexpr int NITEMS = 2 * I_AIN + 2 * I_AOUT + I_AIN + I_KV + I_AIN + 2 * I_BOUT + 64 * I_G;
    for (int it = gw; it < NITEMS; it += NGW) {
        int r = it;
        if (r < 2 * I_AIN) { const int l = r / I_AIN; transpose_item(Pk->in[8] + (size_t)l * 4096 * 8192, 4096, 8192, (bf16_t*)(ws + O_BT1) + (size_t)l * 8192 * 4096, Pk->in[7] + l * 4096, scr, r % I_AIN, lane); continue; } r -= 2 * I_AIN;
        if (r < 2 * I_AOUT) { const int l = r / I_AOUT; transpose_item(Pk->in[16] + (size_t)l * 4096 * 4096, 4096, 4096, (bf16_t*)(ws + O_BT2) + (size_t)l * 4096 * 4096, nullptr, scr, r % I_AOUT, lane); continue; } r -= 2 * I_AOUT;
        if (r < I_AIN) { transpose_item(Pk->in[22], 4096, 8192, (bf16_t*)(ws + O_BT3), Pk->in[21], scr, r, lane); continue; } r -= I_AIN;
        if (r < I_KV) { transpose_item(Pk->in[19], 4096, 3072, (bf16_t*)(ws + O_BT3) + (size_t)8192 * 4096, Pk->in[18], scr, r, lane); continue; } r -= I_KV;
        if (r < I_AIN) { transpose_item(Pk->in[22] + (size_t)4096 * 8192, 4096, 8192, (bf16_t*)(ws + O_BT4), Pk->in[21] + 4096, scr, r, lane); continue; } r -= I_AIN;
        if (r < 2 * I_BOUT) { const int l = r / I_BOUT; transpose_item(Pk->in[23] + (size_t)l * 2048 * 4096, 2048, 4096, (bf16_t*)(ws + O_BT5) + (size_t)l * 4096 * 2048, nullptr, scr, r % I_BOUT, lane); continue; } r -= 2 * I_BOUT;
        { const int mat = r / I_G, gate = mat & 1, lh = mat >> 1;
          transpose_item((gate ? Pk->in[13] : Pk->in[11]) + (size_t)lh * 65536, 256, 256, (bf16_t*)(ws + O_WG) + (size_t)(lh * 2 + gate) * 65536, nullptr, scr, r % I_G, lane); }
    }
}

template <int KSTEPS>
__device__ __forceinline__ void skinny_phase(const bf16_t* A, const bf16_t* Bt, int N, int K, float* sout, LAS unsigned char* lds) {
    int tid = threadIdx.x; asm volatile("" : "+v"(tid));
    const int lane = tid & 63, w = __builtin_amdgcn_readfirstlane(tid >> 6), fr = lane & 15, fq = lane >> 4;
    LAS float* red = (LAS float*)lds;
    const int ngroups = N / 16, k0 = w * (KSTEPS * 32);
    for (int grp = blockIdx.x; grp < ngroups; grp += gridDim.x) {
        const int n0 = grp * 16;
        const bf16_t* ap = A + (size_t)(fr & 7) * K + k0 + fq * 8; const bf16_t* bp = Bt + (size_t)(n0 + fr) * K + k0 + fq * 8;
        bf16x8 a[KSTEPS], b[KSTEPS];
#pragma unroll
        for (int s = 0; s < KSTEPS; ++s) { b[s] = __builtin_nontemporal_load((const bf16x8*)(bp + s * 32)); a[s] = *(const bf16x8*)(ap + s * 32); }
        f32x4 acc = {0.f, 0.f, 0.f, 0.f};
#pragma unroll
        for (int s = 0; s < KSTEPS; ++s) { if (fr >= 8) a[s] = (bf16x8){0, 0, 0, 0, 0, 0, 0, 0}; acc = __builtin_amdgcn_mfma_f32_16x16x32_bf16(a[s], b[s], acc, 0, 0, 0); }
        __syncthreads();
        if (fq < 2) {
#pragma unroll
            for (int i = 0; i < 4; ++i) red[(w * 8 + fq * 4 + i) * 16 + fr] = acc[i];
        }
        __syncthreads();
        if (tid < 128) { float s = 0.f;
#pragma unroll
            for (int ww = 0; ww < 8; ++ww) s += red[ww * 128 + tid];
            sout[(size_t)(tid >> 4) * N + n0 + (tid & 15)] = s; }
    }
}
__device__ __forceinline__ float part_sum(const float* sout, int N, int b, int col) { return sout[(size_t)b * N + col]; }

constexpr int SROW = 528;
__device__ __forceinline__ void scan_tile(const Params& P, LAS unsigned char* lds, int l, int tile) {
    const KParams Pk = kparams();
    int tid = threadIdx.x; asm volatile("" : "+v"(tid));
    const int lane = tid & 63, w = __builtin_amdgcn_readfirstlane(tid >> 6), hh = lane >> 5, l32 = lane & 31;
    LAS unsigned char* RAW = lds;
    LAS unsigned char* AT = lds + 35840;
    unsigned char* ws = Pk->ws;
    const bf16_t* XB = (const bf16_t*)(ws + P_XB); const bf16_t* SG = (const bf16_t*)(ws + P_SG); bf16_t* HG = (bf16_t*)(ws + P_HG);
    const float* PART = (const float*)(ws + O_PART); const float* RS = (const float*)(ws + O_RS);
    const bool is_s = tile < 16;
    int head, n = 0, sp = 0;
    if (is_s) head = tile; else { const int idx = tile - 16; sp = idx >> 6; n = (idx >> 4) & 3; head = idx & 15; }
    const int r0 = n * 2048 + sp * 64, gc0 = head * 256;
    const float* cwp = Pk->in[9] + (size_t)l * 4 * 4096; const float* cbp = Pk->in[10] + (size_t)l * 4096;
    __syncthreads();
    if (is_s) {
        const int b = tid >> 6, ch = (tid & 63) * 4; const float rsb = RS[TP + b];
        float xc[4][4];
#pragma unroll
        for (int e = 0; e < 4; ++e) {
            const int gc = gc0 + ch + e;
#pragma unroll
            for (int k = 0; k < 3; ++k) xc[k][e] = Pk->in[2][((size_t)(l * 8 + b) * 3 + k) * 4096 + gc];
            xc[3][e] = rsb * part_sum(PART, 8192, b, gc);
        }
        float o[4];
#pragma unroll
        for (int e = 0; e < 4; ++e) {
            const int gc = gc0 + ch + e; float v = cbp[gc];
#pragma unroll
            for (int k = 0; k < 4; ++k) v += xc[k][e] * cwp[k * 4096 + gc];
            o[e] = v;
#pragma unroll
            for (int k = 0; k < 3; ++k) Pk->out[OUT_SCONV + ((size_t)(l * 8 + b) * 3 + k) * 4096 + gc] = xc[k + 1][e];
        }
        u32x2 q; q.x = pk2(o[0], o[1]); q.y = pk2(o[2], o[3]);
        *(LAS u32x2*)(AT + b * SROW + ch * 2) = q;
    } else {
#pragma unroll
        for (int j = 0; j < 5; ++j) {
            const int id = tid + 512 * j, i = id >> 5, c8 = id & 31;
            if (i < 67) {
                u32x4 v = {0u, 0u, 0u, 0u};
                if (!(sp == 0 && i < 3)) v = *(const u32x4*)(XB + (size_t)(r0 - 3 + i) * 4096 + gc0 + c8 * 8);
                *(LAS u32x4*)(RAW + i * SROW + c8 * 16) = v;
            }
        }
        __syncthreads();
        const int c8 = tid & 31; float wk[4][8], bb[8];
#pragma unroll
        for (int e = 0; e < 8; ++e) { bb[e] = cbp[gc0 + c8 * 8 + e];
#pragma unroll
            for (int k = 0; k < 4; ++k) wk[k][e] = cwp[k * 4096 + gc0 + c8 * 8 + e]; }
#pragma unroll
        for (int j = 0; j < 4; ++j) {
            const int i = (tid >> 5) + 16 * j;
            float o[8];
#pragma unroll
            for (int e = 0; e < 8; ++e) o[e] = bb[e];
            u32x4 last;
#pragma unroll
            for (int k = 0; k < 4; ++k) {
                const u32x4 v = *(const LAS u32x4*)(RAW + (i + k) * SROW + c8 * 16); last = v;
                o[0] += bflo(v.x) * wk[k][0]; o[1] += bfhi(v.x) * wk[k][1]; o[2] += bflo(v.y) * wk[k][2]; o[3] += bfhi(v.y) * wk[k][3];
                o[4] += bflo(v.z) * wk[k][4]; o[5] += bfhi(v.z) * wk[k][5]; o[6] += bflo(v.w) * wk[k][6]; o[7] += bfhi(v.w) * wk[k][7];
            }
            u32x4 q; q.x = pk2(o[0], o[1]); q.y = pk2(o[2], o[3]); q.z = pk2(o[4], o[5]); q.w = pk2(o[6], o[7]);
            *(LAS u32x4*)(AT + i * SROW + c8 * 16) = q;
            if (sp == 31 && i >= 61) {
                float* d = Pk->out + OUT_PCONV + ((size_t)(l * 4 + n) * 3 + (i - 61)) * 4096 + gc0 + c8 * 8;
                f32x4 a = {bflo(last.x), bfhi(last.x), bflo(last.y), bfhi(last.y)}, b = {bflo(last.z), bfhi(last.z), bflo(last.w), bfhi(last.w)};
                *(f32x4*)d = a; *(f32x4*)(d + 4) = b;
            }
        }
    }
    __syncthreads();
    f32x16 aR[2], aI[2];
#pragma unroll
    for (int mt = 0; mt < 2; ++mt)
#pragma unroll
        for (int e = 0; e < 16; ++e) { aR[mt][e] = 0.f; aI[mt][e] = 0.f; }
    {
        const bf16_t* wrp = (const bf16_t*)(ws + O_WG) + (size_t)((l * 16 + head) * 2) * 65536 + (size_t)(w * 32 + l32) * 256 + hh * 8;
        const bf16_t* wip = wrp + 65536;
#pragma unroll 4
        for (int ks = 0; ks < 16; ++ks) {
            const bf16x8 bR = *(const bf16x8*)(wrp + ks * 16), bI = *(const bf16x8*)(wip + ks * 16);
#pragma unroll
            for (int mt = 0; mt < 2; ++mt) {
                const bf16x8 a = *(const LAS bf16x8*)(AT + (mt * 32 + l32) * SROW + (ks * 16 + hh * 8) * 2);
                aR[mt] = MFMA32(a, bR, aR[mt]); aI[mt] = MFMA32(a, bI, aI[mt]);
            }
        }
    }
    const int ch = w * 32 + l32, gch = gc0 + ch;
    const float bga = Pk->in[12][(size_t)l * 4096 + gch], bgx = Pk->in[14][(size_t)l * 4096 + gch];
    const float lamc = -8.0f * log1pf(expf(-Pk->in[15][(size_t)l * 4096 + gch]));
#pragma unroll
    for (int mt = 0; mt < 2; ++mt)
#pragma unroll
        for (int reg = 0; reg < 16; ++reg) {
            const int row = mt * 32 + crow(reg, hh);
            const float r = sigm_f(aR[mt][reg] + bga), ig = sigm_f(aI[mt][reg] + bgx);
            const float la = lamc * r, a = __expf(la);
            const float em = fmaf(-a, a, 1.0f);
            const float xf = bf2f(*(const LAS bf16_t*)(AT + row * SROW + ch * 2));
            aR[mt][reg] = a; aI[mt][reg] = __builtin_amdgcn_sqrtf(em) * ig * xf;
            if ((reg & 3) == 3) __builtin_amdgcn_sched_barrier(0);
        }
    if (is_s) {
#pragma unroll
        for (int j = 0; j < 4; ++j) {
            const int b = j + 4 * hh;
            const float h0 = Pk->in[3][(size_t)(l * 8 + b) * 4096 + gch];
            const float h = aR[0][j] * h0 + aI[0][j];
            Pk->out[OUT_SH + (size_t)(l * 8 + b) * 4096 + gch] = h;
            const float sg = silu_f(RS[TP + b] * part_sum(PART, 8192, b, 4096 + gch));
            HG[(size_t)(TP + b) * 4096 + gch] = (bf16_t)(pk2(h * sg, 0.f) & 0xffffu);
        }
        return;
    }
    float Pp = 1.f, Cc = 0.f;
#pragma unroll
    for (int mt = 0; mt < 2; ++mt)
#pragma unroll
        for (int g = 0; g < 4; ++g) {
            float A = aR[mt][4 * g], H = aI[mt][4 * g];
#pragma unroll
            for (int j = 1; j < 4; ++j) { const float a = aR[mt][4 * g + j], b = aI[mt][4 * g + j]; H = a * H + b; A = A * a; aR[mt][4 * g + j] = A; aI[mt][4 * g + j] = H; }
            const float pA = __shfl_xor(A, 32), pH = __shfl_xor(H, 32);
            const float s0a = hh ? pA : A, s0b = hh ? pH : H, s1a = hh ? A : pA, s1b = hh ? H : pH;
            const float P1 = Pp * s0a, C1 = s0a * Cc + s0b;
            const float Pm = hh ? P1 : Pp, Cm = hh ? C1 : Cc;
#pragma unroll
            for (int j = 0; j < 4; ++j) { aI[mt][4 * g + j] += aR[mt][4 * g + j] * Cm; aR[mt][4 * g + j] *= Pm; }
            Pp = P1 * s1a; Cc = s1a * C1 + s1b;
        }
    u64* gr = (u64*)(ws + O_GRAN) + ((((size_t)l * 4 + n) * 32 + sp) * 16 + head) * 256 + ch;
    const unsigned tag = 1u + (unsigned)l;
    float H0 = 0.f;
    if (sp > 0) {
        const u64* pg = gr - 16 * 256; u64 x = 0; unsigned spins = 0;
        for (;;) {
            x = __hip_atomic_load(pg, __ATOMIC_RELAXED, __HIP_MEMORY_SCOPE_AGENT);
            if (__all((unsigned)(x >> 32) == tag)) break;
            if (++spins > (1u << 22)) break;
            __builtin_amdgcn_s_sleep(1);
        }
        H0 = __uint_as_float((unsigned)x);
    }
    const float hend = Cc + Pp * H0;
    if (hh == 0) {
        __hip_atomic_store(gr, ((u64)tag << 32) | (u64)__float_as_uint(hend), __ATOMIC_RELAXED, __HIP_MEMORY_SCOPE_AGENT);
        if (sp == 31) Pk->out[OUT_PH + (size_t)(l * 4 + n) * 4096 + gch] = hend;
    }
    __syncthreads();
#pragma unroll
    for (int mt = 0; mt < 2; ++mt)
#pragma unroll
        for (int reg = 0; reg < 16; ++reg) {
            const int row = mt * 32 + crow(reg, hh);
            const float h = aI[mt][reg] + aR[mt][reg] * H0;
            *(LAS bf16_t*)(AT + row * SROW + ch * 2) = (bf16_t)(pk2(h, 0.f) & 0xffffu);
        }
    __syncthreads();
    {
        const int c8 = tid & 31;
#pragma unroll
        for (int j = 0; j < 4; ++j) {
            const int i = (tid >> 5) + 16 * j;
            const u32x4 hv = *(const LAS u32x4*)(AT + i * SROW + c8 * 16);
            const size_t go = (size_t)(r0 + i) * 4096 + gc0 + c8 * 8;
            const u32x4 sv = *(const u32x4*)(SG + go);
            u32x4 q; q.x = pk2(bflo(hv.x) * bflo(sv.x), bfhi(hv.x) * bfhi(sv.x)); q.y = pk2(bflo(hv.y) * bflo(sv.y), bfhi(hv.y) * bfhi(sv.y));
            q.z = pk2(bflo(hv.z) * bflo(sv.z), bfhi(hv.z) * bfhi(sv.z)); q.w = pk2(bflo(hv.w) * bflo(sv.w), bfhi(hv.w) * bfhi(sv.w));
            *(u32x4*)(HG + go) = q;
        }
    }
}

__device__ __forceinline__ void post_phase(const Params& P, int L) {
    const KParams Pk = kparams();
    int tid = threadIdx.x; asm volatile("" : "+v"(tid));
    const int lane = tid & 63, w = __builtin_amdgcn_readfirstlane(tid >> 6);
    const int gw = blockIdx.x * 8 + w, NGW = gridDim.x * 8;
    unsigned char* ws = Pk->ws;
    const float* gain = L < 2 ? Pk->in[17] + (size_t)L * 4096 : Pk->in[24] + (size_t)(L - 2) * 4096;
    const bf16_t* Y = (const bf16_t*)(ws + O_Y); const float* SSQP = (const float*)(ws + O_SSQP); const float* PART = (const float*)(ws + O_PART);
    bf16_t* XBF = (bf16_t*)(ws + O_XBF); float* RS = (float*)(ws + O_RS);
    for (int row = gw; row < TP + 8; row += NGW) {
        if (row < TP) {
            const float* xin = (L == 0 ? Pk->in[0] : Pk->out + OUT_YP) + (size_t)row * 4096; float* xout = Pk->out + OUT_YP + (size_t)row * 4096;
            const float rsn = rsqrtf(wave_sum(SSQP[(size_t)row * 64 + lane]) * (1.0f / 4096.0f) + EPSN);
            float acc = 0.f;
#pragma unroll
            for (int j = 0; j < 8; ++j) {
                const int col = j * 512 + lane * 8;
                const u32x4 yv = *(const u32x4*)(Y + (size_t)row * 4096 + col);
                const f32x4 x0 = *(const f32x4*)(xin + col), x1 = *(const f32x4*)(xin + col + 4), g0 = *(const f32x4*)(gain + col), g1 = *(const f32x4*)(gain + col + 4);
                f32x4 y0 = {bflo(yv.x), bfhi(yv.x), bflo(yv.y), bfhi(yv.y)}, y1 = {bflo(yv.z), bfhi(yv.z), bflo(yv.w), bfhi(yv.w)};
                const f32x4 n0 = x0 + y0 * rsn * g0, n1 = x1 + y1 * rsn * g1;
                acc += (n0.x * n0.x + n0.y * n0.y) + (n0.z * n0.z + n0.w * n0.w) + (n1.x * n1.x + n1.y * n1.y) + (n1.z * n1.z + n1.w * n1.w);
                *(f32x4*)(xout + col) = n0; *(f32x4*)(xout + col + 4) = n1;
                u32x4 q; q.x = pk2(n0.x, n0.y); q.y = pk2(n0.z, n0.w); q.z = pk2(n1.x, n1.y); q.w = pk2(n1.z, n1.w);
                *(u32x4*)(XBF + (size_t)row * 4096 + col) = q;
            }
            acc = wave_sum(acc);
            if (lane == 0) RS[row] = rsqrtf(acc * (1.0f / 4096.0f) + EPSN);
        } else {
            const int b = row - TP;
            const float* xin = (L == 0 ? Pk->in[1] : Pk->out + OUT_YS) + (size_t)b * 4096; float* xout = Pk->out + OUT_YS + (size_t)b * 4096;
            float ss = 0.f;
            for (int j = 0; j < 8; ++j)
#pragma unroll
                for (int e = 0; e < 8; ++e) { const float y = part_sum(PART, 4096, b, j * 512 + lane * 8 + e); ss += y * y; }
            const float rsn = rsqrtf(wave_sum(ss) * (1.0f / 4096.0f) + EPSN);
            float acc = 0.f;
            for (int j = 0; j < 8; ++j) {
                const int col = j * 512 + lane * 8; float nv[8];
#pragma unroll
                for (int e = 0; e < 8; ++e) { const float y = part_sum(PART, 4096, b, col + e); nv[e] = xin[col + e] + y * rsn * gain[col + e]; acc += nv[e] * nv[e]; xout[col + e] = nv[e]; }
                u32x4 q; q.x = pk2(nv[0], nv[1]); q.y = pk2(nv[2], nv[3]); q.z = pk2(nv[4], nv[5]); q.w = pk2(nv[6], nv[7]);
                *(u32x4*)(XBF + (size_t)row * 4096 + col) = q;
            }
            acc = wave_sum(acc);
            if (lane == 0) RS[row] = rsqrtf(acc * (1.0f / 4096.0f) + EPSN);
        }
    }
}

constexpr int KROW = 272, VROW = 320, OFF_VS = 69632, OFF_BI = OFF_VS + 81920, OFF_SW = OFF_BI + 2112;
__device__ __forceinline__ void attn_item(const Params& P, LAS unsigned char* lds, int item) {
    const KParams Pk = kparams();
    int tid = threadIdx.x; asm volatile("" : "+v"(tid));
    const int lane = tid & 63, w = __builtin_amdgcn_readfirstlane(tid >> 6), hh = lane >> 5, l32 = lane & 31;
    unsigned char* ws = Pk->ws;
    const bf16_t* Q = (const bf16_t*)(ws + P_Q); const bf16_t* KVB = (const bf16_t*)(ws + O_KVB); bf16_t* ON = (bf16_t*)(ws + P_ON); float* LSE = (float*)(ws + O_LSE);
    const int g = item >> 8, rem = item & 255, n = rem >> 6, kvh = rem & 3, cb = (rem >> 2) & 15;
    const int r = 1 << (2 * g), nb = 16 >> (2 * g), c = cb / nb, nbi = cb % nb;
    LAS unsigned char* Ks = lds; LAS unsigned char* Vs = lds + OFF_VS; LAS float* BI = (LAS float*)(lds + OFF_BI);
    __syncthreads();
#pragma unroll
    for (int j = 0; j < 8; ++j) {
        const int id = tid + 512 * j, kk = id >> 4, chk = id & 15, pos = (nbi - 1) * 128 + kk;
        u32x4 kv = {0u, 0u, 0u, 0u}, vv = {0u, 0u, 0u, 0u};
        if (pos >= 0) { const bf16_t* src = KVB + (size_t)(n * 2048 + pos * r + c) * 3072 + g * 1024 + kvh * 128 + chk * 8; kv = *(const u32x4*)src; vv = *(const u32x4*)(src + 512); }
        *(LAS u32x4*)(Ks + kk * KROW + chk * 16) = kv; *(LAS u32x4*)(Vs + kk * VROW + chk * 16) = vv;
    }
    for (int e = tid; e < 516; e += 512) { const int hl = e / 129, dist = e % 129; BI[hl * 132 + dist] = Pk->in[20][rel_bucket(dist * r) * 48 + g * 16 + kvh * 4 + hl]; }
    __syncthreads();
    const float scale = 0.08838834764831845f;
    for (int pp = 0; pp < 2; ++pp) {
        const int pair = w + 8 * pp, hl = pair >> 2, qc = pair & 3, slot = kvh * 4 + hl;
        const int qq = qc * 32 + l32, qrow = n * 2048 + (nbi * 128 + qq) * r + c;
        bf16x8 Qf[8];
        { const bf16_t* qp = Q + (size_t)qrow * 6144 + g * 2048 + slot * 128 + hh * 8;
#pragma unroll
          for (int s = 0; s < 8; ++s) Qf[s] = *(const bf16x8*)(qp + s * 16); }
        f32x16 S[5];
#pragma unroll
        for (int kt = 0; kt < 5; ++kt) {
#pragma unroll
            for (int e = 0; e < 16; ++e) S[kt][e] = 0.f;
#pragma unroll
            for (int s = 0; s < 8; ++s) {
                const bf16x8 a = *(const LAS bf16x8*)(Ks + (qc * 32 + kt * 32 + l32) * KROW + (s * 16 + hh * 8) * 2);
                S[kt] = MFMA32(a, Qf[s], S[kt]);
            }
            __builtin_amdgcn_sched_barrier(0);
        }
        float m = -INFINITY;
#pragma unroll
        for (int kt = 0; kt < 5; ++kt)
#pragma unroll
            for (int reg = 0; reg < 16; ++reg) {
                const int kk = qc * 32 + kt * 32 + crow(reg, hh), dist = 128 + qq - kk;
                const bool valid = dist >= 0 && dist <= 128 && (nbi > 0 || kk >= 128);
                const int dcl = dist < 0 ? 0 : (dist > 128 ? 128 : dist);
                const float sv = valid ? S[kt][reg] * scale + BI[hl * 132 + dcl] : -INFINITY;
                S[kt][reg] = sv; m = fmaxf(m, sv);
                if ((reg & 3) == 3) __builtin_amdgcn_sched_barrier(0);
            }
        m = fmaxf(m, __shfl_xor(m, 32));
        float den = 0.f;
#pragma unroll
        for (int kt = 0; kt < 5; ++kt)
#pragma unroll
            for (int reg = 0; reg < 16; ++reg) { const float p = __expf(S[kt][reg] - m); S[kt][reg] = p; den += p; }
        den += __shfl_xor(den, 32);
        f32x16 O[4];
#pragma unroll
        for (int dt = 0; dt < 4; ++dt)
#pragma unroll
            for (int e = 0; e < 16; ++e) O[dt][e] = 0.f;
        const int q_ = (lane & 15) >> 2, p_ = lane & 3, cg16 = (lane >> 4) & 1;
#pragma unroll
        for (int kt = 0; kt < 5; ++kt)
#pragma unroll
            for (int s2 = 0; s2 < 2; ++s2) {
                u32x4 pw; pw.x = pk2(S[kt][8 * s2 + 0], S[kt][8 * s2 + 1]); pw.y = pk2(S[kt][8 * s2 + 2], S[kt][8 * s2 + 3]); pw.z = pk2(S[kt][8 * s2 + 4], S[kt][8 * s2 + 5]); pw.w = pk2(S[kt][8 * s2 + 6], S[kt][8 * s2 + 7]);
                const bf16x8 pf = __builtin_bit_cast(bf16x8, pw);
                const int R0 = qc * 32 + kt * 32 + 16 * s2 + 4 * hh;
#pragma unroll
                for (int dt = 0; dt < 4; ++dt) {
                    LAS unsigned char* ad = Vs + (R0 + q_) * VROW + (dt * 32 + 16 * cg16 + 4 * p_) * 2;
                    const s16x4 lo = __builtin_amdgcn_ds_read_tr16_b64_v4i16((LAS s16x4*)ad), hi = __builtin_amdgcn_ds_read_tr16_b64_v4i16((LAS s16x4*)(ad + 8 * VROW));
                    bf16x8 a; a[0] = lo[0]; a[1] = lo[1]; a[2] = lo[2]; a[3] = lo[3]; a[4] = hi[0]; a[5] = hi[1]; a[6] = hi[2]; a[7] = hi[3];
                    O[dt] = MFMA32(a, pf, O[dt]);
                }
                __builtin_amdgcn_sched_barrier(0);
            }
        const float inv = 1.0f / den;
        bf16_t* op = ON + ((size_t)g * RP + qrow) * 2048 + slot * 128 + 4 * hh;
#pragma unroll
        for (int dt = 0; dt < 4; ++dt)
#pragma unroll
            for (int g4 = 0; g4 < 4; ++g4) {
                u32x2 q; q.x = pk2(O[dt][4 * g4] * inv, O[dt][4 * g4 + 1] * inv); q.y = pk2(O[dt][4 * g4 + 2] * inv, O[dt][4 * g4 + 3] * inv);
                *(u32x2*)(op + dt * 32 + 8 * g4) = q;
            }
        if (hh == 0) LSE[((size_t)g * RP + qrow) * 16 + slot] = m + __logf(den);
    }
}

__device__ __forceinline__ void sample_attn(const Params& P, LAS unsigned char* lds, int si, int lbi, int wv) {
    const KParams Pk = kparams();
    int tid = threadIdx.x; asm volatile("" : "+v"(tid));
    const int lane = tid & 63;
    unsigned char* ws = Pk->ws;
    const float* PART = (const float*)(ws + O_PART); const float* RS = (const float*)(ws + O_RS); bf16_t* ON = (bf16_t*)(ws + P_ON); float* LSE = (float*)(ws + O_LSE);
    const int b = si / 48, rem = si % 48, g = rem >> 4, slot = rem & 15, kvh = slot >> 2, r = 1 << (2 * g), lbuf = 128 << (2 * g);
    const int N = lbi == 0 ? 11264 : 8192;
    const float* state = Pk->in[4 + g]; float* skv = Pk->out + (g == 0 ? OUT_SKV0 : (g == 1 ? OUT_SKV1 : OUT_SKV2));
    LAS float* qs = (LAS float*)(lds + OFF_SW + wv * 2064); LAS float* pw = qs + 128; LAS float* kn = qs + 260; LAS float* vn = qs + 388;
    const float rsb = RS[TP + b];
#pragma unroll
    for (int e = 0; e < 2; ++e) {
        const int d = lane * 2 + e;
        qs[d] = rsb * part_sum(PART, N, b, g * 2048 + slot * 128 + d);
        float kvl, vvl;
        if (lbi == 0) { kvl = rsb * part_sum(PART, N, b, 8192 + g * 1024 + kvh * 128 + d); vvl = rsb * part_sum(PART, N, b, 8192 + g * 1024 + 512 + kvh * 128 + d);
            if ((slot & 3) == 0) { float* dst = skv + ((size_t)(b * lbuf + lbuf - 1) * 2) * 512 + kvh * 128 + d; dst[0] = kvl; dst[512] = vvl; } }
        else { const float* srcp = skv + ((size_t)(b * lbuf + lbuf - 1) * 2) * 512 + kvh * 128 + d; kvl = srcp[0]; vvl = srcp[512]; }
        kn[d] = kvl; vn[d] = vvl;
    }
    LDS_WAIT();
    const float scale = 0.08838834764831845f;
    float m = -INFINITY;
#pragma unroll 1
    for (int rd = 0; rd < 3; ++rd) {
        const int step = lane + 64 * rd; float s = -INFINITY;
        if (step <= 128) {
            float dot = 0.f;
            if (step == 0) {
#pragma unroll 8
                for (int d = 0; d < 128; ++d) dot += qs[d] * kn[d]; }
            else { const f32x4* kr = (const f32x4*)(state + ((size_t)(b * lbuf + lbuf - step * r) * 2) * 512 + kvh * 128);
                f32x4 kv[32];
#pragma unroll
                for (int d4 = 0; d4 < 32; ++d4) kv[d4] = kr[d4];
#pragma unroll
                for (int d4 = 0; d4 < 32; ++d4) { const f32x4 qv = *(const LAS f32x4*)(qs + d4 * 4); dot += (kv[d4].x * qv.x + kv[d4].y * qv.y) + (kv[d4].z * qv.z + kv[d4].w * qv.w); } }
            s = dot * scale + Pk->in[20][rel_bucket(step * r) * 48 + g * 16 + slot];
            pw[step] = s;
        }
        m = fmaxf(m, s);
    }
    m = wave_max(m);
    LDS_WAIT();
    float den = 0.f;
#pragma unroll
    for (int rd = 0; rd < 3; ++rd) { const int step = lane + 64 * rd; if (step <= 128) { const float p = __expf(pw[step] - m); den += p; pw[step] = p; } }
    den = wave_sum(den);
    LDS_WAIT();
    float o0 = pw[0] * vn[lane * 2], o1 = pw[0] * vn[lane * 2 + 1];
#pragma unroll 1
    for (int s0 = 1; s0 <= 128; s0 += 32) {
        f32x2 v[32];
#pragma unroll
        for (int j = 0; j < 32; ++j) v[j] = *(const f32x2*)(state + ((size_t)(b * lbuf + lbuf - (s0 + j) * r) * 2 + 1) * 512 + kvh * 128 + lane * 2);
#pragma unroll
        for (int j = 0; j < 32; ++j) { const float p = pw[s0 + j]; o0 += p * v[j].x; o1 += p * v[j].y; }
    }
    const float inv = 1.0f / den;
    *(unsigned*)(ON + ((size_t)g * RP + TP + b) * 2048 + slot * 128 + lane * 2) = pk2(o0 * inv, o1 * inv);
    if (lane == 0) LSE[((size_t)g * RP + TP + b) * 16 + slot] = m + __logf(den);
    LDS_WAIT();
}

__device__ __forceinline__ void combine_phase(const Params& P, int lbi) {
    const KParams Pk = kparams();
    int tid = threadIdx.x; asm volatile("" : "+v"(tid));
    const int lane = tid & 63, w = __builtin_amdgcn_readfirstlane(tid >> 6);
    const int gw = blockIdx.x * 8 + w, NGW = gridDim.x * 8;
    unsigned char* ws = Pk->ws;
    const bf16_t* ON = (const bf16_t*)(ws + P_ON); const float* LSE = (const float*)(ws + O_LSE); const bf16_t* SG2 = (const bf16_t*)(ws + O_SG2); bf16_t* OG = (bf16_t*)(ws + O_OG);
    const float* PART = (const float*)(ws + O_PART); const float* RS = (const float*)(ws + O_RS);
    const int N = lbi == 0 ? 11264 : 8192;
    for (int row = gw; row < TP + 8; row += NGW) {
#pragma unroll
        for (int cch = 0; cch < 4; ++cch) {
            const int col = cch * 512 + lane * 8, slot = col >> 7;
            const float l0 = LSE[((size_t)0 * RP + row) * 16 + slot], l1 = LSE[((size_t)1 * RP + row) * 16 + slot], l2 = LSE[((size_t)2 * RP + row) * 16 + slot];
            const float mx = fmaxf(l0, fmaxf(l1, l2)); float w0 = __expf(l0 - mx), w1 = __expf(l1 - mx), w2 = __expf(l2 - mx);
            const float iw = 1.0f / (w0 + w1 + w2); w0 *= iw; w1 *= iw; w2 *= iw;
            const u32x4 a0 = *(const u32x4*)(ON + ((size_t)0 * RP + row) * 2048 + col), a1 = *(const u32x4*)(ON + ((size_t)1 * RP + row) * 2048 + col), a2 = *(const u32x4*)(ON + ((size_t)2 * RP + row) * 2048 + col);
            float gt[8];
            if (row < TP) { const u32x4 sv = *(const u32x4*)(SG2 + (size_t)row * 2048 + col);
                gt[0] = bflo(sv.x); gt[1] = bfhi(sv.x); gt[2] = bflo(sv.y); gt[3] = bfhi(sv.y); gt[4] = bflo(sv.z); gt[5] = bfhi(sv.z); gt[6] = bflo(sv.w); gt[7] = bfhi(sv.w); }
            else { const int b = row - TP; const float rsb = RS[row];
#pragma unroll
                for (int e = 0; e < 8; ++e) gt[e] = silu_f(rsb * part_sum(PART, N, b, 6144 + col + e)); }
            float o[8];
            o[0] = w0 * bflo(a0.x) + w1 * bflo(a1.x) + w2 * bflo(a2.x); o[1] = w0 * bfhi(a0.x) + w1 * bfhi(a1.x) + w2 * bfhi(a2.x);
            o[2] = w0 * bflo(a0.y) + w1 * bflo(a1.y) + w2 * bflo(a2.y); o[3] = w0 * bfhi(a0.y) + w1 * bfhi(a1.y) + w2 * bfhi(a2.y);
            o[4] = w0 * bflo(a0.z) + w1 * bflo(a1.z) + w2 * bflo(a2.z); o[5] = w0 * bfhi(a0.z) + w1 * bfhi(a1.z) + w2 * bfhi(a2.z);
            o[6] = w0 * bflo(a0.w) + w1 * bflo(a1.w) + w2 * bflo(a2.w); o[7] = w0 * bfhi(a0.w) + w1 * bfhi(a1.w) + w2 * bfhi(a2.w);
            u32x4 q; q.x = pk2(o[0] * gt[0], o[1] * gt[1]); q.y = pk2(o[2] * gt[2], o[3] * gt[3]); q.z = pk2(o[4] * gt[4], o[5] * gt[5]); q.w = pk2(o[6] * gt[6], o[7] * gt[7]);
            *(u32x4*)(OG + (size_t)row * 2048 + col) = q;
        }
    }
}

__global__ __launch_bounds__(512, 2) void yoco_mega(Params P) {
    extern __shared__ __attribute__((aligned(16))) unsigned char shm[];
    LAS unsigned char* lds = (LAS unsigned char*)shm;
    cg::grid_group grid = cg::this_grid();
    const KParams Pk = kparams();
    unsigned char* ws = Pk->ws;
    const int w = threadIdx.x >> 6;
    if (threadIdx.x == 0) { *(LAS u32x4*)(lds + OFF_XB) = (u32x4){0u, 0u, 0u, 0u}; }
    __syncthreads();
    const XcdBarrier xb = xcd_barrier_post((unsigned*)(ws + O_BAR), (volatile LAS unsigned*)(lds + OFF_XB));
    prep_phase(P, lds);
    grid.sync();
    for (int L = 0; L < 4; ++L) {
        for (int half = 0; half < 2; ++half) {
            pg8::Gemm gm; Epi E; gm.M = TP;
            E.rs = (const float*)(ws + O_RS); E.ssqp = (float*)(ws + O_SSQP); E.outp = Pk->out; E.o2 = (bf16_t*)(ws + O_KVB);
            if (half == 0) {
                gm.A = (const bf16_t*)(ws + O_XBF); gm.K = 4096;
                if (L < 2) { gm.Bt = (const bf16_t*)(ws + O_BT1) + (size_t)L * 8192 * 4096; gm.N = 8192; E.mode = 0; E.o0 = (bf16_t*)(ws + P_XB); E.o1 = (bf16_t*)(ws + P_SG); }
                else { gm.Bt = (const bf16_t*)(ws + (L == 2 ? O_BT3 : O_BT4)); gm.N = L == 2 ? 11264 : 8192; E.mode = 2; E.o0 = (bf16_t*)(ws + P_Q); E.o1 = (bf16_t*)(ws + O_SG2); }
            } else {
                E.mode = 1; E.o0 = (bf16_t*)(ws + O_Y); E.o1 = E.o0; gm.N = 4096;
                if (L < 2) { gm.A = (const bf16_t*)(ws + P_HG); gm.Bt = (const bf16_t*)(ws + O_BT2) + (size_t)L * 4096 * 4096; gm.K = 4096; }
                else { gm.A = (const bf16_t*)(ws + O_OG); gm.Bt = (const bf16_t*)(ws + O_BT5) + (size_t)(L - 2) * 4096 * 2048; gm.K = 2048; }
            }
            pg8::StaticOrder S; S.init(gm.M, gm.N, (int)gridDim.x, (int)blockIdx.x);
            pg8::gemm_phase<Epi, pg8::StaticOrder, false>(lds, gm, S, E, nullptr);
            __syncthreads();
            if (gm.K == 4096) skinny_phase<16>(gm.A + (size_t)TP * gm.K, gm.Bt, gm.N, gm.K, (float*)(ws + O_PART), lds);
            else skinny_phase<8>(gm.A + (size_t)TP * gm.K, gm.Bt, gm.N, gm.K, (float*)(ws + O_PART), lds);
            xcd_barrier(xb);
            if (half == 0) {
                if (L < 2) {
                    for (int t = blockIdx.x; t < 16 + 2048; t += gridDim.x) scan_tile(P, lds, L, t);
                } else {
                    for (int wv = 0; wv < 2; ++wv) { const int si = wv * 256 + (int)blockIdx.x; if (si < 384 && w == wv && gridDim.x >= 256) sample_attn(P, lds, si, L - 2, wv); }
                    if (gridDim.x < 256 && w < 2) for (int si = blockIdx.x * 2 + w; si < 384; si += gridDim.x * 2) sample_attn(P, lds, si, L - 2, w);
                    for (int it = blockIdx.x; it < 768; it += gridDim.x) attn_item(P, lds, it);
                    xcd_barrier(xb);
                    combine_phase(P, L - 2);
                }
            } else {
                post_phase(P, L);
            }
            if (!(L == 3 && half == 1)) xcd_barrier(xb);
        }
    }
}

extern "C" void kernel_launch(void* const* d_in, const int* in_sizes, int n_in, void* d_out, int out_size, void* d_ws, size_t ws_size, hipStream_t stream) {
    static int grid_blocks = 0;
    if (!grid_blocks) {
        int dev = 0, cus = 0, per_cu = 0;
        hipGetDevice(&dev);
        hipDeviceGetAttribute(&cus, hipDeviceAttributeMultiprocessorCount, dev);
        hipFuncSetAttribute((const void*)yoco_mega, hipFuncAttributeMaxDynamicSharedMemorySize, LDS_BYTES);
        if (hipOccupancyMaxActiveBlocksPerMultiprocessor(&per_cu, (const void*)yoco_mega, 512, LDS_BYTES) != hipSuccess || per_cu < 1) per_cu = 1;
        (void)hipGetLastError();
        grid_blocks = cus * per_cu;
        if (ws_size < O_END) fprintf(stderr, "kernel_launch: workspace too small: %zu < %zu\n", ws_size, (size_t)O_END);
    }
    (void)hipMemsetAsync((unsigned char*)d_ws + O_BAR, 0, XCD_BAR_WORDS * sizeof(unsigned), stream);
    Params p{};
    for (int i = 0; i < 25; ++i) p.in[i] = (const float*)d_in[i];
    p.out = (float*)d_out; p.ws = (unsigned char*)d_ws;
    void* args[] = {&p};
    hipError_t e = hipLaunchCooperativeKernel((const void*)yoco_mega, dim3(grid_blocks), dim3(512), args, LDS_BYTES, stream);
    if (e != hipSuccess) fprintf(stderr, "cooperative launch failed: %s (grid %d)\n", hipGetErrorString(e), grid_blocks);
}
```

```cpp
#include <hip/hip_runtime.h>
#include <hip/hip_cooperative_groups.h>
#include <cstdio>
namespace cg = cooperative_groups;

namespace pg8 {
#define PG8_LAS __attribute__((address_space(3)))
typedef unsigned short bf16_t;
typedef short bf16x8 __attribute__((ext_vector_type(8)));
typedef float f32x4 __attribute__((ext_vector_type(4)));
typedef unsigned u32x4 __attribute__((ext_vector_type(4)));
constexpr int BM = 256, BK = 64, HALF = 128, HTB = HALF * BK * 2, STAGE_BYTES = 8 * HTB, NXCD = 8, WGM = 8;

__host__ __device__ __forceinline__ int lds_byte(int r, int c) { const int st = (r >> 4) * 2 + (c >> 5), rr = r & 15, cc = c & 31, ob = rr * 64 + cc * 2; return st * 1024 + (ob ^ (((ob >> 9) & 1) << 5)); }
__host__ __device__ __forceinline__ void stage_rc(int b, int& R, int& C) { const int st = b / 1024, sb = b % 1024, swz = sb ^ (((sb >> 9) & 1) << 5); R = (st >> 1) * 16 + swz / 64; C = (st & 1) * 32 + (swz % 64) / 2; }
__host__ __device__ __forceinline__ int perm32(int rho) { const int n = rho >> 4, i = rho & 15; return 8 * (i >> 2) + 4 * n + (i & 3); }

struct Unit { int pm, pn; };
struct Gemm { const bf16_t* A; const bf16_t* Bt; int M, N, K; };

struct StaticOrder {
    int nM, nN, nwg, G, c;
    __host__ __device__ void init(int M, int N, int G_, int c_) { nM = M / BM; nN = N / BM; nwg = nM * nN; G = G_; c = c_; }
    __host__ __device__ bool next(int i, Unit& u) const {
        const long L = (long)i * G + c; if (L >= nwg) return false;
        int wgid = (int)L; { const int q = nwg / NXCD, r = nwg % NXCD, xcd = wgid % NXCD, off = wgid / NXCD; wgid = (xcd < r ? xcd * (q + 1) : r * (q + 1) + (xcd - r) * q) + off; }
        const int nig = WGM * nN, gid = wgid / nig, fm = gid * WGM, gsz = (nM - fm) < WGM ? (nM - fm) : WGM;
        u.pm = fm + ((wgid % nig) % gsz); u.pn = (wgid % nig) / gsz; return true;
    }
    __device__ __forceinline__ void a_ready(const Unit&) const {}
    __device__ __forceinline__ void done(const Unit&) const {}
};
template <class Epi, class Sched, bool STAMP = false>
__device__ __forceinline__ void gemm_phase(PG8_LAS unsigned char* lds, const Gemm g, const Sched& S, const Epi& E, unsigned long long* stamps) {
    int tid = threadIdx.x; asm volatile("" : "+v"(tid));
    const int wid = __builtin_amdgcn_readfirstlane(tid >> 6), lane = tid & 63, wr = wid >> 2, wc = wid & 3, fr = lane & 15, fq = lane >> 4;
    const int K = g.K, nt = K / BK;
    int ts_lo = 0, ts_hi = 0, nts = 0; const unsigned long long rt_entry = STAMP ? (unsigned long long)wall_clock64() : 0ull;
#define PG8_STAMP() do { if (STAMP && wid == 0 && nts < 64) { const unsigned long long _c = (unsigned long long)clock64(); \
        ts_lo = (lane == nts) ? (int)(unsigned)_c : ts_lo; ts_hi = (lane == nts) ? (int)(unsigned)(_c >> 32) : ts_hi; ++nts; } } while (0)
    PG8_STAMP();
    unsigned voffA[2], voffB[2];
#pragma unroll
    for (int i = 0; i < 2; ++i) { int R, C; stage_rc(tid * 16 + i * 8192, R, C); const int Rb = Epi::PERM ? ((R & ~31) + perm32(R & 31)) : R;
        voffA[i] = (unsigned)(R * K + C) * 2u; voffB[i] = (unsigned)(Rb * K + C) * 2u; }
    const size_t kstep = (size_t)(BK * 2);
    const size_t hstep = (size_t)HALF * K * 2;
    const size_t tstep = 2 * hstep;
    const unsigned ldsw = (unsigned)wid * 1024u;
    const int aoff = lds_byte(wr * 64 + fr, fq * 8), boff = lds_byte(wc * 32 + fr, fq * 8);
#define PG8_SA(b, h) (((b) * 2 + (h)) * HTB)
#define PG8_SB(b, h) ((4 + (b) * 2 + (h)) * HTB)
#define PG8_STAGE(bufoff, gbase, voff) do { _Pragma("unroll") for (int _i = 0; _i < 2; ++_i) \
        __builtin_amdgcn_global_load_lds((const unsigned*)((const char*)(gbase) + (voff)[_i]), (PG8_LAS unsigned*)(lds + (bufoff) + ldsw + _i * 8192), 16, 0, 0); } while (0)
#define PG8_LDA(dst, b, h) do { _Pragma("unroll") for (int m = 0; m < 4; ++m) _Pragma("unroll") for (int k = 0; k < 2; ++k) dst[m][k] = *(const PG8_LAS bf16x8*)(lds + PG8_SA(b, h) + aoff + m * 2048 + k * 1024); } while (0)
#define PG8_LDB(dst, b, h) do { _Pragma("unroll") for (int n = 0; n < 2; ++n) _Pragma("unroll") for (int k = 0; k < 2; ++k) dst[n][k] = *(const PG8_LAS bf16x8*)(lds + PG8_SB(b, h) + boff + n * 2048 + k * 1024); } while (0)
#define PG8_MMA(ai, bj, At, Bt) do { __builtin_amdgcn_s_setprio(1); _Pragma("unroll") for (int m = 0; m < 4; ++m) _Pragma("unroll") for (int n = 0; n < 2; ++n) _Pragma("unroll") for (int k = 0; k < 2; ++k) \
        acc[ai][bj][m][n] = __builtin_amdgcn_mfma_f32_16x16x32_bf16(Bt[n][k], At[m][k], acc[ai][bj][m][n], 0, 0, 0); __builtin_amdgcn_s_setprio(0); } while (0)
#define PG8_WAIT_V(n) asm volatile("s_waitcnt vmcnt(" #n ")" ::: "memory")
#define PG8_WAIT_L(n) asm volatile("s_waitcnt lgkmcnt(" #n ")" ::: "memory")
#define PG8_BAR __builtin_amdgcn_s_barrier()
#define PG8_SCHED __builtin_amdgcn_sched_barrier(0)
    Unit cur, nxt; int ui = 0;
    if (!S.next(0, cur)) return;
    f32x4 acc[2][2][4][2];
#pragma unroll
    for (int a = 0; a < 2; ++a)
#pragma unroll
        for (int b = 0; b < 2; ++b)
#pragma unroll
            for (int m = 0; m < 4; ++m)
#pragma unroll
                for (int n = 0; n < 2; ++n) acc[a][b][m][n] = (f32x4){0.f, 0.f, 0.f, 0.f};
    bf16x8 At[4][2], B0[2][2], B1[2][2];
    const char* cA = (const char*)g.A + (size_t)cur.pm * tstep; const char* cB = (const char*)g.Bt + (size_t)cur.pn * tstep;
    S.a_ready(cur);
    PG8_STAGE(PG8_SB(0, 0), cB, voffB); PG8_STAGE(PG8_SA(0, 0), cA, voffA); PG8_STAGE(PG8_SB(0, 1), cB + hstep, voffB); PG8_STAGE(PG8_SA(0, 1), cA + hstep, voffA);
    if (wr == 1) PG8_BAR;
    PG8_WAIT_V(4); PG8_BAR;
    PG8_STAGE(PG8_SB(1, 0), cB + kstep, voffB); PG8_STAGE(PG8_SA(1, 0), cA + kstep, voffA); PG8_STAGE(PG8_SB(1, 1), cB + hstep + kstep, voffB);
    PG8_WAIT_V(6); PG8_BAR;
    PG8_STAMP();
    for (;;) {
        const bool has_next = S.next(ui + 1, nxt);
        const char* nA = has_next ? (const char*)g.A + (size_t)nxt.pm * tstep : cA; const char* nB = has_next ? (const char*)g.Bt + (size_t)nxt.pn * tstep : cB;
        for (int t = 0; t < nt; t += 2) {
            const bool last = (t == nt - 2);
            const char* a1 = cA + (size_t)(t + 1) * kstep;
            const char* a2 = last ? nA : cA + (size_t)(t + 2) * kstep; const char* b2 = last ? nB : cB + (size_t)(t + 2) * kstep;
            const char* a3 = a2 + kstep; const char* b3 = b2 + kstep;
            if (last && has_next) S.a_ready(nxt);
            PG8_LDB(B0, 0, 0); PG8_SCHED; PG8_LDA(At, 0, 0); PG8_STAGE(PG8_SA(1, 1), a1 + hstep, voffA);
            PG8_WAIT_L(8); PG8_BAR; PG8_WAIT_L(0); PG8_MMA(0, 0, At, B0); PG8_BAR; PG8_SCHED;
            PG8_LDB(B1, 0, 1); PG8_STAGE(PG8_SB(0, 0), b2, voffB);
            PG8_BAR; PG8_WAIT_L(0); PG8_MMA(0, 1, At, B1); PG8_BAR;
            PG8_LDA(At, 0, 1); PG8_STAGE(PG8_SA(0, 0), a2, voffA);
            PG8_BAR; PG8_WAIT_L(0); PG8_MMA(1, 0, At, B0); PG8_BAR; PG8_SCHED;
            PG8_STAGE(PG8_SB(0, 1), b2 + hstep, voffB);
            PG8_WAIT_V(6); PG8_BAR; PG8_MMA(1, 1, At, B1); PG8_BAR;
            PG8_LDB(B0, 1, 0); PG8_SCHED; PG8_LDA(At, 1, 0); PG8_STAGE(PG8_SA(0, 1), a2 + hstep, voffA);
            PG8_WAIT_L(8); PG8_BAR; PG8_WAIT_L(0); PG8_MMA(0, 0, At, B0); PG8_BAR; PG8_SCHED;
            PG8_LDB(B1, 1, 1); PG8_STAGE(PG8_SB(1, 0), b3, voffB);
            PG8_BAR; PG8_WAIT_L(0); PG8_MMA(0, 1, At, B1); PG8_BAR;
            PG8_LDA(At, 1, 1); PG8_STAGE(PG8_SA(1, 0), a3, voffA);
            PG8_BAR; PG8_WAIT_L(0); PG8_MMA(1, 0, At, B0); PG8_BAR; PG8_SCHED;
            PG8_STAGE(PG8_SB(1, 1), b3 + hstep, voffB);
            PG8_WAIT_V(6); PG8_BAR; PG8_MMA(1, 1, At, B1); PG8_BAR;
        }
        PG8_STAMP();
        if constexpr (!Epi::AFTER_DRAIN) { E(acc, cur, wr, wc, fr, fq); S.done(cur); }
        PG8_STAMP();
        if (!has_next) break;
#pragma unroll
        for (int a = 0; a < 2; ++a)
#pragma unroll
            for (int b = 0; b < 2; ++b)
#pragma unroll
                for (int m = 0; m < 4; ++m)
#pragma unroll
                    for (int n = 0; n < 2; ++n) acc[a][b][m][n] = (f32x4){0.f, 0.f, 0.f, 0.f};
        cur = nxt; cA = nA; cB = nB; ++ui;
    }
    PG8_WAIT_V(0);
    if (wr == 0) PG8_BAR;
    PG8_BAR;
    if constexpr (Epi::AFTER_DRAIN) { E.fused(acc, cur, wr, wc, fr, fq, lds, wid, lane); S.done(cur); }
    PG8_STAMP();
    if (STAMP && wid == 0) { stamps[lane] = lane < nts ? (((unsigned long long)(unsigned)ts_hi << 32) | (unsigned)ts_lo) : 0ull;
        if (lane == 62) stamps[62] = rt_entry; if (lane == 63) stamps[63] = (unsigned long long)wall_clock64(); }
#undef PG8_STAMP
#undef PG8_SA
#undef PG8_SB
#undef PG8_STAGE
#undef PG8_LDA
#undef PG8_LDB
#undef PG8_MMA
#undef PG8_WAIT_V
#undef PG8_WAIT_L
#undef PG8_BAR
#undef PG8_SCHED
}}

using pg8::bf16_t; using pg8::bf16x8; using pg8::f32x4; using pg8::u32x4;
typedef short s16x4 __attribute__((ext_vector_type(4)));
typedef float f32x16 __attribute__((ext_vector_type(16)));
typedef float f32x2 __attribute__((ext_vector_type(2)));
typedef unsigned u32x2 __attribute__((ext_vector_type(2)));
typedef unsigned long long u64;
#define LAS __attribute__((address_space(3)))
#define LDS_WAIT() asm volatile("s_waitcnt lgkmcnt(0)" ::: "memory")
#define XB_TMO      128
#define XB_XCNT(j)  (256  + 64 * (j))
#define XB_XSUB(j)  (1280 + 64 * (j))
#define XB_XGEN(j)  (2304 + 64 * (j))
#define XB_TOP      3328
#define XB_TOPGEN   3392
#define XCD_BAR_WORDS 3456
#define XB_SPIN_CAP (1u << 18)

__device__ __forceinline__ unsigned xb_ld(unsigned* p)              { return __hip_atomic_load(p, __ATOMIC_RELAXED, __HIP_MEMORY_SCOPE_AGENT); }
__device__ __forceinline__ unsigned xb_add(unsigned* p, unsigned v) { return __hip_atomic_fetch_add(p, v, __ATOMIC_RELAXED, __HIP_MEMORY_SCOPE_AGENT); }
__device__ __forceinline__ unsigned xb_xcc_id() { return (unsigned)__builtin_amdgcn_s_getreg((3 << 11) | 20) & 0xFu; }
#define XB_SPIN(cond, bar) do { unsigned _sp = 0; while (cond) { __builtin_amdgcn_s_sleep(1); \
    if ((++_sp & 255u) == 0u) { if (xb_ld(&(bar)[XB_TMO])) break; if (_sp > XB_SPIN_CAP) { atomicAdd(&(bar)[XB_TMO], 1u); break; } } } } while (0)

struct XcdBarrier {
    unsigned* bar; unsigned x;
    volatile LAS unsigned* st;
};

__device__ __forceinline__ XcdBarrier xcd_barrier_post(unsigned* bar, volatile LAS unsigned* st) {
    XcdBarrier b; b.bar = bar; b.x = xb_xcc_id(); b.st = st;
    if (threadIdx.x == 0) (void)xb_add(&bar[XB_XCNT(b.x)], 1u);
    return b;
}
__device__ __forceinline__ void xcd_barrier_complete(unsigned* bar, unsigned x, unsigned& nloc, unsigned& nx) {
    const unsigned G = gridDim.x * gridDim.y * gridDim.z;
    unsigned sum, cnt, mine, sp = 0u;
    for (;;) {
        sum = 0u; cnt = 0u; mine = 0u;
#pragma unroll
        for (unsigned j = 0; j < 16; ++j) { const unsigned c = xb_ld(&bar[XB_XCNT(j)]); sum += c; cnt += (c > 0u) ? 1u : 0u; mine = (j == x) ? c : mine; }
        if (sum == G) break;
        __builtin_amdgcn_s_sleep(1);
        if ((++sp & 255u) == 0u) { if (xb_ld(&bar[XB_TMO])) break; if (sp > XB_SPIN_CAP) { atomicAdd(&bar[XB_TMO], 1u); break; } }
    }
    nloc = mine > 0u ? mine : 1u; nx = cnt > 0u ? cnt : 1u;
}

__device__ __forceinline__ void xcd_barrier(const XcdBarrier& b) {
    asm volatile("s_waitcnt vmcnt(0)" ::: "memory");
    __syncthreads();
    if (threadIdx.x == 0) {
        unsigned* bar = b.bar;
        __builtin_amdgcn_s_waitcnt(0);
        unsigned nloc = b.st[0], nx = b.st[1];
        if (nloc == 0u) { xcd_barrier_complete(bar, b.x, nloc, nx); b.st[0] = nloc; b.st[1] = nx; }
        const unsigned old = xb_add(&bar[XB_XSUB(b.x)], 1u);
        const unsigned gen = old / nloc;
        if (old + 1u == (gen + 1u) * nloc) {
            __builtin_amdgcn_fence(__ATOMIC_RELEASE, "agent");
            asm volatile("s_waitcnt vmcnt(0)" ::: "memory");
            const unsigned og = xb_add(&bar[XB_TOP], 1u);
            const unsigned tg = og / nx;
            if (og + 1u == (tg + 1u) * nx) xb_add(&bar[XB_TOPGEN], 1u);
            else XB_SPIN(xb_ld(&bar[XB_TOPGEN]) == tg, bar);
            __builtin_amdgcn_fence(__ATOMIC_ACQUIRE, "agent");
            xb_add(&bar[XB_XGEN(b.x)], 1u);
            asm volatile("s_waitcnt vmcnt(0)" ::: "memory");
        } else {
            XB_SPIN(xb_ld(&bar[XB_XGEN(b.x)]) == gen, bar);
            __builtin_amdgcn_fence(__ATOMIC_ACQUIRE, "agent");
            asm volatile("s_waitcnt vmcnt(0)" ::: "memory");
        }
    }
    __syncthreads();
}


constexpr int DM = 4096, SEQ = 2048, TP = 8192, RP = 8448;
constexpr size_t MiB = (size_t)1 << 20;
constexpr size_t O_BT1 = 0, O_BT2 = O_BT1 + 128 * MiB, O_BT3 = O_BT2 + 64 * MiB, O_BT4 = O_BT3 + 88 * MiB, O_BT5 = O_BT4 + 64 * MiB, O_WG = O_BT5 + 32 * MiB,
                 O_XBF = O_WG + 8 * MiB, O_POOL = O_XBF + 66 * MiB, O_Y = O_POOL + 198 * MiB, O_SG2 = O_Y + 66 * MiB, O_OG = O_SG2 + 33 * MiB, O_KVB = O_OG + 33 * MiB,
                 O_RS = O_KVB + 48 * MiB, O_SSQP = O_RS + 1 * MiB, O_LSE = O_SSQP + 2 * MiB, O_GRAN = O_LSE + 2 * MiB, O_PART = O_GRAN + 8 * MiB, O_BAR = O_PART + 3 * MiB, O_END = O_BAR + 1 * MiB;
constexpr size_t P_XB = O_POOL, P_SG = O_POOL + 66 * MiB, P_HG = O_POOL + 132 * MiB, P_Q = O_POOL, P_ON = O_POOL + 99 * MiB;
constexpr size_t OUT_YP = 0, OUT_YS = 33554432, OUT_PCONV = OUT_YS + 32768, OUT_PH = OUT_PCONV + 98304, OUT_PKV0 = OUT_PH + 32768, OUT_PKV1 = OUT_PKV0 + 524288, OUT_PKV2 = OUT_PKV1 + 2097152,
                 OUT_SCONV = OUT_PKV2 + 8388608, OUT_SH = OUT_SCONV + 196608, OUT_SKV0 = OUT_SH + 65536, OUT_SKV1 = OUT_SKV0 + 1048576, OUT_SKV2 = OUT_SKV1 + 4194304;
constexpr int LDS_BYTES = 159744, OFF_XB = 157824;
constexpr float EPSN = 1e-6f;

struct Params { const float* in[25]; float* out; unsigned char* ws; };
typedef const Params __attribute__((address_space(4))) * KParams;
__device__ __forceinline__ KParams kparams() { KParams p = (KParams)__builtin_amdgcn_kernarg_segment_ptr(); asm volatile("" : "+s"(p)); return p; }
#define PLOCAL const KParams Pk = kparams(); (void)P;


__device__ __forceinline__ unsigned pk2(float a, float b) { typedef __bf16 bf2 __attribute__((ext_vector_type(2))); bf2 v; v[0] = (__bf16)a; v[1] = (__bf16)b; return __builtin_bit_cast(unsigned, v); }
__device__ __forceinline__ float bflo(unsigned u) { return __uint_as_float(u << 16); }
__device__ __forceinline__ float bfhi(unsigned u) { return __uint_as_float(u & 0xffff0000u); }
__device__ __forceinline__ float bf2f(bf16_t h) { return __uint_as_float(((unsigned)h) << 16); }
__device__ __forceinline__ float silu_f(float v) { return v * __builtin_amdgcn_rcpf(1.0f + __expf(-v)); }
__device__ __forceinline__ float sigm_f(float v) { return __builtin_amdgcn_rcpf(1.0f + __expf(-v)); }
__device__ __forceinline__ float wave_sum(float v) {
#pragma unroll
    for (int o = 1; o < 64; o <<= 1) v += __shfl_xor(v, o);
    return v;
}
__device__ __forceinline__ float wave_max(float v) {
#pragma unroll
    for (int o = 1; o < 64; o <<= 1) v = fmaxf(v, __shfl_xor(v, o));
    return v;
}
__device__ __forceinline__ int crow(int reg, int h) { return (reg & 3) + 8 * (reg >> 2) + 4 * h; }
__device__ __forceinline__ int rel_bucket(int dd) {
    if (dd < 16) return dd;
    const float d = (float)dd;
    int large = 16 + (int)(logf(d * (1.0f / 16.0f)) / logf(128.0f) * 16.0f);
    return large < 31 ? large : 31;
}
#define MFMA32(a, b, c) __builtin_amdgcn_mfma_f32_32x32x16_bf16((a), (b), (c), 0, 0, 0)

struct Epi {
    static constexpr bool PERM = true, AFTER_DRAIN = false;
    int mode;
    const float* rs; bf16_t* o0; bf16_t* o1; bf16_t* o2; float* ssqp; float* outp;
    __device__ __forceinline__ void operator()(const f32x4 (&acc)[2][2][4][2], const pg8::Unit& u, int wr, int wc, int fr, int fq) const {
        const int row0 = u.pm * 256 + wr * 64 + fr, colt = u.pn * 256, cw = wc * 32 + 8 * fq;
        if (mode == 1) {
#pragma unroll
            for (int ai = 0; ai < 2; ++ai)
#pragma unroll
                for (int m = 0; m < 4; ++m) {
                    const int row = row0 + ai * 128 + m * 16; float ss = 0.f;
#pragma unroll
                    for (int bj = 0; bj < 2; ++bj) {
                        const f32x4 v0 = acc[ai][bj][m][0], v1 = acc[ai][bj][m][1];
                        ss += (v0[0] * v0[0] + v0[1] * v0[1]) + (v0[2] * v0[2] + v0[3] * v0[3]) + (v1[0] * v1[0] + v1[1] * v1[1]) + (v1[2] * v1[2] + v1[3] * v1[3]);
                        u32x4 w; w.x = pk2(v0[0], v0[1]); w.y = pk2(v0[2], v0[3]); w.z = pk2(v1[0], v1[1]); w.w = pk2(v1[2], v1[3]);
                        *(u32x4*)(o0 + (size_t)row * 4096 + colt + bj * 128 + cw) = w;
                    }
                    ss += __shfl_xor(ss, 16); ss += __shfl_xor(ss, 32);
                    if (fq == 0) ssqp[(size_t)row * 64 + u.pn * 4 + wc] = ss;
                }
            return;
        }
        bf16_t* dst; int ld, col; bool act = false, kv = false;
        if (mode == 0) { ld = 4096; if (colt < 4096) { dst = o0; col = colt; } else { dst = o1; col = colt - 4096; act = true; } }
        else { if (colt < 6144) { dst = o0; ld = 6144; col = colt; } else if (colt < 8192) { dst = o1; ld = 2048; col = colt - 6144; act = true; } else { dst = o2; ld = 3072; col = colt - 8192; kv = true; } }
#pragma unroll
        for (int ai = 0; ai < 2; ++ai)
#pragma unroll
            for (int m = 0; m < 4; ++m) {
                const int row = row0 + ai * 128 + m * 16; const float r = rs[row];
#pragma unroll
                for (int bj = 0; bj < 2; ++bj) {
                    f32x4 v0 = acc[ai][bj][m][0] * r, v1 = acc[ai][bj][m][1] * r;
                    if (act) {
#pragma unroll
                        for (int j = 0; j < 4; ++j) { v0[j] = silu_f(v0[j]); v1[j] = silu_f(v1[j]); }
                    }
                    u32x4 w; w.x = pk2(v0[0], v0[1]); w.y = pk2(v0[2], v0[3]); w.z = pk2(v1[0], v1[1]); w.w = pk2(v1[2], v1[3]);
                    const int cc = col + bj * 128 + cw;
                    *(u32x4*)(dst + (size_t)row * ld + cc) = w;
                    if (kv) {
                        const int g = cc >> 10, rem = cc & 1023, keep = 128 << (2 * g), n = row >> 11, t = row & 2047;
                        if (t >= 2048 - keep) {
                            const size_t ob = (g == 0 ? OUT_PKV0 : (g == 1 ? OUT_PKV1 : OUT_PKV2)) + ((size_t)(n * keep + (t - (2048 - keep))) * 1024 + rem);
                            *(f32x4*)(outp + ob) = v0; *(f32x4*)(outp + ob + 4) = v1;
                        }
                    }
                }
            }
    }
};

__device__ __forceinline__ void transpose_item(const float* W, int K, int N, bf16_t* WT, const float* gain, int item, int lane) {
    const int nblk = N / 256, kb = item / nblk, nb = item % nblk, k0 = 32 * kb, n0 = 256 * nb + lane * 4;
    f32x4 v[32];
    const float* src = W + (size_t)k0 * N + n0;
#pragma unroll
    for (int kk = 0; kk < 32; ++kk) v[kk] = __builtin_nontemporal_load((const f32x4*)(src + (size_t)kk * N));
    if (gain) {
#pragma unroll
        for (int kk = 0; kk < 32; ++kk) v[kk] = v[kk] * gain[k0 + kk];
    }
#pragma unroll
    for (int i = 0; i < 4; ++i) {
        bf16_t* dst = WT + (size_t)(n0 + i) * K + k0;
#pragma unroll
        for (int c = 0; c < 4; ++c) {
            u32x4 o; o.x = pk2(v[8 * c][i], v[8 * c + 1][i]); o.y = pk2(v[8 * c + 2][i], v[8 * c + 3][i]); o.z = pk2(v[8 * c + 4][i], v[8 * c + 5][i]); o.w = pk2(v[8 * c + 6][i], v[8 * c + 7][i]);
            *(u32x4*)(dst + 8 * c) = o;
        }
    }
}

__device__ __forceinline__ void prep_phase(const Params& P, LAS unsigned char* lds) {
    const KParams Pk = kparams();
    int tid = threadIdx.x; asm volatile("" : "+v"(tid));
    const int lane = tid & 63, w = __builtin_amdgcn_readfirstlane(tid >> 6);
    const int gw = blockIdx.x * 8 + w, NGW = gridDim.x * 8;
    unsigned char* ws = Pk->ws;
    { u64* gr = (u64*)(ws + O_GRAN); const size_t n = (8 * MiB) / 8; for (size_t i = (size_t)blockIdx.x * 512 + tid; i < n; i += (size_t)gridDim.x * 512) gr[i] = 0ull; }
    { bf16_t* XBF = (bf16_t*)(ws + O_XBF); float* RS = (float*)(ws + O_RS);
      for (int row = gw; row < TP + 8; row += NGW) {
          const float* xr = row < TP ? Pk->in[0] + (size_t)row * DM : Pk->in[1] + (size_t)(row - TP) * DM;
          const f32x4* x4 = (const f32x4*)xr + lane; f32x4 v[16]; float s = 0.f;
#pragma unroll
          for (int j = 0; j < 16; ++j) { v[j] = x4[64 * j]; s += (v[j].x * v[j].x + v[j].y * v[j].y) + (v[j].z * v[j].z + v[j].w * v[j].w); }
          s = wave_sum(s);
          u32x2* o = (u32x2*)(XBF + (size_t)row * DM) + lane;
#pragma unroll
          for (int j = 0; j < 16; ++j) { u32x2 q; q.x = pk2(v[j].x, v[j].y); q.y = pk2(v[j].z, v[j].w); o[64 * j] = q; }
          if (lane == 0) RS[row] = rsqrtf(s * (1.0f / DM) + EPSN);
      } }
    for (int g = 0; g < 3; ++g) {
        const int lb = 128 << (2 * g); const size_t per = (size_t)(lb - 1) * 256, tot = 8 * per;
        const f32x4* src = (const f32x4*)Pk->in[4 + g]; f32x4* dst = (f32x4*)(Pk->out + (g == 0 ? OUT_SKV0 : (g == 1 ? OUT_SKV1 : OUT_SKV2)));
        for (size_t i = (size_t)blockIdx.x * 512 + tid; i < tot; i += (size_t)gridDim.x * 512) { const size_t b = i / per, o = i - b * per; dst[b * (size_t)lb * 256 + o] = src[b * (size_t)lb * 256 + 256 + o]; }
    }
    constexpr int I_AIN = 128 * 32, I_AOUT = 128 * 16, I_KV = 128 * 12, I_BOUT = 64 * 16, I_G = 8;
    constexpr int NITEMS = 2 * I_AIN + 2 * I_AOUT + I_AIN + I_KV + I_AIN + 2 * I_BOUT + 64 * I_G;
    for (int it = gw; it < NITEMS; it += NGW) {
        int r = it;
        if (r < 2 * I_AIN) { const int l = r / I_AIN; transpose_item(Pk->in[8] + (size_t)l * 4096 * 8192, 4096, 8192, (bf16_t*)(ws + O_BT1) + (size_t)l * 8192 * 4096, Pk->in[7] + l * 4096, r % I_AIN, lane); continue; } r -= 2 * I_AIN;
        if (r < 2 * I_AOUT) { const int l = r / I_AOUT; transpose_item(Pk->in[16] + (size_t)l * 4096 * 4096, 4096, 4096, (bf16_t*)(ws + O_BT2) + (size_t)l * 4096 * 4096, nullptr, r % I_AOUT, lane); continue; } r -= 2 * I_AOUT;
        if (r < I_AIN) { transpose_item(Pk->in[22], 4096, 8192, (bf16_t*)(ws + O_BT3), Pk->in[21], r, lane); continue; } r -= I_AIN;
        if (r < I_KV) { transpose_item(Pk->in[19], 4096, 3072, (bf16_t*)(ws + O_BT3) + (size_t)8192 * 4096, Pk->in[18], r, lane); continue; } r -= I_KV;
        if (r < I_AIN) { transpose_item(Pk->in[22] + (size_t)4096 * 8192, 4096, 8192, (bf16_t*)(ws + O_BT4), Pk->in[21] + 4096, r, lane); continue; } r -= I_AIN;
        if (r < 2 * I_BOUT) { const int l = r / I_BOUT; transpose_item(Pk->in[23] + (size_t)l * 2048 * 4096, 2048, 4096, (bf16_t*)(ws + O_BT5) + (size_t)l * 4096 * 2048, nullptr, r % I_BOUT, lane); continue; } r -= 2 * I_BOUT;
        { const int mat = r / I_G, gate = mat & 1, lh = mat >> 1;
          transpose_item((gate ? Pk->in[13] : Pk->in[11]) + (size_t)lh * 65536, 256, 256, (bf16_t*)(ws + O_WG) + (size_t)(lh * 2 + gate) * 65536, nullptr, r % I_G, lane); }
    }
}

template <int KSTEPS>
__device__ __forceinline__ void skinny_phase(const bf16_t* A, const bf16_t* Bt, int N, int K, float* sout, LAS unsigned char* lds) {
    int tid = threadIdx.x; asm volatile("" : "+v"(tid));
    const int lane = tid & 63, w = __builtin_amdgcn_readfirstlane(tid >> 6), fr = lane & 15, fq = lane >> 4;
    LAS float* red = (LAS float*)lds;
    const int ngroups = N / 16, k0 = w * (KSTEPS * 32);
    for (int grp = blockIdx.x; grp < ngroups; grp += gridDim.x) {
        const int n0 = grp * 16;
        const bf16_t* ap = A + (size_t)(fr & 7) * K + k0 + fq * 8; const bf16_t* bp = Bt + (size_t)(n0 + fr) * K + k0 + fq * 8;
        bf16x8 a[KSTEPS], b[KSTEPS];
#pragma unroll
        for (int s = 0; s < KSTEPS; ++s) { b[s] = __builtin_nontemporal_load((const bf16x8*)(bp + s * 32)); a[s] = *(const bf16x8*)(ap + s * 32); }
        f32x4 acc = {0.f, 0.f, 0.f, 0.f};
#pragma unroll
        for (int s = 0; s < KSTEPS; ++s) { if (fr >= 8) a[s] = (bf16x8){0, 0, 0, 0, 0, 0, 0, 0}; acc = __builtin_amdgcn_mfma_f32_16x16x32_bf16(a[s], b[s], acc, 0, 0, 0); }
        __syncthreads();
        if (fq < 2) {
#pragma unroll
            for (int i = 0; i < 4; ++i) red[(w * 8 + fq * 4 + i) * 16 + fr] = acc[i];
        }
        __syncthreads();
        if (tid < 128) { float s = 0.f;
#pragma unroll
            for (int ww = 0; ww < 8; ++ww) s += red[ww * 128 + tid];
            sout[(size_t)(tid >> 4) * N + n0 + (tid & 15)] = s; }
    }
}
__device__ __forceinline__ float part_sum(const float* sout, int N, int b, int col) { return sout[(size_t)b * N + col]; }

constexpr int SROW = 528;
__device__ __forceinline__ void scan_phase(const Params& P, LAS unsigned char* lds, int l) {
    const KParams Pk = kparams();
    const int tid0 = threadIdx.x;
    LAS unsigned char* RAW = lds;
    LAS unsigned char* AT = lds + 69632;
    unsigned char* ws = Pk->ws;
    const bf16_t* XB = (const bf16_t*)(ws + P_XB); const bf16_t* SG = (const bf16_t*)(ws + P_SG); bf16_t* HG = (bf16_t*)(ws + P_HG);
    const float* SOUT = (const float*)(ws + O_PART); const float* RS = (const float*)(ws + O_RS);
    const float* cwp = Pk->in[9] + (size_t)l * 4 * 4096; const float* cbp = Pk->in[10] + (size_t)l * 4096;
    bf16x8 bR[8], bI[8]; int cur = -1;
    for (int t = blockIdx.x; t < 32 + 2048; t += gridDim.x) {
        int tid = tid0; asm volatile("" : "+v"(tid));
        const int lane = tid & 63, w = __builtin_amdgcn_readfirstlane(tid >> 6), fr = lane & 15, fq = lane >> 4;
        const bool is_s = t < 32;
        int hh2, n = 0, sp = 0;
        if (is_s) hh2 = t; else { const int idx = t - 32; hh2 = idx & 31; n = (idx >> 5) & 3; sp = idx >> 7; }
        const int head = hh2 >> 1, half = hh2 & 1, gc0 = head * 256, hc = half * 128 + w * 16 + fr, gch = gc0 + hc, r0 = n * 2048 + sp * 128;
        if (hh2 != cur) {
            const bf16_t* wp = (const bf16_t*)(ws + O_WG) + (size_t)((l * 16 + head) * 2) * 65536 + (size_t)hc * 256 + fq * 8;
#pragma unroll
            for (int ks = 0; ks < 8; ++ks) { bR[ks] = *(const bf16x8*)(wp + ks * 32); bI[ks] = *(const bf16x8*)(wp + 65536 + ks * 32); }
            cur = hh2;
        }
        __syncthreads();
        if (is_s) {
            const int b = tid >> 6, ch = (tid & 63) * 4; const float rsb = RS[TP + b];
            float xc[4][4];
#pragma unroll
            for (int e = 0; e < 4; ++e) {
                const int gc = gc0 + ch + e;
#pragma unroll
                for (int k = 0; k < 3; ++k) xc[k][e] = Pk->in[2][((size_t)(l * 8 + b) * 3 + k) * 4096 + gc];
                xc[3][e] = rsb * SOUT[(size_t)b * 8192 + gc];
            }
            float o[4];
#pragma unroll
            for (int e = 0; e < 4; ++e) {
                const int gc = gc0 + ch + e; float v = cbp[gc];
#pragma unroll
                for (int k = 0; k < 4; ++k) v += xc[k][e] * cwp[k * 4096 + gc];
                o[e] = v;
                if (half == 0) {
#pragma unroll
                    for (int k = 0; k < 3; ++k) Pk->out[OUT_SCONV + ((size_t)(l * 8 + b) * 3 + k) * 4096 + gc] = xc[k + 1][e];
                }
            }
            u32x2 q; q.x = pk2(o[0], o[1]); q.y = pk2(o[2], o[3]);
            *(LAS u32x2*)(AT + b * SROW + ch * 2) = q;
        } else {
#pragma unroll
            for (int j = 0; j < 9; ++j) {
                const int id = tid + 512 * j, i = id >> 5, c8 = id & 31;
                if (i < 131) {
                    u32x4 v = {0u, 0u, 0u, 0u};
                    if (!(sp == 0 && i < 3)) v = *(const u32x4*)(XB + (size_t)(r0 - 3 + i) * 4096 + gc0 + c8 * 8);
                    *(LAS u32x4*)(RAW + i * SROW + c8 * 16) = v;
                }
            }
            __syncthreads();
            const int c8 = tid & 31; float wk[4][8], bb[8];
#pragma unroll
            for (int e = 0; e < 8; ++e) { bb[e] = cbp[gc0 + c8 * 8 + e];
#pragma unroll
                for (int k = 0; k < 4; ++k) wk[k][e] = cwp[k * 4096 + gc0 + c8 * 8 + e]; }
#pragma unroll
            for (int j = 0; j < 8; ++j) {
                const int i = (tid >> 5) + 16 * j;
                float o[8];
#pragma unroll
                for (int e = 0; e < 8; ++e) o[e] = bb[e];
                u32x4 last;
#pragma unroll
                for (int k = 0; k < 4; ++k) {
                    const u32x4 v = *(const LAS u32x4*)(RAW + (i + k) * SROW + c8 * 16); last = v;
                    o[0] += bflo(v.x) * wk[k][0]; o[1] += bfhi(v.x) * wk[k][1]; o[2] += bflo(v.y) * wk[k][2]; o[3] += bfhi(v.y) * wk[k][3];
                    o[4] += bflo(v.z) * wk[k][4]; o[5] += bfhi(v.z) * wk[k][5]; o[6] += bflo(v.w) * wk[k][6]; o[7] += bfhi(v.w) * wk[k][7];
                }
                u32x4 q; q.x = pk2(o[0], o[1]); q.y = pk2(o[2], o[3]); q.z = pk2(o[4], o[5]); q.w = pk2(o[6], o[7]);
                *(LAS u32x4*)(AT + i * SROW + c8 * 16) = q;
                if (sp == 15 && i >= 125 && half == 0) {
                    float* d = Pk->out + OUT_PCONV + ((size_t)(l * 4 + n) * 3 + (i - 125)) * 4096 + gc0 + c8 * 8;
                    f32x4 a = {bflo(last.x), bfhi(last.x), bflo(last.y), bfhi(last.y)}, b = {bflo(last.z), bfhi(last.z), bflo(last.w), bfhi(last.w)};
                    *(f32x4*)d = a; *(f32x4*)(d + 4) = b;
                }
            }
        }
        __syncthreads();
        f32x4 aR[8], aI[8];
#pragma unroll
        for (int mt = 0; mt < 8; ++mt) { aR[mt] = (f32x4){0.f, 0.f, 0.f, 0.f}; aI[mt] = (f32x4){0.f, 0.f, 0.f, 0.f}; }
#pragma unroll
        for (int ks = 0; ks < 8; ++ks) {
#pragma unroll
            for (int mt = 0; mt < 8; ++mt) {
                const bf16x8 a = *(const LAS bf16x8*)(AT + (mt * 16 + fr) * SROW + (ks * 32 + fq * 8) * 2);
                aR[mt] = __builtin_amdgcn_mfma_f32_16x16x32_bf16(a, bR[ks], aR[mt], 0, 0, 0);
                aI[mt] = __builtin_amdgcn_mfma_f32_16x16x32_bf16(a, bI[ks], aI[mt], 0, 0, 0);
            }
            __builtin_amdgcn_sched_barrier(0);
        }
        const float bga = Pk->in[12][(size_t)l * 4096 + gch], bgx = Pk->in[14][(size_t)l * 4096 + gch];
        const float lamc = -8.0f * log1pf(expf(-Pk->in[15][(size_t)l * 4096 + gch]));
#pragma unroll
        for (int mt = 0; mt < 8; ++mt)
#pragma unroll
            for (int i = 0; i < 4; ++i) {
                const int row = mt * 16 + 4 * fq + i;
                const float r = sigm_f(aR[mt][i] + bga), ig = sigm_f(aI[mt][i] + bgx);
                const float la = lamc * r, a = __expf(la);
                const float em = fmaf(-a, a, 1.0f);
                const float xf = bf2f(*(const LAS bf16_t*)(AT + row * SROW + hc * 2));
                aR[mt][i] = a; aI[mt][i] = __builtin_amdgcn_sqrtf(em) * ig * xf;
            }
        if (is_s) {
            if (fq < 2) {
#pragma unroll
                for (int i = 0; i < 4; ++i) {
                    const int b = 4 * fq + i;
                    const float h0 = Pk->in[3][(size_t)(l * 8 + b) * 4096 + gch];
                    const float h = aR[0][i] * h0 + aI[0][i];
                    Pk->out[OUT_SH + (size_t)(l * 8 + b) * 4096 + gch] = h;
                    const float sg = silu_f(RS[TP + b] * SOUT[(size_t)b * 8192 + 4096 + gch]);
                    HG[(size_t)(TP + b) * 4096 + gch] = (bf16_t)(pk2(h * sg, 0.f) & 0xffffu);
                }
            }
            continue;
        }
        float Pp = 1.f, Cc = 0.f;
#pragma unroll
        for (int mt = 0; mt < 8; ++mt) {
            float A = aR[mt][0], H = aI[mt][0];
#pragma unroll
            for (int i = 1; i < 4; ++i) { const float a = aR[mt][i], b = aI[mt][i]; H = a * H + b; A = A * a; aR[mt][i] = A; aI[mt][i] = H; }
            float Pm = 1.f, Cm = 0.f;
#pragma unroll
            for (int q = 0; q < 4; ++q) {
                const float qA = __shfl(A, fr + 16 * q), qH = __shfl(H, fr + 16 * q);
                if (q == fq) { Pm = Pp; Cm = Cc; }
                Cc = qA * Cc + qH; Pp = Pp * qA;
            }
#pragma unroll
            for (int i = 0; i < 4; ++i) { aI[mt][i] += aR[mt][i] * Cm; aR[mt][i] *= Pm; }
        }
        u64* gr = (u64*)(ws + O_GRAN) + (((size_t)l * 4 + n) * 16 + sp) * 4096 + gch;
        const unsigned tag = 1u + (unsigned)l;
        float H0 = 0.f;
        if (sp > 0) {
            const u64* pg = gr - 4096; u64 x = 0; unsigned spins = 0;
            for (;;) {
                x = __hip_atomic_load(pg, __ATOMIC_RELAXED, __HIP_MEMORY_SCOPE_AGENT);
                if (__all((unsigned)(x >> 32) == tag)) break;
                if (++spins > (1u << 22)) break;
                __builtin_amdgcn_s_sleep(1);
            }
            H0 = __uint_as_float((unsigned)x);
        }
        const float hend = Cc + Pp * H0;
        if (fq == 0) {
            __hip_atomic_store(gr, ((u64)tag << 32) | (u64)__float_as_uint(hend), __ATOMIC_RELAXED, __HIP_MEMORY_SCOPE_AGENT);
            if (sp == 15) Pk->out[OUT_PH + (size_t)(l * 4 + n) * 4096 + gch] = hend;
        }
        __syncthreads();
#pragma unroll
        for (int mt = 0; mt < 8; ++mt)
#pragma unroll
            for (int i = 0; i < 4; ++i) {
                const int row = mt * 16 + 4 * fq + i;
                const float h = aI[mt][i] + aR[mt][i] * H0;
                *(LAS bf16_t*)(AT + row * SROW + hc * 2) = (bf16_t)(pk2(h, 0.f) & 0xffffu);
            }
        __syncthreads();
        {
            const int c8 = tid & 15;
#pragma unroll
            for (int j = 0; j < 4; ++j) {
                const int i = (tid >> 4) + 32 * j;
                const u32x4 hv = *(const LAS u32x4*)(AT + i * SROW + (half * 128 + c8 * 8) * 2);
                const size_t go = (size_t)(r0 + i) * 4096 + gc0 + half * 128 + c8 * 8;
                const u32x4 sv = *(const u32x4*)(SG + go);
                u32x4 q; q.x = pk2(bflo(hv.x) * bflo(sv.x), bfhi(hv.x) * bfhi(sv.x)); q.y = pk2(bflo(hv.y) * bflo(sv.y), bfhi(hv.y) * bfhi(sv.y));
                q.z = pk2(bflo(hv.z) * bflo(sv.z), bfhi(hv.z) * bfhi(sv.z)); q.w = pk2(bflo(hv.w) * bflo(sv.w), bfhi(hv.w) * bfhi(sv.w));
                *(u32x4*)(HG + go) = q;
            }
        }
    }
}

__device__ __forceinline__ void post_phase(const Params& P, int L) {
    const KParams Pk = kparams();
    int tid = threadIdx.x; asm volatile("" : "+v"(tid));
    const int lane = tid & 63, w = __builtin_amdgcn_readfirstlane(tid >> 6);
    const int gw = blockIdx.x * 8 + w, NGW = gridDim.x * 8;
    unsigned char* ws = Pk->ws;
    const float* gain = L < 2 ? Pk->in[17] + (size_t)L * 4096 : Pk->in[24] + (size_t)(L - 2) * 4096;
    const bf16_t* Y = (const bf16_t*)(ws + O_Y); const float* SSQP = (const float*)(ws + O_SSQP); const float* SOUT = (const float*)(ws + O_PART);
    bf16_t* XBF = (bf16_t*)(ws + O_XBF); float* RS = (float*)(ws + O_RS);
    for (int row = gw; row < TP + 8; row += NGW) {
        const bool smp = row >= TP; const int b = row - TP;
        float ssq; f32x4 y0[8], y1[8], x0[8], x1[8];
        if (!smp) {
            ssq = SSQP[(size_t)row * 64 + lane];
#pragma unroll
            for (int j = 0; j < 8; ++j) { const u32x4 yv = *(const u32x4*)(Y + (size_t)row * 4096 + j * 512 + lane * 8);
                y0[j] = (f32x4){bflo(yv.x), bfhi(yv.x), bflo(yv.y), bfhi(yv.y)}; y1[j] = (f32x4){bflo(yv.z), bfhi(yv.z), bflo(yv.w), bfhi(yv.w)}; }
        } else {
            ssq = 0.f;
#pragma unroll
            for (int j = 0; j < 8; ++j) { const float* sp = SOUT + (size_t)b * 4096 + j * 512 + lane * 8; y0[j] = *(const f32x4*)sp; y1[j] = *(const f32x4*)(sp + 4);
                ssq += (y0[j].x * y0[j].x + y0[j].y * y0[j].y) + (y0[j].z * y0[j].z + y0[j].w * y0[j].w) + (y1[j].x * y1[j].x + y1[j].y * y1[j].y) + (y1[j].z * y1[j].z + y1[j].w * y1[j].w); }
        }
        if (L == 0) {
            const float* xin = (smp ? Pk->in[1] + (size_t)b * 4096 : Pk->in[0] + (size_t)row * 4096);
#pragma unroll
            for (int j = 0; j < 8; ++j) { x0[j] = *(const f32x4*)(xin + j * 512 + lane * 8); x1[j] = *(const f32x4*)(xin + j * 512 + lane * 8 + 4); }
        } else {
#pragma unroll
            for (int j = 0; j < 8; ++j) { const u32x4 xv = *(const u32x4*)(XBF + (size_t)row * 4096 + j * 512 + lane * 8);
                x0[j] = (f32x4){bflo(xv.x), bfhi(xv.x), bflo(xv.y), bfhi(xv.y)}; x1[j] = (f32x4){bflo(xv.z), bfhi(xv.z), bflo(xv.w), bfhi(xv.w)}; }
        }
        const float rsn = rsqrtf(wave_sum(ssq) * (1.0f / 4096.0f) + EPSN);
        float acc = 0.f;
        float* xout = Pk->out + (smp ? OUT_YS + (size_t)b * 4096 : OUT_YP + (size_t)row * 4096);
#pragma unroll
        for (int j = 0; j < 8; ++j) {
            const int col = j * 512 + lane * 8;
            const f32x4 g0 = *(const f32x4*)(gain + col), g1 = *(const f32x4*)(gain + col + 4);
            const f32x4 n0 = x0[j] + y0[j] * rsn * g0, n1 = x1[j] + y1[j] * rsn * g1;
            acc += (n0.x * n0.x + n0.y * n0.y) + (n0.z * n0.z + n0.w * n0.w) + (n1.x * n1.x + n1.y * n1.y) + (n1.z * n1.z + n1.w * n1.w);
            if (L == 3) { *(f32x4*)(xout + col) = n0; *(f32x4*)(xout + col + 4) = n1; }
            else { u32x4 q; q.x = pk2(n0.x, n0.y); q.y = pk2(n0.z, n0.w); q.z = pk2(n1.x, n1.y); q.w = pk2(n1.z, n1.w); *(u32x4*)(XBF + (size_t)row * 4096 + col) = q; }
        }
        acc = wave_sum(acc);
        if (lane == 0) RS[row] = rsqrtf(acc * (1.0f / 4096.0f) + EPSN);
    }
}

constexpr int KROW = 272, VROW = 320, OFF_VS = 69632, OFF_BI = OFF_VS + 81920, OFF_SW = OFF_BI + 2112;
__device__ __forceinline__ void attn_item(const Params& P, LAS unsigned char* lds, int item) {
    const KParams Pk = kparams();
    int tid = threadIdx.x; asm volatile("" : "+v"(tid));
    const int lane = tid & 63, w = __builtin_amdgcn_readfirstlane(tid >> 6), hh = lane >> 5, l32 = lane & 31;
    unsigned char* ws = Pk->ws;
    const bf16_t* Q = (const bf16_t*)(ws + P_Q); const bf16_t* KVB = (const bf16_t*)(ws + O_KVB); bf16_t* ON = (bf16_t*)(ws + P_ON); float* LSE = (float*)(ws + O_LSE);
    const int g = item >> 8, rem = item & 255, n = rem >> 6, kvh = rem & 3, cb = (rem >> 2) & 15;
    const int r = 1 << (2 * g), nb = 16 >> (2 * g), c = cb / nb, nbi = cb % nb;
    LAS unsigned char* Ks = lds; LAS unsigned char* Vs = lds + OFF_VS; LAS float* BI = (LAS float*)(lds + OFF_BI);
    __syncthreads();
#pragma unroll
    for (int j = 0; j < 8; ++j) {
        const int id = tid + 512 * j, kk = id >> 4, chk = id & 15, pos = (nbi - 1) * 128 + kk;
        u32x4 kv = {0u, 0u, 0u, 0u}, vv = {0u, 0u, 0u, 0u};
        if (pos >= 0) { const bf16_t* src = KVB + (size_t)(n * 2048 + pos * r + c) * 3072 + g * 1024 + kvh * 128 + chk * 8; kv = *(const u32x4*)src; vv = *(const u32x4*)(src + 512); }
        *(LAS u32x4*)(Ks + kk * KROW + chk * 16) = kv; *(LAS u32x4*)(Vs + kk * VROW + chk * 16) = vv;
    }
    for (int e = tid; e < 516; e += 512) { const int hl = e / 129, dist = e % 129; BI[hl * 132 + dist] = 1.4426950408889634f * Pk->in[20][rel_bucket(dist * r) * 48 + g * 16 + kvh * 4 + hl]; }
    __syncthreads();
    const float scale2 = 0.08838834764831845f * 1.4426950408889634f;
    const int qc = w & 3, qq = qc * 32 + l32, qrow = n * 2048 + (nbi * 128 + qq) * r + c;
    bf16x8 Qf[8];
    { const bf16_t* qp = Q + (size_t)qrow * 6144 + g * 2048 + (kvh * 4 + (w >> 2)) * 128 + hh * 8;
#pragma unroll
      for (int s = 0; s < 8; ++s) Qf[s] = *(const bf16x8*)(qp + s * 16); }
    for (int pp = 0; pp < 2; ++pp) {
        const int hl = (w >> 2) + 2 * pp, slot = kvh * 4 + hl;
        f32x16 S[5];
#pragma unroll
        for (int kt = 0; kt < 5; ++kt) {
#pragma unroll
            for (int e = 0; e < 16; ++e) S[kt][e] = 0.f;
            if (nbi > 0 || qc + kt >= 4) {
#pragma unroll
                for (int s = 0; s < 8; ++s) {
                    const bf16x8 a = *(const LAS bf16x8*)(Ks + (qc * 32 + kt * 32 + l32) * KROW + (s * 16 + hh * 8) * 2);
                    S[kt] = MFMA32(a, Qf[s], S[kt]);
                }
            }
            __builtin_amdgcn_sched_barrier(0);
        }
        if (pp == 0) {
            const bf16_t* qp = Q + (size_t)qrow * 6144 + g * 2048 + (slot + 2) * 128 + hh * 8;
#pragma unroll
            for (int s = 0; s < 8; ++s) Qf[s] = *(const bf16x8*)(qp + s * 16);
        }
        float m = -INFINITY;
#pragma unroll
        for (int kt = 0; kt < 5; ++kt) {
            const bool on = nbi > 0 || qc + kt >= 4;
            const LAS float* bp = BI + hl * 132 + (128 - 32 * kt - 27 - 4 * hh) + l32;
#pragma unroll
            for (int reg = 0; reg < 16; ++reg) {
                const int kc = (reg & 3) + 8 * (reg >> 2);
                float sv = S[kt][reg] * scale2 + bp[27 - kc];
                if (kt == 0) sv = (kc + 4 * hh >= l32) ? sv : -INFINITY;
                if (kt == 4) sv = (kc + 4 * hh <= l32) ? sv : -INFINITY;
                if (!on) sv = -INFINITY;
                S[kt][reg] = sv; m = fmaxf(m, sv);
            }
            __builtin_amdgcn_sched_barrier(0);
        }
        m = fmaxf(m, __shfl_xor(m, 32));
        float den = 0.f;
#pragma unroll
        for (int kt = 0; kt < 5; ++kt)
#pragma unroll
            for (int reg = 0; reg < 16; ++reg) { const float p = __builtin_amdgcn_exp2f(S[kt][reg] - m); S[kt][reg] = p; den += p; }
        den += __shfl_xor(den, 32);
        f32x16 O[4];
#pragma unroll
        for (int dt = 0; dt < 4; ++dt)
#pragma unroll
            for (int e = 0; e < 16; ++e) O[dt][e] = 0.f;
        const int q_ = (lane & 15) >> 2, p_ = lane & 3, cg16 = (lane >> 4) & 1;
#pragma unroll
        for (int kt = 0; kt < 5; ++kt) {
            if (nbi > 0 || qc + kt >= 4) {
#pragma unroll
                for (int s2 = 0; s2 < 2; ++s2) {
                    u32x4 pw; pw.x = pk2(S[kt][8 * s2 + 0], S[kt][8 * s2 + 1]); pw.y = pk2(S[kt][8 * s2 + 2], S[kt][8 * s2 + 3]); pw.z = pk2(S[kt][8 * s2 + 4], S[kt][8 * s2 + 5]); pw.w = pk2(S[kt][8 * s2 + 6], S[kt][8 * s2 + 7]);
                    const bf16x8 pf = __builtin_bit_cast(bf16x8, pw);
                    const int R0 = qc * 32 + kt * 32 + 16 * s2 + 4 * hh;
#pragma unroll
                    for (int dt = 0; dt < 4; ++dt) {
                        LAS unsigned char* ad = Vs + (R0 + q_) * VROW + (dt * 32 + 16 * cg16 + 4 * p_) * 2;
                        const s16x4 lo = __builtin_amdgcn_ds_read_tr16_b64_v4i16((LAS s16x4*)ad), hi = __builtin_amdgcn_ds_read_tr16_b64_v4i16((LAS s16x4*)(ad + 8 * VROW));
                        bf16x8 a; a[0] = lo[0]; a[1] = lo[1]; a[2] = lo[2]; a[3] = lo[3]; a[4] = hi[0]; a[5] = hi[1]; a[6] = hi[2]; a[7] = hi[3];
                        O[dt] = MFMA32(a, pf, O[dt]);
                    }
                    __builtin_amdgcn_sched_barrier(0);
                }
            }
        }
        const float inv = __builtin_amdgcn_rcpf(den);
        bf16_t* op = ON + ((size_t)g * RP + qrow) * 2048 + slot * 128 + 4 * hh;
#pragma unroll
        for (int dt = 0; dt < 4; ++dt)
#pragma unroll
            for (int g4 = 0; g4 < 4; ++g4) {
                u32x2 q; q.x = pk2(O[dt][4 * g4] * inv, O[dt][4 * g4 + 1] * inv); q.y = pk2(O[dt][4 * g4 + 2] * inv, O[dt][4 * g4 + 3] * inv);
                *(u32x2*)(op + dt * 32 + 8 * g4) = q;
            }
        if (hh == 0) LSE[((size_t)g * RP + qrow) * 16 + slot] = (m + __builtin_amdgcn_logf(den)) * 0.6931471805599453f;
    }
}

__device__ __forceinline__ void sample_attn(const Params& P, LAS unsigned char* lds, int si, int lbi, int wv) {
    const KParams Pk = kparams();
    int tid = threadIdx.x; asm volatile("" : "+v"(tid));
    const int lane = tid & 63;
    unsigned char* ws = Pk->ws;
    const float* PART = (const float*)(ws + O_PART); const float* RS = (const float*)(ws + O_RS); bf16_t* ON = (bf16_t*)(ws + P_ON); float* LSE = (float*)(ws + O_LSE);
    const int b = si / 48, rem = si % 48, g = rem >> 4, slot = rem & 15, kvh = slot >> 2, r = 1 << (2 * g), lbuf = 128 << (2 * g);
    const int N = lbi == 0 ? 11264 : 8192;
    const float* state = Pk->in[4 + g]; float* skv = Pk->out + (g == 0 ? OUT_SKV0 : (g == 1 ? OUT_SKV1 : OUT_SKV2));
    LAS float* qs = (LAS float*)(lds + OFF_SW + wv * 2064); LAS float* pw = qs + 128; LAS float* kn = qs + 260; LAS float* vn = qs + 388;
    const float rsb = RS[TP + b];
#pragma unroll
    for (int e = 0; e < 2; ++e) {
        const int d = lane * 2 + e;
        qs[d] = rsb * part_sum(PART, N, b, g * 2048 + slot * 128 + d);
        float kvl, vvl;
        if (lbi == 0) { kvl = rsb * part_sum(PART, N, b, 8192 + g * 1024 + kvh * 128 + d); vvl = rsb * part_sum(PART, N, b, 8192 + g * 1024 + 512 + kvh * 128 + d);
            if ((slot & 3) == 0) { float* dst = skv + ((size_t)(b * lbuf + lbuf - 1) * 2) * 512 + kvh * 128 + d; dst[0] = kvl; dst[512] = vvl; } }
        else { const float* srcp = skv + ((size_t)(b * lbuf + lbuf - 1) * 2) * 512 + kvh * 128 + d; kvl = srcp[0]; vvl = srcp[512]; }
        kn[d] = kvl; vn[d] = vvl;
    }
    LDS_WAIT();
    const float scale = 0.08838834764831845f;
    float m = -INFINITY;
#pragma unroll 1
    for (int rd = 0; rd < 3; ++rd) {
        const int step = lane + 64 * rd; float s = -INFINITY;
        if (step <= 128) {
            float dot = 0.f;
            if (step == 0) {
#pragma unroll 8
                for (int d = 0; d < 128; ++d) dot += qs[d] * kn[d]; }
            else { const f32x4* kr = (const f32x4*)(state + ((size_t)(b * lbuf + lbuf - step * r) * 2) * 512 + kvh * 128);
                f32x4 kv[32];
#pragma unroll
                for (int d4 = 0; d4 < 32; ++d4) kv[d4] = kr[d4];
#pragma unroll
                for (int d4 = 0; d4 < 32; ++d4) { const f32x4 qv = *(const LAS f32x4*)(qs + d4 * 4); dot += (kv[d4].x * qv.x + kv[d4].y * qv.y) + (kv[d4].z * qv.z + kv[d4].w * qv.w); } }
            s = dot * scale + Pk->in[20][rel_bucket(step * r) * 48 + g * 16 + slot];
            pw[step] = s;
        }
        m = fmaxf(m, s);
    }
    m = wave_max(m);
    LDS_WAIT();
    float den = 0.f;
#pragma unroll
    for (int rd = 0; rd < 3; ++rd) { const int step = lane + 64 * rd; if (step <= 128) { const float p = __expf(pw[step] - m); den += p; pw[step] = p; } }
    den = wave_sum(den);
    LDS_WAIT();
    float o0 = pw[0] * vn[lane * 2], o1 = pw[0] * vn[lane * 2 + 1];
#pragma unroll 1
    for (int s0 = 1; s0 <= 128; s0 += 32) {
        f32x2 v[32];
#pragma unroll
        for (int j = 0; j < 32; ++j) v[j] = *(const f32x2*)(state + ((size_t)(b * lbuf + lbuf - (s0 + j) * r) * 2 + 1) * 512 + kvh * 128 + lane * 2);
#pragma unroll
        for (int j = 0; j < 32; ++j) { const float p = pw[s0 + j]; o0 += p * v[j].x; o1 += p * v[j].y; }
    }
    const float inv = 1.0f / den;
    *(unsigned*)(ON + ((size_t)g * RP + TP + b) * 2048 + slot * 128 + lane * 2) = pk2(o0 * inv, o1 * inv);
    if (lane == 0) LSE[((size_t)g * RP + TP + b) * 16 + slot] = m + __logf(den);
    LDS_WAIT();
}

__device__ __forceinline__ void combine_phase(const Params& P, int lbi) {
    const KParams Pk = kparams();
    int tid = threadIdx.x; asm volatile("" : "+v"(tid));
    const int lane = tid & 63, w = __builtin_amdgcn_readfirstlane(tid >> 6);
    const int gw = blockIdx.x * 8 + w, NGW = gridDim.x * 8;
    unsigned char* ws = Pk->ws;
    const bf16_t* ON = (const bf16_t*)(ws + P_ON); const float* LSE = (const float*)(ws + O_LSE); const bf16_t* SG2 = (const bf16_t*)(ws + O_SG2); bf16_t* OG = (bf16_t*)(ws + O_OG);
    const float* PART = (const float*)(ws + O_PART); const float* RS = (const float*)(ws + O_RS);
    const int N = lbi == 0 ? 11264 : 8192;
    for (int row = gw; row < TP + 8; row += NGW) {
#pragma unroll
        for (int cch = 0; cch < 4; ++cch) {
            const int col = cch * 512 + lane * 8, slot = col >> 7;
            const float l0 = LSE[((size_t)0 * RP + row) * 16 + slot], l1 = LSE[((size_t)1 * RP + row) * 16 + slot], l2 = LSE[((size_t)2 * RP + row) * 16 + slot];
            const float mx = fmaxf(l0, fmaxf(l1, l2)); float w0 = __expf(l0 - mx), w1 = __expf(l1 - mx), w2 = __expf(l2 - mx);
            const float iw = 1.0f / (w0 + w1 + w2); w0 *= iw; w1 *= iw; w2 *= iw;
            const u32x4 a0 = *(const u32x4*)(ON + ((size_t)0 * RP + row) * 2048 + col), a1 = *(const u32x4*)(ON + ((size_t)1 * RP + row) * 2048 + col), a2 = *(const u32x4*)(ON + ((size_t)2 * RP + row) * 2048 + col);
            float gt[8];
            if (row < TP) { const u32x4 sv = *(const u32x4*)(SG2 + (size_t)row * 2048 + col);
                gt[0] = bflo(sv.x); gt[1] = bfhi(sv.x); gt[2] = bflo(sv.y); gt[3] = bfhi(sv.y); gt[4] = bflo(sv.z); gt[5] = bfhi(sv.z); gt[6] = bflo(sv.w); gt[7] = bfhi(sv.w); }
            else { const int b = row - TP; const float rsb = RS[row];
#pragma unroll
                for (int e = 0; e < 8; ++e) gt[e] = silu_f(rsb * part_sum(PART, N, b, 6144 + col + e)); }
            float o[8];
            o[0] = w0 * bflo(a0.x) + w1 * bflo(a1.x) + w2 * bflo(a2.x); o[1] = w0 * bfhi(a0.x) + w1 * bfhi(a1.x) + w2 * bfhi(a2.x);
            o[2] = w0 * bflo(a0.y) + w1 * bflo(a1.y) + w2 * bflo(a2.y); o[3] = w0 * bfhi(a0.y) + w1 * bfhi(a1.y) + w2 * bfhi(a2.y);
            o[4] = w0 * bflo(a0.z) + w1 * bflo(a1.z) + w2 * bflo(a2.z); o[5] = w0 * bfhi(a0.z) + w1 * bfhi(a1.z) + w2 * bfhi(a2.z);
            o[6] = w0 * bflo(a0.w) + w1 * bflo(a1.w) + w2 * bflo(a2.w); o[7] = w0 * bfhi(a0.w) + w1 * bfhi(a1.w) + w2 * bfhi(a2.w);
            u32x4 q; q.x = pk2(o[0] * gt[0], o[1] * gt[1]); q.y = pk2(o[2] * gt[2], o[3] * gt[3]); q.z = pk2(o[4] * gt[4], o[5] * gt[5]); q.w = pk2(o[6] * gt[6], o[7] * gt[7]);
            *(u32x4*)(OG + (size_t)row * 2048 + col) = q;
        }
    }
}

__global__ __launch_bounds__(512, 2) void yoco_mega(Params P) {
    extern __shared__ __attribute__((aligned(16))) unsigned char shm[];
    LAS unsigned char* lds = (LAS unsigned char*)shm;
    cg::grid_group grid = cg::this_grid();
    const KParams Pk = kparams();
    unsigned char* ws = Pk->ws;
    const int w = threadIdx.x >> 6;
    if (threadIdx.x == 0) { *(LAS u32x4*)(lds + OFF_XB) = (u32x4){0u, 0u, 0u, 0u}; }
    __syncthreads();
    const XcdBarrier xb = xcd_barrier_post((unsigned*)(ws + O_BAR), (volatile LAS unsigned*)(lds + OFF_XB));
    prep_phase(P, lds);
    grid.sync();
    for (int L = 0; L < 4; ++L) {
        for (int half = 0; half < 2; ++half) {
            pg8::Gemm gm; Epi E; gm.M = TP;
            E.rs = (const float*)(ws + O_RS); E.ssqp = (float*)(ws + O_SSQP); E.outp = Pk->out; E.o2 = (bf16_t*)(ws + O_KVB);
            if (half == 0) {
                gm.A = (const bf16_t*)(ws + O_XBF); gm.K = 4096;
                if (L < 2) { gm.Bt = (const bf16_t*)(ws + O_BT1) + (size_t)L * 8192 * 4096; gm.N = 8192; E.mode = 0; E.o0 = (bf16_t*)(ws + P_XB); E.o1 = (bf16_t*)(ws + P_SG); }
                else { gm.Bt = (const bf16_t*)(ws + (L == 2 ? O_BT3 : O_BT4)); gm.N = L == 2 ? 11264 : 8192; E.mode = 2; E.o0 = (bf16_t*)(ws + P_Q); E.o1 = (bf16_t*)(ws + O_SG2); }
            } else {
                E.mode = 1; E.o0 = (bf16_t*)(ws + O_Y); E.o1 = E.o0; gm.N = 4096;
                if (L < 2) { gm.A = (const bf16_t*)(ws + P_HG); gm.Bt = (const bf16_t*)(ws + O_BT2) + (size_t)L * 4096 * 4096; gm.K = 4096; }
                else { gm.A = (const bf16_t*)(ws + O_OG); gm.Bt = (const bf16_t*)(ws + O_BT5) + (size_t)(L - 2) * 4096 * 2048; gm.K = 2048; }
            }
            pg8::StaticOrder S; S.init(gm.M, gm.N, (int)gridDim.x, (int)blockIdx.x);
            pg8::gemm_phase<Epi, pg8::StaticOrder, false>(lds, gm, S, E, nullptr);
            __syncthreads();
            if (gm.K == 4096) skinny_phase<16>(gm.A + (size_t)TP * gm.K, gm.Bt, gm.N, gm.K, (float*)(ws + O_PART), lds);
            else skinny_phase<8>(gm.A + (size_t)TP * gm.K, gm.Bt, gm.N, gm.K, (float*)(ws + O_PART), lds);
            xcd_barrier(xb);
            if (half == 0) {
                if (L < 2) {
                    scan_phase(P, lds, L);
                } else {
                    for (int wv = 0; wv < 2; ++wv) { const int si = wv * 256 + (int)blockIdx.x; if (si < 384 && w == wv && gridDim.x >= 256) sample_attn(P, lds, si, L - 2, wv); }
                    if (gridDim.x < 256 && w < 2) for (int si = blockIdx.x * 2 + w; si < 384; si += gridDim.x * 2) sample_attn(P, lds, si, L - 2, w);
                    for (int it = blockIdx.x; it < 768; it += gridDim.x) attn_item(P, lds, it);
                    xcd_barrier(xb);
                    combine_phase(P, L - 2);
                }
            } else {
                post_phase(P, L);
            }
            if (!(L == 3 && half == 1)) xcd_barrier(xb);
        }
    }
}

extern "C" void kernel_launch(void* const* d_in, const int* in_sizes, int n_in, void* d_out, int out_size, void* d_ws, size_t ws_size, hipStream_t stream) {
    static int grid_blocks = 0;
    if (!grid_blocks) {
        int dev = 0, cus = 0, per_cu = 0;
        hipGetDevice(&dev);
        hipDeviceGetAttribute(&cus, hipDeviceAttributeMultiprocessorCount, dev);
        hipFuncSetAttribute((const void*)yoco_mega, hipFuncAttributeMaxDynamicSharedMemorySize, LDS_BYTES);
        if (hipOccupancyMaxActiveBlocksPerMultiprocessor(&per_cu, (const void*)yoco_mega, 512, LDS_BYTES) != hipSuccess || per_cu < 1) per_cu = 1;
        (void)hipGetLastError();
        grid_blocks = cus * per_cu;
        if (ws_size < O_END) fprintf(stderr, "kernel_launch: workspace too small: %zu < %zu\n", ws_size, (size_t)O_END);
    }
    (void)hipMemsetAsync((unsigned char*)d_ws + O_BAR, 0, XCD_BAR_WORDS * sizeof(unsigned), stream);
    Params p{};
    for (int i = 0; i < 25; ++i) p.in[i] = (const float*)d_in[i];
    p.out = (float*)d_out; p.ws = (unsigned char*)d_ws;
    void* args[] = {&p};
    hipError_t e = hipLaunchCooperativeKernel((const void*)yoco_mega, dim3(grid_blocks), dim3(512), args, LDS_BYTES, stream);
    if (e != hipSuccess) fprintf(stderr, "cooperative launch failed: %s (grid %d)\n", hipGetErrorString(e), grid_blocks);
}
```

```cpp
#include <hip/hip_runtime.h>
#include <hip/hip_cooperative_groups.h>
#include <cstdio>
namespace cg = cooperative_groups;

namespace pg8 {
#define PG8_LAS __attribute__((address_space(3)))
typedef unsigned short bf16_t;
typedef short bf16x8 __attribute__((ext_vector_type(8)));
typedef float f32x4 __attribute__((ext_vector_type(4)));
typedef unsigned u32x4 __attribute__((ext_vector_type(4)));
constexpr int BM = 256, BK = 64, HALF = 128, HTB = HALF * BK * 2, STAGE_BYTES = 8 * HTB, NXCD = 8, WGM = 8;

__host__ __device__ __forceinline__ int lds_byte(int r, int c) { const int st = (r >> 4) * 2 + (c >> 5), rr = r & 15, cc = c & 31, ob = rr * 64 + cc * 2; return st * 1024 + (ob ^ (((ob >> 9) & 1) << 5)); }
__host__ __device__ __forceinline__ void stage_rc(int b, int& R, int& C) { const int st = b / 1024, sb = b % 1024, swz = sb ^ (((sb >> 9) & 1) << 5); R = (st >> 1) * 16 + swz / 64; C = (st & 1) * 32 + (swz % 64) / 2; }
__host__ __device__ __forceinline__ int perm32(int rho) { const int n = rho >> 4, i = rho & 15; return 8 * (i >> 2) + 4 * n + (i & 3); }

struct Unit { int pm, pn; };
struct Gemm { const bf16_t* A; const bf16_t* Bt; int M, N, K; };

struct StaticOrder {
    int nM, nN, nwg, G, c;
    __host__ __device__ void init(int M, int N, int G_, int c_) { nM = M / BM; nN = N / BM; nwg = nM * nN; G = G_; c = c_; }
    __host__ __device__ bool next(int i, Unit& u) const {
        const long L = (long)i * G + c; if (L >= nwg) return false;
        int wgid = (int)L; { const int q = nwg / NXCD, r = nwg % NXCD, xcd = wgid % NXCD, off = wgid / NXCD; wgid = (xcd < r ? xcd * (q + 1) : r * (q + 1) + (xcd - r) * q) + off; }
        const int nig = WGM * nN, gid = wgid / nig, fm = gid * WGM, gsz = (nM - fm) < WGM ? (nM - fm) : WGM;
        u.pm = fm + ((wgid % nig) % gsz); u.pn = (wgid % nig) / gsz; return true;
    }
    __device__ __forceinline__ void a_ready(const Unit&) const {}
    __device__ __forceinline__ void done(const Unit&) const {}
};
template <class Epi, class Sched, bool STAMP = false>
__device__ __forceinline__ void gemm_phase(PG8_LAS unsigned char* lds, const Gemm g, const Sched& S, const Epi& E, unsigned long long* stamps) {
    int tid = threadIdx.x; asm volatile("" : "+v"(tid));
    const int wid = __builtin_amdgcn_readfirstlane(tid >> 6), lane = tid & 63, wr = wid >> 2, wc = wid & 3, fr = lane & 15, fq = lane >> 4;
    const int K = g.K, nt = K / BK;
    int ts_lo = 0, ts_hi = 0, nts = 0; const unsigned long long rt_entry = STAMP ? (unsigned long long)wall_clock64() : 0ull;
#define PG8_STAMP() do { if (STAMP && wid == 0 && nts < 64) { const unsigned long long _c = (unsigned long long)clock64(); \
        ts_lo = (lane == nts) ? (int)(unsigned)_c : ts_lo; ts_hi = (lane == nts) ? (int)(unsigned)(_c >> 32) : ts_hi; ++nts; } } while (0)
    PG8_STAMP();
    unsigned voffA[2], voffB[2];
#pragma unroll
    for (int i = 0; i < 2; ++i) { int R, C; stage_rc(tid * 16 + i * 8192, R, C); const int Rb = Epi::PERM ? ((R & ~31) + perm32(R & 31)) : R;
        voffA[i] = (unsigned)(R * K + C) * 2u; voffB[i] = (unsigned)(Rb * K + C) * 2u; }
    const size_t kstep = (size_t)(BK * 2);
    const size_t hstep = (size_t)HALF * K * 2;
    const size_t tstep = 2 * hstep;
    const unsigned ldsw = (unsigned)wid * 1024u;
    const int aoff = lds_byte(wr * 64 + fr, fq * 8), boff = lds_byte(wc * 32 + fr, fq * 8);
#define PG8_SA(b, h) (((b) * 2 + (h)) * HTB)
#define PG8_SB(b, h) ((4 + (b) * 2 + (h)) * HTB)
#define PG8_STAGE(bufoff, gbase, voff) do { _Pragma("unroll") for (int _i = 0; _i < 2; ++_i) \
        __builtin_amdgcn_global_load_lds((const unsigned*)((const char*)(gbase) + (voff)[_i]), (PG8_LAS unsigned*)(lds + (bufoff) + ldsw + _i * 8192), 16, 0, 0); } while (0)
#define PG8_LDA(dst, b, h) do { _Pragma("unroll") for (int m = 0; m < 4; ++m) _Pragma("unroll") for (int k = 0; k < 2; ++k) dst[m][k] = *(const PG8_LAS bf16x8*)(lds + PG8_SA(b, h) + aoff + m * 2048 + k * 1024); } while (0)
#define PG8_LDB(dst, b, h) do { _Pragma("unroll") for (int n = 0; n < 2; ++n) _Pragma("unroll") for (int k = 0; k < 2; ++k) dst[n][k] = *(const PG8_LAS bf16x8*)(lds + PG8_SB(b, h) + boff + n * 2048 + k * 1024); } while (0)
#define PG8_MMA(ai, bj, At, Bt) do { __builtin_amdgcn_s_setprio(1); _Pragma("unroll") for (int m = 0; m < 4; ++m) _Pragma("unroll") for (int n = 0; n < 2; ++n) _Pragma("unroll") for (int k = 0; k < 2; ++k) \
        acc[ai][bj][m][n] = __builtin_amdgcn_mfma_f32_16x16x32_bf16(Bt[n][k], At[m][k], acc[ai][bj][m][n], 0, 0, 0); __builtin_amdgcn_s_setprio(0); } while (0)
#define PG8_WAIT_V(n) asm volatile("s_waitcnt vmcnt(" #n ")" ::: "memory")
#define PG8_WAIT_L(n) asm volatile("s_waitcnt lgkmcnt(" #n ")" ::: "memory")
#define PG8_BAR __builtin_amdgcn_s_barrier()
#define PG8_SCHED __builtin_amdgcn_sched_barrier(0)
    Unit cur, nxt; int ui = 0;
    if (!S.next(0, cur)) return;
    f32x4 acc[2][2][4][2];
#pragma unroll
    for (int a = 0; a < 2; ++a)
#pragma unroll
        for (int b = 0; b < 2; ++b)
#pragma unroll
            for (int m = 0; m < 4; ++m)
#pragma unroll
                for (int n = 0; n < 2; ++n) acc[a][b][m][n] = (f32x4){0.f, 0.f, 0.f, 0.f};
    bf16x8 At[4][2], B0[2][2], B1[2][2];
    const char* cA = (const char*)g.A + (size_t)cur.pm * tstep; const char* cB = (const char*)g.Bt + (size_t)cur.pn * tstep;
    S.a_ready(cur);
    PG8_STAGE(PG8_SB(0, 0), cB, voffB); PG8_STAGE(PG8_SA(0, 0), cA, voffA); PG8_STAGE(PG8_SB(0, 1), cB + hstep, voffB); PG8_STAGE(PG8_SA(0, 1), cA + hstep, voffA);
    if (wr == 1) PG8_BAR;
    PG8_WAIT_V(4); PG8_BAR;
    PG8_STAGE(PG8_SB(1, 0), cB + kstep, voffB); PG8_STAGE(PG8_SA(1, 0), cA + kstep, voffA); PG8_STAGE(PG8_SB(1, 1), cB + hstep + kstep, voffB);
    PG8_WAIT_V(6); PG8_BAR;
    PG8_STAMP();
    for (;;) {
        const bool has_next = S.next(ui + 1, nxt);
        const char* nA = has_next ? (const char*)g.A + (size_t)nxt.pm * tstep : cA; const char* nB = has_next ? (const char*)g.Bt + (size_t)nxt.pn * tstep : cB;
        for (int t = 0; t < nt; t += 2) {
            const bool last = (t == nt - 2);
            const char* a1 = cA + (size_t)(t + 1) * kstep;
            const char* a2 = last ? nA : cA + (size_t)(t + 2) * kstep; const char* b2 = last ? nB : cB + (size_t)(t + 2) * kstep;
            const char* a3 = a2 + kstep; const char* b3 = b2 + kstep;
            if (last && has_next) S.a_ready(nxt);
            PG8_LDB(B0, 0, 0); PG8_SCHED; PG8_LDA(At, 0, 0); PG8_STAGE(PG8_SA(1, 1), a1 + hstep, voffA);
            PG8_WAIT_L(8); PG8_BAR; PG8_WAIT_L(0); PG8_MMA(0, 0, At, B0); PG8_BAR; PG8_SCHED;
            PG8_LDB(B1, 0, 1); PG8_STAGE(PG8_SB(0, 0), b2, voffB);
            PG8_BAR; PG8_WAIT_L(0); PG8_MMA(0, 1, At, B1); PG8_BAR;
            PG8_LDA(At, 0, 1); PG8_STAGE(PG8_SA(0, 0), a2, voffA);
            PG8_BAR; PG8_WAIT_L(0); PG8_MMA(1, 0, At, B0); PG8_BAR; PG8_SCHED;
            PG8_STAGE(PG8_SB(0, 1), b2 + hstep, voffB);
            PG8_WAIT_V(6); PG8_BAR; PG8_MMA(1, 1, At, B1); PG8_BAR;
            PG8_LDB(B0, 1, 0); PG8_SCHED; PG8_LDA(At, 1, 0); PG8_STAGE(PG8_SA(0, 1), a2 + hstep, voffA);
            PG8_WAIT_L(8); PG8_BAR; PG8_WAIT_L(0); PG8_MMA(0, 0, At, B0); PG8_BAR; PG8_SCHED;
            PG8_LDB(B1, 1, 1); PG8_STAGE(PG8_SB(1, 0), b3, voffB);
            PG8_BAR; PG8_WAIT_L(0); PG8_MMA(0, 1, At, B1); PG8_BAR;
            PG8_LDA(At, 1, 1); PG8_STAGE(PG8_SA(1, 0), a3, voffA);
            PG8_BAR; PG8_WAIT_L(0); PG8_MMA(1, 0, At, B0); PG8_BAR; PG8_SCHED;
            PG8_STAGE(PG8_SB(1, 1), b3 + hstep, voffB);
            PG8_WAIT_V(6); PG8_BAR; PG8_MMA(1, 1, At, B1); PG8_BAR;
        }
        PG8_STAMP();
        if constexpr (!Epi::AFTER_DRAIN) { E(acc, cur, wr, wc, fr, fq); S.done(cur); }
        PG8_STAMP();
        if (!has_next) break;
#pragma unroll
        for (int a = 0; a < 2; ++a)
#pragma unroll
            for (int b = 0; b < 2; ++b)
#pragma unroll
                for (int m = 0; m < 4; ++m)
#pragma unroll
                    for (int n = 0; n < 2; ++n) acc[a][b][m][n] = (f32x4){0.f, 0.f, 0.f, 0.f};
        cur = nxt; cA = nA; cB = nB; ++ui;
    }
    PG8_WAIT_V(0);
    if (wr == 0) PG8_BAR;
    PG8_BAR;
    if constexpr (Epi::AFTER_DRAIN) { E.fused(acc, cur, wr, wc, fr, fq, lds, wid, lane); S.done(cur); }
    PG8_STAMP();
    if (STAMP && wid == 0) { stamps[lane] = lane < nts ? (((unsigned long long)(unsigned)ts_hi << 32) | (unsigned)ts_lo) : 0ull;
        if (lane == 62) stamps[62] = rt_entry; if (lane == 63) stamps[63] = (unsigned long long)wall_clock64(); }
#undef PG8_STAMP
#undef PG8_SA
#undef PG8_SB
#undef PG8_STAGE
#undef PG8_LDA
#undef PG8_LDB
#undef PG8_MMA
#undef PG8_WAIT_V
#undef PG8_WAIT_L
#undef PG8_BAR
#undef PG8_SCHED
}}

using pg8::bf16_t; using pg8::bf16x8; using pg8::f32x4; using pg8::u32x4;
typedef short s16x4 __attribute__((ext_vector_type(4)));
typedef float f32x16 __attribute__((ext_vector_type(16)));
typedef float f32x2 __attribute__((ext_vector_type(2)));
typedef unsigned u32x2 __attribute__((ext_vector_type(2)));
typedef unsigned long long u64;
#define LAS __attribute__((address_space(3)))
#define LDS_WAIT() asm volatile("s_waitcnt lgkmcnt(0)" ::: "memory")
#define XB_TMO      128
#define XB_XCNT(j)  (256  + 64 * (j))
#define XB_XSUB(j)  (1280 + 64 * (j))
#define XB_XGEN(j)  (2304 + 64 * (j))
#define XB_TOP      3328
#define XB_TOPGEN   3392
#define XCD_BAR_WORDS 3456
#define XB_SPIN_CAP (1u << 18)

__device__ __forceinline__ unsigned xb_ld(unsigned* p)              { return __hip_atomic_load(p, __ATOMIC_RELAXED, __HIP_MEMORY_SCOPE_AGENT); }
__device__ __forceinline__ unsigned xb_add(unsigned* p, unsigned v) { return __hip_atomic_fetch_add(p, v, __ATOMIC_RELAXED, __HIP_MEMORY_SCOPE_AGENT); }
__device__ __forceinline__ unsigned xb_xcc_id() { return (unsigned)__builtin_amdgcn_s_getreg((3 << 11) | 20) & 0xFu; }
#define XB_SPIN(cond, bar) do { unsigned _sp = 0; while (cond) { __builtin_amdgcn_s_sleep(1); \
    if ((++_sp & 255u) == 0u) { if (xb_ld(&(bar)[XB_TMO])) break; if (_sp > XB_SPIN_CAP) { atomicAdd(&(bar)[XB_TMO], 1u); break; } } } } while (0)

struct XcdBarrier {
    unsigned* bar; unsigned x;
    volatile LAS unsigned* st;
};

__device__ __forceinline__ XcdBarrier xcd_barrier_post(unsigned* bar, volatile LAS unsigned* st) {
    XcdBarrier b; b.bar = bar; b.x = xb_xcc_id(); b.st = st;
    if (threadIdx.x == 0) (void)xb_add(&bar[XB_XCNT(b.x)], 1u);
    return b;
}
__device__ __forceinline__ void xcd_barrier_complete(unsigned* bar, unsigned x, unsigned& nloc, unsigned& nx) {
    const unsigned G = gridDim.x * gridDim.y * gridDim.z;
    unsigned sum, cnt, mine, sp = 0u;
    for (;;) {
        sum = 0u; cnt = 0u; mine = 0u;
#pragma unroll
        for (unsigned j = 0; j < 16; ++j) { const unsigned c = xb_ld(&bar[XB_XCNT(j)]); sum += c; cnt += (c > 0u) ? 1u : 0u; mine = (j == x) ? c : mine; }
        if (sum == G) break;
        __builtin_amdgcn_s_sleep(1);
        if ((++sp & 255u) == 0u) { if (xb_ld(&bar[XB_TMO])) break; if (sp > XB_SPIN_CAP) { atomicAdd(&bar[XB_TMO], 1u); break; } }
    }
    nloc = mine > 0u ? mine : 1u; nx = cnt > 0u ? cnt : 1u;
}

__device__ __forceinline__ void xcd_barrier(const XcdBarrier& b) {
    asm volatile("s_waitcnt vmcnt(0)" ::: "memory");
    __syncthreads();
    if (threadIdx.x == 0) {
        unsigned* bar = b.bar;
        __builtin_amdgcn_s_waitcnt(0);
        unsigned nloc = b.st[0], nx = b.st[1];
        if (nloc == 0u) { xcd_barrier_complete(bar, b.x, nloc, nx); b.st[0] = nloc; b.st[1] = nx; }
        const unsigned old = xb_add(&bar[XB_XSUB(b.x)], 1u);
        const unsigned gen = old / nloc;
        if (old + 1u == (gen + 1u) * nloc) {
            __builtin_amdgcn_fence(__ATOMIC_RELEASE, "agent");
            asm volatile("s_waitcnt vmcnt(0)" ::: "memory");
            const unsigned og = xb_add(&bar[XB_TOP], 1u);
            const unsigned tg = og / nx;
            if (og + 1u == (tg + 1u) * nx) xb_add(&bar[XB_TOPGEN], 1u);
            else XB_SPIN(xb_ld(&bar[XB_TOPGEN]) == tg, bar);
            __builtin_amdgcn_fence(__ATOMIC_ACQUIRE, "agent");
            xb_add(&bar[XB_XGEN(b.x)], 1u);
            asm volatile("s_waitcnt vmcnt(0)" ::: "memory");
        } else {
            XB_SPIN(xb_ld(&bar[XB_XGEN(b.x)]) == gen, bar);
            __builtin_amdgcn_fence(__ATOMIC_ACQUIRE, "agent");
            asm volatile("s_waitcnt vmcnt(0)" ::: "memory");
        }
    }
    __syncthreads();
}


constexpr int DM = 4096, SEQ = 2048, TP = 8192, RP = 8448;
constexpr size_t MiB = (size_t)1 << 20;
constexpr size_t O_BT1 = 0, O_BT2 = O_BT1 + 128 * MiB, O_BT3 = O_BT2 + 64 * MiB, O_BT4 = O_BT3 + 88 * MiB, O_BT5 = O_BT4 + 64 * MiB, O_WG = O_BT5 + 32 * MiB,
                 O_XBF = O_WG + 8 * MiB, O_POOL = O_XBF + 66 * MiB, O_Y = O_POOL + 198 * MiB, O_SG2 = O_Y + 66 * MiB, O_OG = O_SG2 + 33 * MiB, O_KVB = O_OG + 33 * MiB,
                 O_RS = O_KVB + 48 * MiB, O_SSQP = O_RS + 1 * MiB, O_LSE = O_SSQP + 2 * MiB, O_GRAN = O_LSE + 2 * MiB, O_PART = O_GRAN + 8 * MiB, O_BAR = O_PART + 3 * MiB, O_END = O_BAR + 1 * MiB;
constexpr size_t P_XB = O_POOL, P_SG = O_POOL + 66 * MiB, P_HG = O_POOL + 132 * MiB, P_Q = O_POOL, P_ON = O_POOL + 99 * MiB;
constexpr size_t OUT_YP = 0, OUT_YS = 33554432, OUT_PCONV = OUT_YS + 32768, OUT_PH = OUT_PCONV + 98304, OUT_PKV0 = OUT_PH + 32768, OUT_PKV1 = OUT_PKV0 + 524288, OUT_PKV2 = OUT_PKV1 + 2097152,
                 OUT_SCONV = OUT_PKV2 + 8388608, OUT_SH = OUT_SCONV + 196608, OUT_SKV0 = OUT_SH + 65536, OUT_SKV1 = OUT_SKV0 + 1048576, OUT_SKV2 = OUT_SKV1 + 4194304;
constexpr int LDS_BYTES = 159744, OFF_XB = 157824;
constexpr float EPSN = 1e-6f;

struct Params { const float* in[25]; float* out; unsigned char* ws; };
typedef const Params __attribute__((address_space(4))) * KParams;
__device__ __forceinline__ KParams kparams() { KParams p = (KParams)__builtin_amdgcn_kernarg_segment_ptr(); asm volatile("" : "+s"(p)); return p; }
#define PLOCAL const KParams Pk = kparams(); (void)P;


__device__ __forceinline__ unsigned pk2(float a, float b) { typedef __bf16 bf2 __attribute__((ext_vector_type(2))); bf2 v; v[0] = (__bf16)a; v[1] = (__bf16)b; return __builtin_bit_cast(unsigned, v); }
__device__ __forceinline__ float bflo(unsigned u) { return __uint_as_float(u << 16); }
__device__ __forceinline__ float bfhi(unsigned u) { return __uint_as_float(u & 0xffff0000u); }
__device__ __forceinline__ float bf2f(bf16_t h) { return __uint_as_float(((unsigned)h) << 16); }
__device__ __forceinline__ float silu_f(float v) { return v * __builtin_amdgcn_rcpf(1.0f + __expf(-v)); }
__device__ __forceinline__ float sigm_f(float v) { return __builtin_amdgcn_rcpf(1.0f + __expf(-v)); }
__device__ __forceinline__ float wave_sum(float v) {
#pragma unroll
    for (int o = 1; o < 64; o <<= 1) v += __shfl_xor(v, o);
    return v;
}
__device__ __forceinline__ float wave_max(float v) {
#pragma unroll
    for (int o = 1; o < 64; o <<= 1) v = fmaxf(v, __shfl_xor(v, o));
    return v;
}
__device__ __forceinline__ int crow(int reg, int h) { return (reg & 3) + 8 * (reg >> 2) + 4 * h; }
__device__ __forceinline__ int rel_bucket(int dd) {
    if (dd < 16) return dd;
    const float d = (float)dd;
    int large = 16 + (int)(logf(d * (1.0f / 16.0f)) / logf(128.0f) * 16.0f);
    return large < 31 ? large : 31;
}
#define MFMA32(a, b, c) __builtin_amdgcn_mfma_f32_32x32x16_bf16((a), (b), (c), 0, 0, 0)

struct Epi {
    static constexpr bool PERM = true, AFTER_DRAIN = false;
    int mode;
    const float* rs; bf16_t* o0; bf16_t* o1; bf16_t* o2; float* ssqp; float* outp;
    __device__ __forceinline__ void operator()(const f32x4 (&acc)[2][2][4][2], const pg8::Unit& u, int wr, int wc, int fr, int fq) const {
        const int row0 = u.pm * 256 + wr * 64 + fr, colt = u.pn * 256, cw = wc * 32 + 8 * fq;
        if (mode == 1) {
#pragma unroll
            for (int ai = 0; ai < 2; ++ai)
#pragma unroll
                for (int m = 0; m < 4; ++m) {
                    const int row = row0 + ai * 128 + m * 16; float ss = 0.f;
#pragma unroll
                    for (int bj = 0; bj < 2; ++bj) {
                        const f32x4 v0 = acc[ai][bj][m][0], v1 = acc[ai][bj][m][1];
                        ss += (v0[0] * v0[0] + v0[1] * v0[1]) + (v0[2] * v0[2] + v0[3] * v0[3]) + (v1[0] * v1[0] + v1[1] * v1[1]) + (v1[2] * v1[2] + v1[3] * v1[3]);
                        u32x4 w; w.x = pk2(v0[0], v0[1]); w.y = pk2(v0[2], v0[3]); w.z = pk2(v1[0], v1[1]); w.w = pk2(v1[2], v1[3]);
                        *(u32x4*)(o0 + (size_t)row * 4096 + colt + bj * 128 + cw) = w;
                    }
                    ss += __shfl_xor(ss, 16); ss += __shfl_xor(ss, 32);
                    if (fq == 0) ssqp[(size_t)row * 64 + u.pn * 4 + wc] = ss;
                }
            return;
        }
        bf16_t* dst; int ld, col; bool act = false, kv = false;
        if (mode == 0) { ld = 4096; if (colt < 4096) { dst = o0; col = colt; } else { dst = o1; col = colt - 4096; act = true; } }
        else { if (colt < 6144) { dst = o0; ld = 6144; col = colt; } else if (colt < 8192) { dst = o1; ld = 2048; col = colt - 6144; act = true; } else { dst = o2; ld = 3072; col = colt - 8192; kv = true; } }
#pragma unroll
        for (int ai = 0; ai < 2; ++ai)
#pragma unroll
            for (int m = 0; m < 4; ++m) {
                const int row = row0 + ai * 128 + m * 16; const float r = rs[row];
#pragma unroll
                for (int bj = 0; bj < 2; ++bj) {
                    f32x4 v0 = acc[ai][bj][m][0] * r, v1 = acc[ai][bj][m][1] * r;
                    if (act) {
#pragma unroll
                        for (int j = 0; j < 4; ++j) { v0[j] = silu_f(v0[j]); v1[j] = silu_f(v1[j]); }
                    }
                    u32x4 w; w.x = pk2(v0[0], v0[1]); w.y = pk2(v0[2], v0[3]); w.z = pk2(v1[0], v1[1]); w.w = pk2(v1[2], v1[3]);
                    const int cc = col + bj * 128 + cw;
                    *(u32x4*)(dst + (size_t)row * ld + cc) = w;
                    if (kv) {
                        const int g = cc >> 10, rem = cc & 1023, keep = 128 << (2 * g), n = row >> 11, t = row & 2047;
                        if (t >= 2048 - keep) {
                            const size_t ob = (g == 0 ? OUT_PKV0 : (g == 1 ? OUT_PKV1 : OUT_PKV2)) + ((size_t)(n * keep + (t - (2048 - keep))) * 1024 + rem);
                            *(f32x4*)(outp + ob) = v0; *(f32x4*)(outp + ob + 4) = v1;
                        }
                    }
                }
            }
    }
};

constexpr int TPITCH = 144, TTILE = 128 * TPITCH;
__device__ __forceinline__ void transpose_item(const float* W, int K, int N, bf16_t* WT, const float* gain, int item, int lane, LAS unsigned char* tile) {
    const int nblk = N / 128, kb = item / nblk, nb = item % nblk, k0 = 64 * kb, n0 = 128 * nb;
    f32x2 v[64];
    const float* src = W + (size_t)k0 * N + n0 + lane * 2;
#pragma unroll
    for (int kk = 0; kk < 64; ++kk) v[kk] = __builtin_nontemporal_load((const f32x2*)(src + (size_t)kk * N));
    if (gain) {
#pragma unroll
        for (int kk = 0; kk < 64; ++kk) v[kk] = v[kk] * gain[k0 + kk];
    }
#pragma unroll
    for (int i = 0; i < 2; ++i) {
        LAS unsigned char* row = tile + (lane * 2 + i) * TPITCH;
#pragma unroll
        for (int c = 0; c < 8; ++c) {
            u32x4 o; o.x = pk2(v[8 * c][i], v[8 * c + 1][i]); o.y = pk2(v[8 * c + 2][i], v[8 * c + 3][i]); o.z = pk2(v[8 * c + 4][i], v[8 * c + 5][i]); o.w = pk2(v[8 * c + 6][i], v[8 * c + 7][i]);
            *(LAS u32x4*)(row + c * 16) = o;
        }
    }
    LDS_WAIT();
    const int chunk = lane & 7, r8 = lane >> 3;
#pragma unroll
    for (int j = 0; j < 16; ++j) {
        const int rowi = r8 + 8 * j;
        const u32x4 o = *(const LAS u32x4*)(tile + rowi * TPITCH + chunk * 16);
        *(u32x4*)(WT + (size_t)(n0 + rowi) * K + k0 + chunk * 8) = o;
    }
    LDS_WAIT();
}

constexpr int I_AIN = 64 * 64, I_AOUT = 64 * 32, I_KV = 64 * 24, I_BOUT = 32 * 32, I_G = 4 * 2;
constexpr int N_PREP_ITEMS = 2 * I_AIN + 2 * I_AOUT + I_AIN + I_KV + I_AIN + 64 * I_G, N_ALL_ITEMS = N_PREP_ITEMS + 2 * I_BOUT;
__device__ __forceinline__ void convert_work(const Params& P, LAS unsigned char* lds, int lo, int hi, bool kvcopy, int vb, int nvb) {
    const KParams Pk = kparams();
    int tid = threadIdx.x; asm volatile("" : "+v"(tid));
    const int lane = tid & 63, w = __builtin_amdgcn_readfirstlane(tid >> 6);
    const int gw = vb * 8 + w, NGW = nvb * 8;
    unsigned char* ws = Pk->ws;
    LAS unsigned char* tile = lds + w * TTILE;
    if (kvcopy) {
        for (int g = 0; g < 3; ++g) {
            const int lb = 128 << (2 * g); const size_t per = (size_t)(lb - 1) * 256, tot = 8 * per;
            const f32x4* src = (const f32x4*)Pk->in[4 + g]; f32x4* dst = (f32x4*)(Pk->out + (g == 0 ? OUT_SKV0 : (g == 1 ? OUT_SKV1 : OUT_SKV2)));
            for (size_t i = (size_t)vb * 512 + tid; i < tot; i += (size_t)nvb * 512) { const size_t b = i / per, o = i - b * per; dst[b * (size_t)lb * 256 + o] = __builtin_nontemporal_load(src + b * (size_t)lb * 256 + 256 + o); }
        }
    }
    for (int it = lo + gw; it < hi; it += NGW) {
        int r = it;
        if (r < 2 * I_AIN) { const int l = r / I_AIN; transpose_item(Pk->in[8] + (size_t)l * 4096 * 8192, 4096, 8192, (bf16_t*)(ws + O_BT1) + (size_t)l * 8192 * 4096, Pk->in[7] + l * 4096, r % I_AIN, lane, tile); continue; } r -= 2 * I_AIN;
        if (r < 2 * I_AOUT) { const int l = r / I_AOUT; transpose_item(Pk->in[16] + (size_t)l * 4096 * 4096, 4096, 4096, (bf16_t*)(ws + O_BT2) + (size_t)l * 4096 * 4096, nullptr, r % I_AOUT, lane, tile); continue; } r -= 2 * I_AOUT;
        if (r < I_AIN) { transpose_item(Pk->in[22], 4096, 8192, (bf16_t*)(ws + O_BT3), Pk->in[21], r, lane, tile); continue; } r -= I_AIN;
        if (r < I_KV) { transpose_item(Pk->in[19], 4096, 3072, (bf16_t*)(ws + O_BT3) + (size_t)8192 * 4096, Pk->in[18], r, lane, tile); continue; } r -= I_KV;
        if (r < I_AIN) { transpose_item(Pk->in[22] + (size_t)4096 * 8192, 4096, 8192, (bf16_t*)(ws + O_BT4), Pk->in[21] + 4096, r, lane, tile); continue; } r -= I_AIN;
        if (r < 64 * I_G) { const int mat = r / I_G, gate = mat & 1, lh = mat >> 1;
            transpose_item((gate ? Pk->in[13] : Pk->in[11]) + (size_t)lh * 65536, 256, 256, (bf16_t*)(ws + O_WG) + (size_t)(lh * 2 + gate) * 65536, nullptr, r % I_G, lane, tile); continue; } r -= 64 * I_G;
        { const int l = r / I_BOUT; transpose_item(Pk->in[23] + (size_t)l * 2048 * 4096, 2048, 4096, (bf16_t*)(ws + O_BT5) + (size_t)l * 4096 * 2048, nullptr, r % I_BOUT, lane, tile); }
    }
}

__device__ __forceinline__ void prep_phase(const Params& P, LAS unsigned char* lds) {
    const KParams Pk = kparams();
    int tid = threadIdx.x; asm volatile("" : "+v"(tid));
    const int lane = tid & 63, w = __builtin_amdgcn_readfirstlane(tid >> 6);
    const int gw = blockIdx.x * 8 + w, NGW = gridDim.x * 8;
    unsigned char* ws = Pk->ws;
    { u64* gr = (u64*)(ws + O_GRAN); const size_t n = (8 * MiB) / 8; for (size_t i = (size_t)blockIdx.x * 512 + tid; i < n; i += (size_t)gridDim.x * 512) gr[i] = 0ull; }
    { bf16_t* XBF = (bf16_t*)(ws + O_XBF); float* RS = (float*)(ws + O_RS);
      for (int row = gw; row < TP + 8; row += NGW) {
          const float* xr = row < TP ? Pk->in[0] + (size_t)row * DM : Pk->in[1] + (size_t)(row - TP) * DM;
          const f32x4* x4 = (const f32x4*)xr + lane; f32x4 v[16]; float s = 0.f;
#pragma unroll
          for (int j = 0; j < 16; ++j) { v[j] = x4[64 * j]; s += (v[j].x * v[j].x + v[j].y * v[j].y) + (v[j].z * v[j].z + v[j].w * v[j].w); }
          s = wave_sum(s);
          u32x2* o = (u32x2*)(XBF + (size_t)row * DM) + lane;
#pragma unroll
          for (int j = 0; j < 16; ++j) { u32x2 q; q.x = pk2(v[j].x, v[j].y); q.y = pk2(v[j].z, v[j].w); o[64 * j] = q; }
          if (lane == 0) RS[row] = rsqrtf(s * (1.0f / DM) + EPSN);
      } }
}

template <int KSTEPS>
__device__ __forceinline__ void skinny_phase(const bf16_t* A, const bf16_t* Bt, int N, int K, float* sout, LAS unsigned char* lds) {
    int tid = threadIdx.x; asm volatile("" : "+v"(tid));
    const int lane = tid & 63, w = __builtin_amdgcn_readfirstlane(tid >> 6), fr = lane & 15, fq = lane >> 4;
    LAS float* red = (LAS float*)lds;
    const int ngroups = N / 16, k0 = w * (KSTEPS * 32);
    for (int grp = blockIdx.x; grp < ngroups; grp += gridDim.x) {
        const int n0 = grp * 16;
        const bf16_t* ap = A + (size_t)(fr & 7) * K + k0 + fq * 8; const bf16_t* bp = Bt + (size_t)(n0 + fr) * K + k0 + fq * 8;
        bf16x8 a[KSTEPS], b[KSTEPS];
#pragma unroll
        for (int s = 0; s < KSTEPS; ++s) { b[s] = __builtin_nontemporal_load((const bf16x8*)(bp + s * 32)); a[s] = *(const bf16x8*)(ap + s * 32); }
        f32x4 acc = {0.f, 0.f, 0.f, 0.f};
#pragma unroll
        for (int s = 0; s < KSTEPS; ++s) { if (fr >= 8) a[s] = (bf16x8){0, 0, 0, 0, 0, 0, 0, 0}; acc = __builtin_amdgcn_mfma_f32_16x16x32_bf16(a[s], b[s], acc, 0, 0, 0); }
        __syncthreads();
        if (fq < 2) {
#pragma unroll
            for (int i = 0; i < 4; ++i) red[(w * 8 + fq * 4 + i) * 16 + fr] = acc[i];
        }
        __syncthreads();
        if (tid < 128) { float s = 0.f;
#pragma unroll
            for (int ww = 0; ww < 8; ++ww) s += red[ww * 128 + tid];
            sout[(size_t)(tid >> 4) * N + n0 + (tid & 15)] = s; }
    }
}
__device__ __forceinline__ float part_sum(const float* sout, int N, int b, int col) { return sout[(size_t)b * N + col]; }

constexpr int SROW = 528;
__device__ __forceinline__ void scan_phase(const Params& P, LAS unsigned char* lds, int l) {
    const KParams Pk = kparams();
    const int tid0 = threadIdx.x;
    LAS unsigned char* RAW = lds;
    LAS unsigned char* AT = lds + 69632;
    unsigned char* ws = Pk->ws;
    const bf16_t* XB = (const bf16_t*)(ws + P_XB); const bf16_t* SG = (const bf16_t*)(ws + P_SG); bf16_t* HG = (bf16_t*)(ws + P_HG);
    const float* SOUT = (const float*)(ws + O_PART); const float* RS = (const float*)(ws + O_RS);
    const float* cwp = Pk->in[9] + (size_t)l * 4 * 4096; const float* cbp = Pk->in[10] + (size_t)l * 4096;
    bf16x8 bR[8], bI[8]; int cur = -1;
    for (int t = blockIdx.x; t < 32 + 2048; t += gridDim.x) {
        int tid = tid0; asm volatile("" : "+v"(tid));
        const int lane = tid & 63, w = __builtin_amdgcn_readfirstlane(tid >> 6), fr = lane & 15, fq = lane >> 4;
        const bool is_s = t < 32;
        int hh2, n = 0, sp = 0;
        if (is_s) hh2 = t; else { const int idx = t - 32; hh2 = idx & 31; n = (idx >> 5) & 3; sp = idx >> 7; }
        const int head = hh2 >> 1, half = hh2 & 1, gc0 = head * 256, hc = half * 128 + w * 16 + fr, gch = gc0 + hc, r0 = n * 2048 + sp * 128;
        if (hh2 != cur) {
            const bf16_t* wp = (const bf16_t*)(ws + O_WG) + (size_t)((l * 16 + head) * 2) * 65536 + (size_t)hc * 256 + fq * 8;
#pragma unroll
            for (int ks = 0; ks < 8; ++ks) { bR[ks] = *(const bf16x8*)(wp + ks * 32); bI[ks] = *(const bf16x8*)(wp + 65536 + ks * 32); }
            cur = hh2;
        }
        __syncthreads();
        if (is_s) {
            const int b = tid >> 6, ch = (tid & 63) * 4; const float rsb = RS[TP + b];
            float xc[4][4];
#pragma unroll
            for (int e = 0; e < 4; ++e) {
                const int gc = gc0 + ch + e;
#pragma unroll
                for (int k = 0; k < 3; ++k) xc[k][e] = Pk->in[2][((size_t)(l * 8 + b) * 3 + k) * 4096 + gc];
                xc[3][e] = rsb * SOUT[(size_t)b * 8192 + gc];
            }
            float o[4];
#pragma unroll
            for (int e = 0; e < 4; ++e) {
                const int gc = gc0 + ch + e; float v = cbp[gc];
#pragma unroll
                for (int k = 0; k < 4; ++k) v += xc[k][e] * cwp[k * 4096 + gc];
                o[e] = v;
                if (half == 0) {
#pragma unroll
                    for (int k = 0; k < 3; ++k) Pk->out[OUT_SCONV + ((size_t)(l * 8 + b) * 3 + k) * 4096 + gc] = xc[k + 1][e];
                }
            }
            u32x2 q; q.x = pk2(o[0], o[1]); q.y = pk2(o[2], o[3]);
            *(LAS u32x2*)(AT + b * SROW + ch * 2) = q;
        } else {
#pragma unroll
            for (int j = 0; j < 9; ++j) {
                const int id = tid + 512 * j, i = id >> 5, c8 = id & 31;
                if (i < 131) {
                    u32x4 v = {0u, 0u, 0u, 0u};
                    if (!(sp == 0 && i < 3)) v = *(const u32x4*)(XB + (size_t)(r0 - 3 + i) * 4096 + gc0 + c8 * 8);
                    *(LAS u32x4*)(RAW + i * SROW + c8 * 16) = v;
                }
            }
            __syncthreads();
            const int c8 = tid & 31; float wk[4][8], bb[8];
#pragma unroll
            for (int e = 0; e < 8; ++e) { bb[e] = cbp[gc0 + c8 * 8 + e];
#pragma unroll
                for (int k = 0; k < 4; ++k) wk[k][e] = cwp[k * 4096 + gc0 + c8 * 8 + e]; }
#pragma unroll
            for (int j = 0; j < 8; ++j) {
                const int i = (tid >> 5) + 16 * j;
                float o[8];
#pragma unroll
                for (int e = 0; e < 8; ++e) o[e] = bb[e];
                u32x4 last;
#pragma unroll
                for (int k = 0; k < 4; ++k) {
                    const u32x4 v = *(const LAS u32x4*)(RAW + (i + k) * SROW + c8 * 16); last = v;
                    o[0] += bflo(v.x) * wk[k][0]; o[1] += bfhi(v.x) * wk[k][1]; o[2] += bflo(v.y) * wk[k][2]; o[3] += bfhi(v.y) * wk[k][3];
                    o[4] += bflo(v.z) * wk[k][4]; o[5] += bfhi(v.z) * wk[k][5]; o[6] += bflo(v.w) * wk[k][6]; o[7] += bfhi(v.w) * wk[k][7];
                }
                u32x4 q; q.x = pk2(o[0], o[1]); q.y = pk2(o[2], o[3]); q.z = pk2(o[4], o[5]); q.w = pk2(o[6], o[7]);
                *(LAS u32x4*)(AT + i * SROW + c8 * 16) = q;
                if (sp == 15 && i >= 125 && half == 0) {
                    float* d = Pk->out + OUT_PCONV + ((size_t)(l * 4 + n) * 3 + (i - 125)) * 4096 + gc0 + c8 * 8;
                    f32x4 a = {bflo(last.x), bfhi(last.x), bflo(last.y), bfhi(last.y)}, b = {bflo(last.z), bfhi(last.z), bflo(last.w), bfhi(last.w)};
                    *(f32x4*)d = a; *(f32x4*)(d + 4) = b;
                }
            }
        }
        __syncthreads();
        f32x4 aR[8], aI[8];
#pragma unroll
        for (int mt = 0; mt < 8; ++mt) { aR[mt] = (f32x4){0.f, 0.f, 0.f, 0.f}; aI[mt] = (f32x4){0.f, 0.f, 0.f, 0.f}; }
#pragma unroll
        for (int ks = 0; ks < 8; ++ks) {
#pragma unroll
            for (int mt = 0; mt < 8; ++mt) {
                const bf16x8 a = *(const LAS bf16x8*)(AT + (mt * 16 + fr) * SROW + (ks * 32 + fq * 8) * 2);
                aR[mt] = __builtin_amdgcn_mfma_f32_16x16x32_bf16(a, bR[ks], aR[mt], 0, 0, 0);
                aI[mt] = __builtin_amdgcn_mfma_f32_16x16x32_bf16(a, bI[ks], aI[mt], 0, 0, 0);
            }
            __builtin_amdgcn_sched_barrier(0);
        }
        const float bga = Pk->in[12][(size_t)l * 4096 + gch], bgx = Pk->in[14][(size_t)l * 4096 + gch];
        const float lamc = -8.0f * log1pf(expf(-Pk->in[15][(size_t)l * 4096 + gch]));
#pragma unroll
        for (int mt = 0; mt < 8; ++mt)
#pragma unroll
            for (int i = 0; i < 4; ++i) {
                const int row = mt * 16 + 4 * fq + i;
                const float r = sigm_f(aR[mt][i] + bga), ig = sigm_f(aI[mt][i] + bgx);
                const float la = lamc * r, a = __expf(la);
                const float em = fmaf(-a, a, 1.0f);
                const float xf = bf2f(*(const LAS bf16_t*)(AT + row * SROW + hc * 2));
                aR[mt][i] = a; aI[mt][i] = __builtin_amdgcn_sqrtf(em) * ig * xf;
            }
        if (is_s) {
            if (fq < 2) {
#pragma unroll
                for (int i = 0; i < 4; ++i) {
                    const int b = 4 * fq + i;
                    const float h0 = Pk->in[3][(size_t)(l * 8 + b) * 4096 + gch];
                    const float h = aR[0][i] * h0 + aI[0][i];
                    Pk->out[OUT_SH + (size_t)(l * 8 + b) * 4096 + gch] = h;
                    const float sg = silu_f(RS[TP + b] * SOUT[(size_t)b * 8192 + 4096 + gch]);
                    HG[(size_t)(TP + b) * 4096 + gch] = (bf16_t)(pk2(h * sg, 0.f) & 0xffffu);
                }
            }
            continue;
        }
        float Pp = 1.f, Cc = 0.f;
#pragma unroll
        for (int mt = 0; mt < 8; ++mt) {
            float A = aR[mt][0], H = aI[mt][0];
#pragma unroll
            for (int i = 1; i < 4; ++i) { const float a = aR[mt][i], b = aI[mt][i]; H = a * H + b; A = A * a; aR[mt][i] = A; aI[mt][i] = H; }
            float Pm = 1.f, Cm = 0.f;
#pragma unroll
            for (int q = 0; q < 4; ++q) {
                const float qA = __shfl(A, fr + 16 * q), qH = __shfl(H, fr + 16 * q);
                if (q == fq) { Pm = Pp; Cm = Cc; }
                Cc = qA * Cc + qH; Pp = Pp * qA;
            }
#pragma unroll
            for (int i = 0; i < 4; ++i) { aI[mt][i] += aR[mt][i] * Cm; aR[mt][i] *= Pm; }
        }
        u64* gr = (u64*)(ws + O_GRAN) + (((size_t)l * 4 + n) * 16 + sp) * 4096 + gch;
        const unsigned tag = 1u + (unsigned)l;
        float H0 = 0.f;
        if (sp > 0) {
            const u64* pg = gr - 4096; u64 x = 0; unsigned spins = 0;
            for (;;) {
                x = __hip_atomic_load(pg, __ATOMIC_RELAXED, __HIP_MEMORY_SCOPE_AGENT);
                if (__all((unsigned)(x >> 32) == tag)) break;
                if (++spins > (1u << 22)) break;
                __builtin_amdgcn_s_sleep(1);
            }
            H0 = __uint_as_float((unsigned)x);
        }
        const float hend = Cc + Pp * H0;
        if (fq == 0) {
            __hip_atomic_store(gr, ((u64)tag << 32) | (u64)__float_as_uint(hend), __ATOMIC_RELAXED, __HIP_MEMORY_SCOPE_AGENT);
            if (sp == 15) Pk->out[OUT_PH + (size_t)(l * 4 + n) * 4096 + gch] = hend;
        }
        __syncthreads();
#pragma unroll
        for (int mt = 0; mt < 8; ++mt)
#pragma unroll
            for (int i = 0; i < 4; ++i) {
                const int row = mt * 16 + 4 * fq + i;
                const float h = aI[mt][i] + aR[mt][i] * H0;
                *(LAS bf16_t*)(AT + row * SROW + hc * 2) = (bf16_t)(pk2(h, 0.f) & 0xffffu);
            }
        __syncthreads();
        {
            const int c8 = tid & 15;
#pragma unroll
            for (int j = 0; j < 4; ++j) {
                const int i = (tid >> 4) + 32 * j;
                const u32x4 hv = *(const LAS u32x4*)(AT + i * SROW + (half * 128 + c8 * 8) * 2);
                const size_t go = (size_t)(r0 + i) * 4096 + gc0 + half * 128 + c8 * 8;
                const u32x4 sv = *(const u32x4*)(SG + go);
                u32x4 q; q.x = pk2(bflo(hv.x) * bflo(sv.x), bfhi(hv.x) * bfhi(sv.x)); q.y = pk2(bflo(hv.y) * bflo(sv.y), bfhi(hv.y) * bfhi(sv.y));
                q.z = pk2(bflo(hv.z) * bflo(sv.z), bfhi(hv.z) * bfhi(sv.z)); q.w = pk2(bflo(hv.w) * bflo(sv.w), bfhi(hv.w) * bfhi(sv.w));
                *(u32x4*)(HG + go) = q;
            }
        }
    }
}

__device__ __forceinline__ void post_phase(const Params& P, int L) {
    const KParams Pk = kparams();
    int tid = threadIdx.x; asm volatile("" : "+v"(tid));
    const int lane = tid & 63, w = __builtin_amdgcn_readfirstlane(tid >> 6);
    const int gw = blockIdx.x * 8 + w, NGW = gridDim.x * 8;
    unsigned char* ws = Pk->ws;
    const float* gain = L < 2 ? Pk->in[17] + (size_t)L * 4096 : Pk->in[24] + (size_t)(L - 2) * 4096;
    const bf16_t* Y = (const bf16_t*)(ws + O_Y); const float* SSQP = (const float*)(ws + O_SSQP); const float* SOUT = (const float*)(ws + O_PART);
    bf16_t* XBF = (bf16_t*)(ws + O_XBF); float* RS = (float*)(ws + O_RS);
    for (int row = gw; row < TP + 8; row += NGW) {
        const bool smp = row >= TP; const int b = row - TP;
        float ssq; f32x4 y0[8], y1[8], x0[8], x1[8];
        if (!smp) {
            ssq = SSQP[(size_t)row * 64 + lane];
#pragma unroll
            for (int j = 0; j < 8; ++j) { const u32x4 yv = *(const u32x4*)(Y + (size_t)row * 4096 + j * 512 + lane * 8);
                y0[j] = (f32x4){bflo(yv.x), bfhi(yv.x), bflo(yv.y), bfhi(yv.y)}; y1[j] = (f32x4){bflo(yv.z), bfhi(yv.z), bflo(yv.w), bfhi(yv.w)}; }
        } else {
            ssq = 0.f;
#pragma unroll
            for (int j = 0; j < 8; ++j) { const float* sp = SOUT + (size_t)b * 4096 + j * 512 + lane * 8; y0[j] = *(const f32x4*)sp; y1[j] = *(const f32x4*)(sp + 4);
                ssq += (y0[j].x * y0[j].x + y0[j].y * y0[j].y) + (y0[j].z * y0[j].z + y0[j].w * y0[j].w) + (y1[j].x * y1[j].x + y1[j].y * y1[j].y) + (y1[j].z * y1[j].z + y1[j].w * y1[j].w); }
        }
        if (L == 0) {
            const float* xin = (smp ? Pk->in[1] + (size_t)b * 4096 : Pk->in[0] + (size_t)row * 4096);
#pragma unroll
            for (int j = 0; j < 8; ++j) { x0[j] = *(const f32x4*)(xin + j * 512 + lane * 8); x1[j] = *(const f32x4*)(xin + j * 512 + lane * 8 + 4); }
        } else {
#pragma unroll
            for (int j = 0; j < 8; ++j) { const u32x4 xv = *(const u32x4*)(XBF + (size_t)row * 4096 + j * 512 + lane * 8);
                x0[j] = (f32x4){bflo(xv.x), bfhi(xv.x), bflo(xv.y), bfhi(xv.y)}; x1[j] = (f32x4){bflo(xv.z), bfhi(xv.z), bflo(xv.w), bfhi(xv.w)}; }
        }
        const float rsn = rsqrtf(wave_sum(ssq) * (1.0f / 4096.0f) + EPSN);
        float acc = 0.f;
        float* xout = Pk->out + (smp ? OUT_YS + (size_t)b * 4096 : OUT_YP + (size_t)row * 4096);
#pragma unroll
        for (int j = 0; j < 8; ++j) {
            const int col = j * 512 + lane * 8;
            const f32x4 g0 = *(const f32x4*)(gain + col), g1 = *(const f32x4*)(gain + col + 4);
            const f32x4 n0 = x0[j] + y0[j] * rsn * g0, n1 = x1[j] + y1[j] * rsn * g1;
            acc += (n0.x * n0.x + n0.y * n0.y) + (n0.z * n0.z + n0.w * n0.w) + (n1.x * n1.x + n1.y * n1.y) + (n1.z * n1.z + n1.w * n1.w);
            if (L == 3) { *(f32x4*)(xout + col) = n0; *(f32x4*)(xout + col + 4) = n1; }
            else { u32x4 q; q.x = pk2(n0.x, n0.y); q.y = pk2(n0.z, n0.w); q.z = pk2(n1.x, n1.y); q.w = pk2(n1.z, n1.w); *(u32x4*)(XBF + (size_t)row * 4096 + col) = q; }
        }
        acc = wave_sum(acc);
        if (lane == 0) RS[row] = rsqrtf(acc * (1.0f / 4096.0f) + EPSN);
    }
}

constexpr int KROW = 272, VROW = 320, OFF_VS = 69632, OFF_BI = OFF_VS + 81920, OFF_SW = OFF_BI + 2112;
__device__ __forceinline__ void attn_item(const Params& P, LAS unsigned char* lds, int item) {
    const KParams Pk = kparams();
    int tid = threadIdx.x; asm volatile("" : "+v"(tid));
    const int lane = tid & 63, w = __builtin_amdgcn_readfirstlane(tid >> 6), hh = lane >> 5, l32 = lane & 31;
    unsigned char* ws = Pk->ws;
    const bf16_t* Q = (const bf16_t*)(ws + P_Q); const bf16_t* KVB = (const bf16_t*)(ws + O_KVB); bf16_t* ON = (bf16_t*)(ws + P_ON); float* LSE = (float*)(ws + O_LSE);
    const int g = item >> 8, rem = item & 255, n = rem >> 6, kvh = rem & 3, cb = (rem >> 2) & 15;
    const int r = 1 << (2 * g), nb = 16 >> (2 * g), c = cb / nb, nbi = cb % nb;
    LAS unsigned char* Ks = lds; LAS unsigned char* Vs = lds + OFF_VS; LAS float* BI = (LAS float*)(lds + OFF_BI);
    __syncthreads();
#pragma unroll
    for (int j = 0; j < 8; ++j) {
        const int id = tid + 512 * j, kk = id >> 4, chk = id & 15, pos = (nbi - 1) * 128 + kk;
        u32x4 kv = {0u, 0u, 0u, 0u}, vv = {0u, 0u, 0u, 0u};
        if (pos >= 0) { const bf16_t* src = KVB + (size_t)(n * 2048 + pos * r + c) * 3072 + g * 1024 + kvh * 128 + chk * 8; kv = *(const u32x4*)src; vv = *(const u32x4*)(src + 512); }
        *(LAS u32x4*)(Ks + kk * KROW + chk * 16) = kv; *(LAS u32x4*)(Vs + kk * VROW + chk * 16) = vv;
    }
    for (int e = tid; e < 516; e += 512) { const int hl = e / 129, dist = e % 129; BI[hl * 132 + dist] = 1.4426950408889634f * Pk->in[20][rel_bucket(dist * r) * 48 + g * 16 + kvh * 4 + hl]; }
    __syncthreads();
    const float scale2 = 0.08838834764831845f * 1.4426950408889634f;
    const int qc = w & 3, qq = qc * 32 + l32, qrow = n * 2048 + (nbi * 128 + qq) * r + c;
    bf16x8 Qf[8];
    { const bf16_t* qp = Q + (size_t)qrow * 6144 + g * 2048 + (kvh * 4 + (w >> 2)) * 128 + hh * 8;
#pragma unroll
      for (int s = 0; s < 8; ++s) Qf[s] = *(const bf16x8*)(qp + s * 16); }
    for (int pp = 0; pp < 2; ++pp) {
        const int hl = (w >> 2) + 2 * pp, slot = kvh * 4 + hl;
        f32x16 S[5];
#pragma unroll
        for (int kt = 0; kt < 5; ++kt) {
#pragma unroll
            for (int e = 0; e < 16; ++e) S[kt][e] = 0.f;
            if (nbi > 0 || qc + kt >= 4) {
#pragma unroll
                for (int s = 0; s < 8; ++s) {
                    const bf16x8 a = *(const LAS bf16x8*)(Ks + (qc * 32 + kt * 32 + l32) * KROW + (s * 16 + hh * 8) * 2);
                    S[kt] = MFMA32(a, Qf[s], S[kt]);
                }
            }
            __builtin_amdgcn_sched_barrier(0);
        }
        if (pp == 0) {
            const bf16_t* qp = Q + (size_t)qrow * 6144 + g * 2048 + (slot + 2) * 128 + hh * 8;
#pragma unroll
            for (int s = 0; s < 8; ++s) Qf[s] = *(const bf16x8*)(qp + s * 16);
        }
        float m = -INFINITY;
#pragma unroll
        for (int kt = 0; kt < 5; ++kt) {
            const bool on = nbi > 0 || qc + kt >= 4;
            const LAS float* bp = BI + hl * 132 + (128 - 32 * kt - 27 - 4 * hh) + l32;
#pragma unroll
            for (int reg = 0; reg < 16; ++reg) {
                const int kc = (reg & 3) + 8 * (reg >> 2);
                float sv = S[kt][reg] * scale2 + bp[27 - kc];
                if (kt == 0) sv = (kc + 4 * hh >= l32) ? sv : -INFINITY;
                if (kt == 4) sv = (kc + 4 * hh <= l32) ? sv : -INFINITY;
                if (!on) sv = -INFINITY;
                S[kt][reg] = sv; m = fmaxf(m, sv);
            }
            __builtin_amdgcn_sched_barrier(0);
        }
        m = fmaxf(m, __shfl_xor(m, 32));
        float den = 0.f;
#pragma unroll
        for (int kt = 0; kt < 5; ++kt)
#pragma unroll
            for (int reg = 0; reg < 16; ++reg) { const float p = __builtin_amdgcn_exp2f(S[kt][reg] - m); S[kt][reg] = p; den += p; }
        den += __shfl_xor(den, 32);
        f32x16 O[4];
#pragma unroll
        for (int dt = 0; dt < 4; ++dt)
#pragma unroll
            for (int e = 0; e < 16; ++e) O[dt][e] = 0.f;
        const int q_ = (lane & 15) >> 2, p_ = lane & 3, cg16 = (lane >> 4) & 1;
#pragma unroll
        for (int kt = 0; kt < 5; ++kt) {
            if (nbi > 0 || qc + kt >= 4) {
#pragma unroll
                for (int s2 = 0; s2 < 2; ++s2) {
                    u32x4 pw; pw.x = pk2(S[kt][8 * s2 + 0], S[kt][8 * s2 + 1]); pw.y = pk2(S[kt][8 * s2 + 2], S[kt][8 * s2 + 3]); pw.z = pk2(S[kt][8 * s2 + 4], S[kt][8 * s2 + 5]); pw.w = pk2(S[kt][8 * s2 + 6], S[kt][8 * s2 + 7]);
                    const bf16x8 pf = __builtin_bit_cast(bf16x8, pw);
                    const int R0 = qc * 32 + kt * 32 + 16 * s2 + 4 * hh;
#pragma unroll
                    for (int dt = 0; dt < 4; ++dt) {
                        LAS unsigned char* ad = Vs + (R0 + q_) * VROW + (dt * 32 + 16 * cg16 + 4 * p_) * 2;
                        const s16x4 lo = __builtin_amdgcn_ds_read_tr16_b64_v4i16((LAS s16x4*)ad), hi = __builtin_amdgcn_ds_read_tr16_b64_v4i16((LAS s16x4*)(ad + 8 * VROW));
                        bf16x8 a; a[0] = lo[0]; a[1] = lo[1]; a[2] = lo[2]; a[3] = lo[3]; a[4] = hi[0]; a[5] = hi[1]; a[6] = hi[2]; a[7] = hi[3];
                        O[dt] = MFMA32(a, pf, O[dt]);
                    }
                    __builtin_amdgcn_sched_barrier(0);
                }
            }
        }
        const float inv = __builtin_amdgcn_rcpf(den);
        bf16_t* op = ON + ((size_t)g * RP + qrow) * 2048 + slot * 128 + 4 * hh;
#pragma unroll
        for (int dt = 0; dt < 4; ++dt)
#pragma unroll
            for (int g4 = 0; g4 < 4; ++g4) {
                u32x2 q; q.x = pk2(O[dt][4 * g4] * inv, O[dt][4 * g4 + 1] * inv); q.y = pk2(O[dt][4 * g4 + 2] * inv, O[dt][4 * g4 + 3] * inv);
                *(u32x2*)(op + dt * 32 + 8 * g4) = q;
            }
        if (hh == 0) LSE[((size_t)g * RP + qrow) * 16 + slot] = (m + __builtin_amdgcn_logf(den)) * 0.6931471805599453f;
    }
}

__device__ __forceinline__ void sample_attn(const Params& P, LAS unsigned char* lds, int si, int lbi, int wv) {
    const KParams Pk = kparams();
    int tid = threadIdx.x; asm volatile("" : "+v"(tid));
    const int lane = tid & 63;
    unsigned char* ws = Pk->ws;
    const float* PART = (const float*)(ws + O_PART); const float* RS = (const float*)(ws + O_RS); bf16_t* ON = (bf16_t*)(ws + P_ON); float* LSE = (float*)(ws + O_LSE);
    const int b = si / 48, rem = si % 48, g = rem >> 4, slot = rem & 15, kvh = slot >> 2, r = 1 << (2 * g), lbuf = 128 << (2 * g);
    const int N = lbi == 0 ? 11264 : 8192;
    const float* state = Pk->in[4 + g]; float* skv = Pk->out + (g == 0 ? OUT_SKV0 : (g == 1 ? OUT_SKV1 : OUT_SKV2));
    LAS float* qs = (LAS float*)(lds + OFF_SW + wv * 2064); LAS float* pw = qs + 128; LAS float* kn = qs + 260; LAS float* vn = qs + 388;
    const float rsb = RS[TP + b];
#pragma unroll
    for (int e = 0; e < 2; ++e) {
        const int d = lane * 2 + e;
        qs[d] = rsb * part_sum(PART, N, b, g * 2048 + slot * 128 + d);
        float kvl, vvl;
        if (lbi == 0) { kvl = rsb * part_sum(PART, N, b, 8192 + g * 1024 + kvh * 128 + d); vvl = rsb * part_sum(PART, N, b, 8192 + g * 1024 + 512 + kvh * 128 + d);
            if ((slot & 3) == 0) { float* dst = skv + ((size_t)(b * lbuf + lbuf - 1) * 2) * 512 + kvh * 128 + d; dst[0] = kvl; dst[512] = vvl; } }
        else { const float* srcp = skv + ((size_t)(b * lbuf + lbuf - 1) * 2) * 512 + kvh * 128 + d; kvl = srcp[0]; vvl = srcp[512]; }
        kn[d] = kvl; vn[d] = vvl;
    }
    LDS_WAIT();
    const float scale = 0.08838834764831845f;
    float m = -INFINITY;
#pragma unroll 1
    for (int rd = 0; rd < 3; ++rd) {
        const int step = lane + 64 * rd; float s = -INFINITY;
        if (step <= 128) {
            float dot = 0.f;
            if (step == 0) {
#pragma unroll 8
                for (int d = 0; d < 128; ++d) dot += qs[d] * kn[d]; }
            else { const f32x4* kr = (const f32x4*)(state + ((size_t)(b * lbuf + lbuf - step * r) * 2) * 512 + kvh * 128);
                f32x4 kv[32];
#pragma unroll
                for (int d4 = 0; d4 < 32; ++d4) kv[d4] = kr[d4];
#pragma unroll
                for (int d4 = 0; d4 < 32; ++d4) { const f32x4 qv = *(const LAS f32x4*)(qs + d4 * 4); dot += (kv[d4].x * qv.x + kv[d4].y * qv.y) + (kv[d4].z * qv.z + kv[d4].w * qv.w); } }
            s = dot * scale + Pk->in[20][rel_bucket(step * r) * 48 + g * 16 + slot];
            pw[step] = s;
        }
        m = fmaxf(m, s);
    }
    m = wave_max(m);
    LDS_WAIT();
    float den = 0.f;
#pragma unroll
    for (int rd = 0; rd < 3; ++rd) { const int step = lane + 64 * rd; if (step <= 128) { const float p = __expf(pw[step] - m); den += p; pw[step] = p; } }
    den = wave_sum(den);
    LDS_WAIT();
    float o0 = pw[0] * vn[lane * 2], o1 = pw[0] * vn[lane * 2 + 1];
#pragma unroll 1
    for (int s0 = 1; s0 <= 128; s0 += 32) {
        f32x2 v[32];
#pragma unroll
        for (int j = 0; j < 32; ++j) v[j] = *(const f32x2*)(state + ((size_t)(b * lbuf + lbuf - (s0 + j) * r) * 2 + 1) * 512 + kvh * 128 + lane * 2);
#pragma unroll
        for (int j = 0; j < 32; ++j) { const float p = pw[s0 + j]; o0 += p * v[j].x; o1 += p * v[j].y; }
    }
    const float inv = 1.0f / den;
    *(unsigned*)(ON + ((size_t)g * RP + TP + b) * 2048 + slot * 128 + lane * 2) = pk2(o0 * inv, o1 * inv);
    if (lane == 0) LSE[((size_t)g * RP + TP + b) * 16 + slot] = m + __logf(den);
    LDS_WAIT();
}

__device__ __forceinline__ void combine_phase(const Params& P, int lbi) {
    const KParams Pk = kparams();
    int tid = threadIdx.x; asm volatile("" : "+v"(tid));
    const int lane = tid & 63, w = __builtin_amdgcn_readfirstlane(tid >> 6);
    const int gw = blockIdx.x * 8 + w, NGW = gridDim.x * 8;
    unsigned char* ws = Pk->ws;
    const bf16_t* ON = (const bf16_t*)(ws + P_ON); const float* LSE = (const float*)(ws + O_LSE); const bf16_t* SG2 = (const bf16_t*)(ws + O_SG2); bf16_t* OG = (bf16_t*)(ws + O_OG);
    const float* PART = (const float*)(ws + O_PART); const float* RS = (const float*)(ws + O_RS);
    const int N = lbi == 0 ? 11264 : 8192;
    for (int row = gw; row < TP + 8; row += NGW) {
#pragma unroll
        for (int cch = 0; cch < 4; ++cch) {
            const int col = cch * 512 + lane * 8, slot = col >> 7;
            const float l0 = LSE[((size_t)0 * RP + row) * 16 + slot], l1 = LSE[((size_t)1 * RP + row) * 16 + slot], l2 = LSE[((size_t)2 * RP + row) * 16 + slot];
            const float mx = fmaxf(l0, fmaxf(l1, l2)); float w0 = __expf(l0 - mx), w1 = __expf(l1 - mx), w2 = __expf(l2 - mx);
            const float iw = 1.0f / (w0 + w1 + w2); w0 *= iw; w1 *= iw; w2 *= iw;
            const u32x4 a0 = *(const u32x4*)(ON + ((size_t)0 * RP + row) * 2048 + col), a1 = *(const u32x4*)(ON + ((size_t)1 * RP + row) * 2048 + col), a2 = *(const u32x4*)(ON + ((size_t)2 * RP + row) * 2048 + col);
            float gt[8];
            if (row < TP) { const u32x4 sv = *(const u32x4*)(SG2 + (size_t)row * 2048 + col);
                gt[0] = bflo(sv.x); gt[1] = bfhi(sv.x); gt[2] = bflo(sv.y); gt[3] = bfhi(sv.y); gt[4] = bflo(sv.z); gt[5] = bfhi(sv.z); gt[6] = bflo(sv.w); gt[7] = bfhi(sv.w); }
            else { const int b = row - TP; const float rsb = RS[row];
#pragma unroll
                for (int e = 0; e < 8; ++e) gt[e] = silu_f(rsb * part_sum(PART, N, b, 6144 + col + e)); }
            float o[8];
            o[0] = w0 * bflo(a0.x) + w1 * bflo(a1.x) + w2 * bflo(a2.x); o[1] = w0 * bfhi(a0.x) + w1 * bfhi(a1.x) + w2 * bfhi(a2.x);
            o[2] = w0 * bflo(a0.y) + w1 * bflo(a1.y) + w2 * bflo(a2.y); o[3] = w0 * bfhi(a0.y) + w1 * bfhi(a1.y) + w2 * bfhi(a2.y);
            o[4] = w0 * bflo(a0.z) + w1 * bflo(a1.z) + w2 * bflo(a2.z); o[5] = w0 * bfhi(a0.z) + w1 * bfhi(a1.z) + w2 * bfhi(a2.z);
            o[6] = w0 * bflo(a0.w) + w1 * bflo(a1.w) + w2 * bflo(a2.w); o[7] = w0 * bfhi(a0.w) + w1 * bfhi(a1.w) + w2 * bfhi(a2.w);
            u32x4 q; q.x = pk2(o[0] * gt[0], o[1] * gt[1]); q.y = pk2(o[2] * gt[2], o[3] * gt[3]); q.z = pk2(o[4] * gt[4], o[5] * gt[5]); q.w = pk2(o[6] * gt[6], o[7] * gt[7]);
            *(u32x4*)(OG + (size_t)row * 2048 + col) = q;
        }
    }
}

__global__ __launch_bounds__(512, 2) void yoco_mega(Params P) {
    extern __shared__ __attribute__((aligned(16))) unsigned char shm[];
    LAS unsigned char* lds = (LAS unsigned char*)shm;
    cg::grid_group grid = cg::this_grid();
    const KParams Pk = kparams();
    unsigned char* ws = Pk->ws;
    const int w = threadIdx.x >> 6;
    if (threadIdx.x == 0) { *(LAS u32x4*)(lds + OFF_XB) = (u32x4){0u, 0u, 0u, 0u}; }
    __syncthreads();
    const XcdBarrier xb = xcd_barrier_post((unsigned*)(ws + O_BAR), (volatile LAS unsigned*)(lds + OFF_XB));
    prep_phase(P, lds);
    convert_work(P, lds, 0, N_PREP_ITEMS, false, (int)blockIdx.x, (int)gridDim.x);
    grid.sync();
    for (int L = 0; L < 4; ++L) {
        for (int half = 0; half < 2; ++half) {
            pg8::Gemm gm; Epi E; gm.M = TP;
            E.rs = (const float*)(ws + O_RS); E.ssqp = (float*)(ws + O_SSQP); E.outp = Pk->out; E.o2 = (bf16_t*)(ws + O_KVB);
            if (half == 0) {
                gm.A = (const bf16_t*)(ws + O_XBF); gm.K = 4096;
                if (L < 2) { gm.Bt = (const bf16_t*)(ws + O_BT1) + (size_t)L * 8192 * 4096; gm.N = 8192; E.mode = 0; E.o0 = (bf16_t*)(ws + P_XB); E.o1 = (bf16_t*)(ws + P_SG); }
                else { gm.Bt = (const bf16_t*)(ws + (L == 2 ? O_BT3 : O_BT4)); gm.N = L == 2 ? 11264 : 8192; E.mode = 2; E.o0 = (bf16_t*)(ws + P_Q); E.o1 = (bf16_t*)(ws + O_SG2); }
            } else {
                E.mode = 1; E.o0 = (bf16_t*)(ws + O_Y); E.o1 = E.o0; gm.N = 4096;
                if (L < 2) { gm.A = (const bf16_t*)(ws + P_HG); gm.Bt = (const bf16_t*)(ws + O_BT2) + (size_t)L * 4096 * 4096; gm.K = 4096; }
                else { gm.A = (const bf16_t*)(ws + O_OG); gm.Bt = (const bf16_t*)(ws + O_BT5) + (size_t)(L - 2) * 4096 * 2048; gm.K = 2048; }
            }
            pg8::StaticOrder S; S.init(gm.M, gm.N, (int)gridDim.x, (int)blockIdx.x);
            pg8::gemm_phase<Epi, pg8::StaticOrder, false>(lds, gm, S, E, nullptr);
            if (L == 2 && half == 0) {
                const int nwg = (gm.M / 256) * (gm.N / 256), G = (int)gridDim.x, fi = nwg - ((nwg - 1) / G) * G;
                int vb = (int)blockIdx.x, nvb = G;
                if (fi < G) { vb = (int)blockIdx.x - fi; nvb = vb >= 0 ? G - fi : 0; }
                __syncthreads();
                if (nvb > 0) convert_work(P, lds, N_PREP_ITEMS, N_ALL_ITEMS, true, vb, nvb);
            }
            __syncthreads();
            if (gm.K == 4096) skinny_phase<16>(gm.A + (size_t)TP * gm.K, gm.Bt, gm.N, gm.K, (float*)(ws + O_PART), lds);
            else skinny_phase<8>(gm.A + (size_t)TP * gm.K, gm.Bt, gm.N, gm.K, (float*)(ws + O_PART), lds);
            xcd_barrier(xb);
            if (half == 0) {
                if (L < 2) {
                    scan_phase(P, lds, L);
                } else {
                    for (int wv = 0; wv < 2; ++wv) { const int si = wv * 256 + (int)blockIdx.x; if (si < 384 && w == wv && gridDim.x >= 256) sample_attn(P, lds, si, L - 2, wv); }
                    if (gridDim.x < 256 && w < 2) for (int si = blockIdx.x * 2 + w; si < 384; si += gridDim.x * 2) sample_attn(P, lds, si, L - 2, w);
                    for (int it = blockIdx.x; it < 768; it += gridDim.x) attn_item(P, lds, it);
                    xcd_barrier(xb);
                    combine_phase(P, L - 2);
                }
            } else {
                post_phase(P, L);
            }
            if (!(L == 3 && half == 1)) xcd_barrier(xb);
        }
    }
}

extern "C" void kernel_launch(void* const* d_in, const int* in_sizes, int n_in, void* d_out, int out_size, void* d_ws, size_t ws_size, hipStream_t stream) {
    static int grid_blocks = 0;
    if (!grid_blocks) {
        int dev = 0, cus = 0, per_cu = 0;
        hipGetDevice(&dev);
        hipDeviceGetAttribute(&cus, hipDeviceAttributeMultiprocessorCount, dev);
        hipFuncSetAttribute((const void*)yoco_mega, hipFuncAttributeMaxDynamicSharedMemorySize, LDS_BYTES);
        if (hipOccupancyMaxActiveBlocksPerMultiprocessor(&per_cu, (const void*)yoco_mega, 512, LDS_BYTES) != hipSuccess || per_cu < 1) per_cu = 1;
        (void)hipGetLastError();
        grid_blocks = cus * per_cu;
        if (ws_size < O_END) fprintf(stderr, "kernel_launch: workspace too small: %zu < %zu\n", ws_size, (size_t)O_END);
    }
    (void)hipMemsetAsync((unsigned char*)d_ws + O_BAR, 0, XCD_BAR_WORDS * sizeof(unsigned), stream);
    Params p{};
    for (int i = 0; i < 25; ++i) p.in[i] = (const float*)d_in[i];
    p.out = (float*)d_out; p.ws = (unsigned char*)d_ws;
    void* args[] = {&p};
    hipError_t e = hipLaunchCooperativeKernel((const void*)yoco_mega, dim3(grid_blocks), dim3(512), args, LDS_BYTES, stream);
    if (e != hipSuccess) fprintf(stderr, "cooperative launch failed: %s (grid %d)\n", hipGetErrorString(e), grid_blocks);
}
```

```cpp
#include <hip/hip_runtime.h>
#include <hip/hip_cooperative_groups.h>
#include <cstdio>
namespace cg = cooperative_groups;

namespace pg8 {
#define PG8_LAS __attribute__((address_space(3)))
typedef unsigned short bf16_t;
typedef short bf16x8 __attribute__((ext_vector_type(8)));
typedef float f32x4 __attribute__((ext_vector_type(4)));
typedef unsigned u32x4 __attribute__((ext_vector_type(4)));
constexpr int BM = 256, BK = 64, HALF = 128, HTB = HALF * BK * 2, STAGE_BYTES = 8 * HTB, NXCD = 8, WGM = 8;

__host__ __device__ __forceinline__ int lds_byte(int r, int c) { const int st = (r >> 4) * 2 + (c >> 5), rr = r & 15, cc = c & 31, ob = rr * 64 + cc * 2; return st * 1024 + (ob ^ (((ob >> 9) & 1) << 5)); }
__host__ __device__ __forceinline__ void stage_rc(int b, int& R, int& C) { const int st = b / 1024, sb = b % 1024, swz = sb ^ (((sb >> 9) & 1) << 5); R = (st >> 1) * 16 + swz / 64; C = (st & 1) * 32 + (swz % 64) / 2; }
__host__ __device__ __forceinline__ int perm32(int rho) { const int n = rho >> 4, i = rho & 15; return 8 * (i >> 2) + 4 * n + (i & 3); }

struct Unit { int pm, pn; };
struct Gemm { const bf16_t* A; const bf16_t* Bt; int M, N, K; };

struct StaticOrder {
    int nM, nN, nwg, G, c;
    __host__ __device__ void init(int M, int N, int G_, int c_) { nM = M / BM; nN = N / BM; nwg = nM * nN; G = G_; c = c_; }
    __host__ __device__ bool next(int i, Unit& u) const {
        const long L = (long)i * G + c; if (L >= nwg) return false;
        int wgid = (int)L; { const int q = nwg / NXCD, r = nwg % NXCD, xcd = wgid % NXCD, off = wgid / NXCD; wgid = (xcd < r ? xcd * (q + 1) : r * (q + 1) + (xcd - r) * q) + off; }
        const int nig = WGM * nN, gid = wgid / nig, fm = gid * WGM, gsz = (nM - fm) < WGM ? (nM - fm) : WGM;
        u.pm = fm + ((wgid % nig) % gsz); u.pn = (wgid % nig) / gsz; return true;
    }
    __device__ __forceinline__ void a_ready(const Unit&) const {}
    __device__ __forceinline__ void done(const Unit&) const {}
};
template <class Epi, class Sched, bool STAMP = false>
__device__ __forceinline__ void gemm_phase(PG8_LAS unsigned char* lds, const Gemm g, const Sched& S, const Epi& E, unsigned long long* stamps) {
    int tid = threadIdx.x; asm volatile("" : "+v"(tid));
    const int wid = __builtin_amdgcn_readfirstlane(tid >> 6), lane = tid & 63, wr = wid >> 2, wc = wid & 3, fr = lane & 15, fq = lane >> 4;
    const int K = g.K, nt = K / BK;
    int ts_lo = 0, ts_hi = 0, nts = 0; const unsigned long long rt_entry = STAMP ? (unsigned long long)wall_clock64() : 0ull;
#define PG8_STAMP() do { if (STAMP && wid == 0 && nts < 64) { const unsigned long long _c = (unsigned long long)clock64(); \
        ts_lo = (lane == nts) ? (int)(unsigned)_c : ts_lo; ts_hi = (lane == nts) ? (int)(unsigned)(_c >> 32) : ts_hi; ++nts; } } while (0)
    PG8_STAMP();
    unsigned voffA[2], voffB[2];
#pragma unroll
    for (int i = 0; i < 2; ++i) { int R, C; stage_rc(tid * 16 + i * 8192, R, C); const int Rb = Epi::PERM ? ((R & ~31) + perm32(R & 31)) : R;
        voffA[i] = (unsigned)(R * K + C) * 2u; voffB[i] = (unsigned)(Rb * K + C) * 2u; }
    const size_t kstep = (size_t)(BK * 2);
    const size_t hstep = (size_t)HALF * K * 2;
    const size_t tstep = 2 * hstep;
    const unsigned ldsw = (unsigned)wid * 1024u;
    const int aoff = lds_byte(wr * 64 + fr, fq * 8), boff = lds_byte(wc * 32 + fr, fq * 8);
#define PG8_SA(b, h) (((b) * 2 + (h)) * HTB)
#define PG8_SB(b, h) ((4 + (b) * 2 + (h)) * HTB)
#define PG8_STAGE(bufoff, gbase, voff) do { _Pragma("unroll") for (int _i = 0; _i < 2; ++_i) \
        __builtin_amdgcn_global_load_lds((const unsigned*)((const char*)(gbase) + (voff)[_i]), (PG8_LAS unsigned*)(lds + (bufoff) + ldsw + _i * 8192), 16, 0, 0); } while (0)
#define PG8_LDA(dst, b, h) do { _Pragma("unroll") for (int m = 0; m < 4; ++m) _Pragma("unroll") for (int k = 0; k < 2; ++k) dst[m][k] = *(const PG8_LAS bf16x8*)(lds + PG8_SA(b, h) + aoff + m * 2048 + k * 1024); } while (0)
#define PG8_LDB(dst, b, h) do { _Pragma("unroll") for (int n = 0; n < 2; ++n) _Pragma("unroll") for (int k = 0; k < 2; ++k) dst[n][k] = *(const PG8_LAS bf16x8*)(lds + PG8_SB(b, h) + boff + n * 2048 + k * 1024); } while (0)
#define PG8_MMA(ai, bj, At, Bt) do { __builtin_amdgcn_s_setprio(1); _Pragma("unroll") for (int m = 0; m < 4; ++m) _Pragma("unroll") for (int n = 0; n < 2; ++n) _Pragma("unroll") for (int k = 0; k < 2; ++k) \
        acc[ai][bj][m][n] = __builtin_amdgcn_mfma_f32_16x16x32_bf16(Bt[n][k], At[m][k], acc[ai][bj][m][n], 0, 0, 0); __builtin_amdgcn_s_setprio(0); } while (0)
#define PG8_WAIT_V(n) asm volatile("s_waitcnt vmcnt(" #n ")" ::: "memory")
#define PG8_WAIT_L(n) asm volatile("s_waitcnt lgkmcnt(" #n ")" ::: "memory")
#define PG8_BAR __builtin_amdgcn_s_barrier()
#define PG8_SCHED __builtin_amdgcn_sched_barrier(0)
    Unit cur, nxt; int ui = 0;
    if (!S.next(0, cur)) return;
    f32x4 acc[2][2][4][2];
#pragma unroll
    for (int a = 0; a < 2; ++a)
#pragma unroll
        for (int b = 0; b < 2; ++b)
#pragma unroll
            for (int m = 0; m < 4; ++m)
#pragma unroll
                for (int n = 0; n < 2; ++n) acc[a][b][m][n] = (f32x4){0.f, 0.f, 0.f, 0.f};
    bf16x8 At[4][2], B0[2][2], B1[2][2];
    const char* cA = (const char*)g.A + (size_t)cur.pm * tstep; const char* cB = (const char*)g.Bt + (size_t)cur.pn * tstep;
    S.a_ready(cur);
    PG8_STAGE(PG8_SB(0, 0), cB, voffB); PG8_STAGE(PG8_SA(0, 0), cA, voffA); PG8_STAGE(PG8_SB(0, 1), cB + hstep, voffB); PG8_STAGE(PG8_SA(0, 1), cA + hstep, voffA);
    if (wr == 1) PG8_BAR;
    PG8_WAIT_V(4); PG8_BAR;
    PG8_STAGE(PG8_SB(1, 0), cB + kstep, voffB); PG8_STAGE(PG8_SA(1, 0), cA + kstep, voffA); PG8_STAGE(PG8_SB(1, 1), cB + hstep + kstep, voffB);
    PG8_WAIT_V(6); PG8_BAR;
    PG8_STAMP();
    for (;;) {
        const bool has_next = S.next(ui + 1, nxt);
        const char* nA = has_next ? (const char*)g.A + (size_t)nxt.pm * tstep : cA; const char* nB = has_next ? (const char*)g.Bt + (size_t)nxt.pn * tstep : cB;
        for (int t = 0; t < nt; t += 2) {
            const bool last = (t == nt - 2);
            const char* a1 = cA + (size_t)(t + 1) * kstep;
            const char* a2 = last ? nA : cA + (size_t)(t + 2) * kstep; const char* b2 = last ? nB : cB + (size_t)(t + 2) * kstep;
            const char* a3 = a2 + kstep; const char* b3 = b2 + kstep;
            if (last && has_next) S.a_ready(nxt);
            PG8_LDB(B0, 0, 0); PG8_SCHED; PG8_LDA(At, 0, 0); PG8_STAGE(PG8_SA(1, 1), a1 + hstep, voffA);
            PG8_WAIT_L(8); PG8_BAR; PG8_WAIT_L(0); PG8_MMA(0, 0, At, B0); PG8_BAR; PG8_SCHED;
            PG8_LDB(B1, 0, 1); PG8_STAGE(PG8_SB(0, 0), b2, voffB);
            PG8_BAR; PG8_WAIT_L(0); PG8_MMA(0, 1, At, B1); PG8_BAR;
            PG8_LDA(At, 0, 1); PG8_STAGE(PG8_SA(0, 0), a2, voffA);
            PG8_BAR; PG8_WAIT_L(0); PG8_MMA(1, 0, At, B0); PG8_BAR; PG8_SCHED;
            PG8_STAGE(PG8_SB(0, 1), b2 + hstep, voffB);
            PG8_WAIT_V(6); PG8_BAR; PG8_MMA(1, 1, At, B1); PG8_BAR;
            PG8_LDB(B0, 1, 0); PG8_SCHED; PG8_LDA(At, 1, 0); PG8_STAGE(PG8_SA(0, 1), a2 + hstep, voffA);
            PG8_WAIT_L(8); PG8_BAR; PG8_WAIT_L(0); PG8_MMA(0, 0, At, B0); PG8_BAR; PG8_SCHED;
            PG8_LDB(B1, 1, 1); PG8_STAGE(PG8_SB(1, 0), b3, voffB);
            PG8_BAR; PG8_WAIT_L(0); PG8_MMA(0, 1, At, B1); PG8_BAR;
            PG8_LDA(At, 1, 1); PG8_STAGE(PG8_SA(1, 0), a3, voffA);
            PG8_BAR; PG8_WAIT_L(0); PG8_MMA(1, 0, At, B0); PG8_BAR; PG8_SCHED;
            PG8_STAGE(PG8_SB(1, 1), b3 + hstep, voffB);
            PG8_WAIT_V(6); PG8_BAR; PG8_MMA(1, 1, At, B1); PG8_BAR;
        }
        PG8_STAMP();
        if constexpr (!Epi::AFTER_DRAIN) { E(acc, cur, wr, wc, fr, fq); S.done(cur); }
        PG8_STAMP();
        if (!has_next) break;
#pragma unroll
        for (int a = 0; a < 2; ++a)
#pragma unroll
            for (int b = 0; b < 2; ++b)
#pragma unroll
                for (int m = 0; m < 4; ++m)
#pragma unroll
                    for (int n = 0; n < 2; ++n) acc[a][b][m][n] = (f32x4){0.f, 0.f, 0.f, 0.f};
        cur = nxt; cA = nA; cB = nB; ++ui;
    }
    PG8_WAIT_V(0);
    if (wr == 0) PG8_BAR;
    PG8_BAR;
    if constexpr (Epi::AFTER_DRAIN) { E.fused(acc, cur, wr, wc, fr, fq, lds, wid, lane); S.done(cur); }
    PG8_STAMP();
    if (STAMP && wid == 0) { stamps[lane] = lane < nts ? (((unsigned long long)(unsigned)ts_hi << 32) | (unsigned)ts_lo) : 0ull;
        if (lane == 62) stamps[62] = rt_entry; if (lane == 63) stamps[63] = (unsigned long long)wall_clock64(); }
#undef PG8_STAMP
#undef PG8_SA
#undef PG8_SB
#undef PG8_STAGE
#undef PG8_LDA
#undef PG8_LDB
#undef PG8_MMA
#undef PG8_WAIT_V
#undef PG8_WAIT_L
#undef PG8_BAR
#undef PG8_SCHED
}}

using pg8::bf16_t; using pg8::bf16x8; using pg8::f32x4; using pg8::u32x4;
typedef short s16x4 __attribute__((ext_vector_type(4)));
typedef float f32x16 __attribute__((ext_vector_type(16)));
typedef float f32x2 __attribute__((ext_vector_type(2)));
typedef unsigned u32x2 __attribute__((ext_vector_type(2)));
typedef unsigned long long u64;
#define LAS __attribute__((address_space(3)))
#define LDS_WAIT() asm volatile("s_waitcnt lgkmcnt(0)" ::: "memory")
#define XB_TMO      128
#define XB_XCNT(j)  (256  + 64 * (j))
#define XB_XSUB(j)  (1280 + 64 * (j))
#define XB_XGEN(j)  (2304 + 64 * (j))
#define XB_TOP      3328
#define XB_TOPGEN   3392
#define XCD_BAR_WORDS 3456
#define XB_SPIN_CAP (1u << 18)

__device__ __forceinline__ unsigned xb_ld(unsigned* p)              { return __hip_atomic_load(p, __ATOMIC_RELAXED, __HIP_MEMORY_SCOPE_AGENT); }
__device__ __forceinline__ unsigned xb_add(unsigned* p, unsigned v) { return __hip_atomic_fetch_add(p, v, __ATOMIC_RELAXED, __HIP_MEMORY_SCOPE_AGENT); }
__device__ __forceinline__ unsigned xb_xcc_id() { return (unsigned)__builtin_amdgcn_s_getreg((3 << 11) | 20) & 0xFu; }
#define XB_SPIN(cond, bar) do { unsigned _sp = 0; while (cond) { __builtin_amdgcn_s_sleep(1); \
    if ((++_sp & 255u) == 0u) { if (xb_ld(&(bar)[XB_TMO])) break; if (_sp > XB_SPIN_CAP) { atomicAdd(&(bar)[XB_TMO], 1u); break; } } } } while (0)

struct XcdBarrier {
    unsigned* bar; unsigned x;
    volatile LAS unsigned* st;
};

__device__ __forceinline__ XcdBarrier xcd_barrier_post(unsigned* bar, volatile LAS unsigned* st) {
    XcdBarrier b; b.bar = bar; b.x = xb_xcc_id(); b.st = st;
    if (threadIdx.x == 0) (void)xb_add(&bar[XB_XCNT(b.x)], 1u);
    return b;
}
__device__ __forceinline__ void xcd_barrier_complete(unsigned* bar, unsigned x, unsigned& nloc, unsigned& nx) {
    const unsigned G = gridDim.x * gridDim.y * gridDim.z;
    unsigned sum, cnt, mine, sp = 0u;
    for (;;) {
        sum = 0u; cnt = 0u; mine = 0u;
#pragma unroll
        for (unsigned j = 0; j < 16; ++j) { const unsigned c = xb_ld(&bar[XB_XCNT(j)]); sum += c; cnt += (c > 0u) ? 1u : 0u; mine = (j == x) ? c : mine; }
        if (sum == G) break;
        __builtin_amdgcn_s_sleep(1);
        if ((++sp & 255u) == 0u) { if (xb_ld(&bar[XB_TMO])) break; if (sp > XB_SPIN_CAP) { atomicAdd(&bar[XB_TMO], 1u); break; } }
    }
    nloc = mine > 0u ? mine : 1u; nx = cnt > 0u ? cnt : 1u;
}

__device__ __forceinline__ void xcd_barrier(const XcdBarrier& b) {
    asm volatile("s_waitcnt vmcnt(0)" ::: "memory");
    __syncthreads();
    if (threadIdx.x == 0) {
        unsigned* bar = b.bar;
        __builtin_amdgcn_s_waitcnt(0);
        unsigned nloc = b.st[0], nx = b.st[1];
        if (nloc == 0u) { xcd_barrier_complete(bar, b.x, nloc, nx); b.st[0] = nloc; b.st[1] = nx; }
        const unsigned old = xb_add(&bar[XB_XSUB(b.x)], 1u);
        const unsigned gen = old / nloc;
        if (old + 1u == (gen + 1u) * nloc) {
            __builtin_amdgcn_fence(__ATOMIC_RELEASE, "agent");
            asm volatile("s_waitcnt vmcnt(0)" ::: "memory");
            const unsigned og = xb_add(&bar[XB_TOP], 1u);
            const unsigned tg = og / nx;
            if (og + 1u == (tg + 1u) * nx) xb_add(&bar[XB_TOPGEN], 1u);
            else XB_SPIN(xb_ld(&bar[XB_TOPGEN]) == tg, bar);
            __builtin_amdgcn_fence(__ATOMIC_ACQUIRE, "agent");
            xb_add(&bar[XB_XGEN(b.x)], 1u);
            asm volatile("s_waitcnt vmcnt(0)" ::: "memory");
        } else {
            XB_SPIN(xb_ld(&bar[XB_XGEN(b.x)]) == gen, bar);
            __builtin_amdgcn_fence(__ATOMIC_ACQUIRE, "agent");
            asm volatile("s_waitcnt vmcnt(0)" ::: "memory");
        }
    }
    __syncthreads();
}


constexpr int DM = 4096, SEQ = 2048, TP = 8192, RP = 8448;
constexpr size_t MiB = (size_t)1 << 20;
constexpr size_t O_BT1 = 0, O_BT2 = O_BT1 + 128 * MiB, O_BT3 = O_BT2 + 64 * MiB, O_BT4 = O_BT3 + 88 * MiB, O_BT5 = O_BT4 + 64 * MiB, O_WG = O_BT5 + 32 * MiB,
                 O_XBF = O_WG + 8 * MiB, O_POOL = O_XBF + 66 * MiB, O_Y = O_POOL + 198 * MiB, O_SG2 = O_Y + 66 * MiB, O_OG = O_SG2 + 33 * MiB, O_KVB = O_OG + 33 * MiB,
                 O_RS = O_KVB + 48 * MiB, O_SSQP = O_RS + 1 * MiB, O_LSE = O_SSQP + 2 * MiB, O_GRAN = O_LSE + 2 * MiB, O_PART = O_GRAN + 8 * MiB, O_BAR = O_PART + 3 * MiB, O_END = O_BAR + 1 * MiB;
constexpr size_t P_XB = O_POOL, P_SG = O_POOL + 66 * MiB, P_HG = O_POOL + 132 * MiB, P_Q = O_POOL, P_ON = O_POOL + 99 * MiB;
constexpr size_t OUT_YP = 0, OUT_YS = 33554432, OUT_PCONV = OUT_YS + 32768, OUT_PH = OUT_PCONV + 98304, OUT_PKV0 = OUT_PH + 32768, OUT_PKV1 = OUT_PKV0 + 524288, OUT_PKV2 = OUT_PKV1 + 2097152,
                 OUT_SCONV = OUT_PKV2 + 8388608, OUT_SH = OUT_SCONV + 196608, OUT_SKV0 = OUT_SH + 65536, OUT_SKV1 = OUT_SKV0 + 1048576, OUT_SKV2 = OUT_SKV1 + 4194304;
constexpr int LDS_BYTES = 159744, OFF_XB = 157824;
constexpr float EPSN = 1e-6f;

struct Params { const float* in[25]; float* out; unsigned char* ws; };
typedef const Params __attribute__((address_space(4))) * KParams;
__device__ __forceinline__ KParams kparams() { KParams p = (KParams)__builtin_amdgcn_kernarg_segment_ptr(); asm volatile("" : "+s"(p)); return p; }
#define PLOCAL const KParams Pk = kparams(); (void)P;


__device__ __forceinline__ unsigned pk2(float a, float b) { typedef __bf16 bf2 __attribute__((ext_vector_type(2))); bf2 v; v[0] = (__bf16)a; v[1] = (__bf16)b; return __builtin_bit_cast(unsigned, v); }
__device__ __forceinline__ float bflo(unsigned u) { return __uint_as_float(u << 16); }
__device__ __forceinline__ float bfhi(unsigned u) { return __uint_as_float(u & 0xffff0000u); }
__device__ __forceinline__ float bf2f(bf16_t h) { return __uint_as_float(((unsigned)h) << 16); }
__device__ __forceinline__ float silu_f(float v) { return v * __builtin_amdgcn_rcpf(1.0f + __expf(-v)); }
__device__ __forceinline__ float sigm_f(float v) { return __builtin_amdgcn_rcpf(1.0f + __expf(-v)); }
__device__ __forceinline__ float wave_sum(float v) {
#pragma unroll
    for (int o = 1; o < 64; o <<= 1) v += __shfl_xor(v, o);
    return v;
}
__device__ __forceinline__ float wave_max(float v) {
#pragma unroll
    for (int o = 1; o < 64; o <<= 1) v = fmaxf(v, __shfl_xor(v, o));
    return v;
}
__device__ __forceinline__ int crow(int reg, int h) { return (reg & 3) + 8 * (reg >> 2) + 4 * h; }
__device__ __forceinline__ int rel_bucket(int dd) {
    if (dd < 16) return dd;
    const float d = (float)dd;
    int large = 16 + (int)(logf(d * (1.0f / 16.0f)) / logf(128.0f) * 16.0f);
    return large < 31 ? large : 31;
}
#define MFMA32(a, b, c) __builtin_amdgcn_mfma_f32_32x32x16_bf16((a), (b), (c), 0, 0, 0)

struct Epi {
    static constexpr bool PERM = true, AFTER_DRAIN = false;
    int mode;
    const float* rs; bf16_t* o0; bf16_t* o1; bf16_t* o2; float* ssqp; float* outp;
    __device__ __forceinline__ void operator()(const f32x4 (&acc)[2][2][4][2], const pg8::Unit& u, int wr, int wc, int fr, int fq) const {
        const int row0 = u.pm * 256 + wr * 64 + fr, colt = u.pn * 256, cw = wc * 32 + 8 * fq;
        if (mode == 1) {
#pragma unroll
            for (int ai = 0; ai < 2; ++ai)
#pragma unroll
                for (int m = 0; m < 4; ++m) {
                    const int row = row0 + ai * 128 + m * 16; float ss = 0.f;
#pragma unroll
                    for (int bj = 0; bj < 2; ++bj) {
                        const f32x4 v0 = acc[ai][bj][m][0], v1 = acc[ai][bj][m][1];
                        ss += (v0[0] * v0[0] + v0[1] * v0[1]) + (v0[2] * v0[2] + v0[3] * v0[3]) + (v1[0] * v1[0] + v1[1] * v1[1]) + (v1[2] * v1[2] + v1[3] * v1[3]);
                        u32x4 w; w.x = pk2(v0[0], v0[1]); w.y = pk2(v0[2], v0[3]); w.z = pk2(v1[0], v1[1]); w.w = pk2(v1[2], v1[3]);
                        *(u32x4*)(o0 + (size_t)row * 4096 + colt + bj * 128 + cw) = w;
                    }
                    ss += __shfl_xor(ss, 16); ss += __shfl_xor(ss, 32);
                    if (fq == 0) ssqp[(size_t)row * 64 + u.pn * 4 + wc] = ss;
                }
            return;
        }
        bf16_t* dst; int ld, col; bool act = false, kv = false;
        if (mode == 0) { ld = 4096; if (colt < 4096) { dst = o0; col = colt; } else { dst = o1; col = colt - 4096; act = true; } }
        else { if (colt < 6144) { dst = o0; ld = 6144; col = colt; } else if (colt < 8192) { dst = o1; ld = 2048; col = colt - 6144; act = true; } else { dst = o2; ld = 3072; col = colt - 8192; kv = true; } }
#pragma unroll
        for (int ai = 0; ai < 2; ++ai)
#pragma unroll
            for (int m = 0; m < 4; ++m) {
                const int row = row0 + ai * 128 + m * 16;
#pragma unroll
                for (int bj = 0; bj < 2; ++bj) {
                    f32x4 v0 = acc[ai][bj][m][0], v1 = acc[ai][bj][m][1];
                    if (act) {
#pragma unroll
                        for (int j = 0; j < 4; ++j) { v0[j] = silu_f(v0[j]); v1[j] = silu_f(v1[j]); }
                    }
                    u32x4 w; w.x = pk2(v0[0], v0[1]); w.y = pk2(v0[2], v0[3]); w.z = pk2(v1[0], v1[1]); w.w = pk2(v1[2], v1[3]);
                    const int cc = col + bj * 128 + cw;
                    *(u32x4*)(dst + (size_t)row * ld + cc) = w;
                    if (kv) {
                        const int g = cc >> 10, rem = cc & 1023, keep = 128 << (2 * g), n = row >> 11, t = row & 2047;
                        if (t >= 2048 - keep) {
                            const size_t ob = (g == 0 ? OUT_PKV0 : (g == 1 ? OUT_PKV1 : OUT_PKV2)) + ((size_t)(n * keep + (t - (2048 - keep))) * 1024 + rem);
                            *(f32x4*)(outp + ob) = v0; *(f32x4*)(outp + ob + 4) = v1;
                        }
                    }
                }
            }
    }
};

constexpr int TPITCH = 144, TTILE = 128 * TPITCH;
__device__ __forceinline__ void transpose_item(const float* W, int K, int N, bf16_t* WT, const float* gain, int item, int lane, LAS unsigned char* tile) {
    const int nblk = N / 128, kb = item / nblk, nb = item % nblk, k0 = 64 * kb, n0 = 128 * nb;
    f32x2 v[64];
    const float* src = W + (size_t)k0 * N + n0 + lane * 2;
#pragma unroll
    for (int kk = 0; kk < 64; ++kk) v[kk] = __builtin_nontemporal_load((const f32x2*)(src + (size_t)kk * N));
    if (gain) {
#pragma unroll
        for (int kk = 0; kk < 64; ++kk) v[kk] = v[kk] * gain[k0 + kk];
    }
#pragma unroll
    for (int i = 0; i < 2; ++i) {
        LAS unsigned char* row = tile + (lane * 2 + i) * TPITCH;
#pragma unroll
        for (int c = 0; c < 8; ++c) {
            u32x4 o; o.x = pk2(v[8 * c][i], v[8 * c + 1][i]); o.y = pk2(v[8 * c + 2][i], v[8 * c + 3][i]); o.z = pk2(v[8 * c + 4][i], v[8 * c + 5][i]); o.w = pk2(v[8 * c + 6][i], v[8 * c + 7][i]);
            *(LAS u32x4*)(row + c * 16) = o;
        }
    }
    LDS_WAIT();
    const int chunk = lane & 7, r8 = lane >> 3;
#pragma unroll
    for (int j = 0; j < 16; ++j) {
        const int rowi = r8 + 8 * j;
        const u32x4 o = *(const LAS u32x4*)(tile + rowi * TPITCH + chunk * 16);
        *(u32x4*)(WT + (size_t)(n0 + rowi) * K + k0 + chunk * 8) = o;
    }
    LDS_WAIT();
}

constexpr int I_AIN = 64 * 64, I_AOUT = 64 * 32, I_KV = 64 * 24, I_BOUT = 32 * 32, I_G = 4 * 2;
constexpr int N_PREP_ITEMS = 2 * I_AIN + 2 * I_AOUT + I_AIN + I_KV + I_AIN + 64 * I_G, N_ALL_ITEMS = N_PREP_ITEMS + 2 * I_BOUT;
__device__ __forceinline__ void convert_work(const Params& P, LAS unsigned char* lds, int lo, int hi, bool kvcopy, int vb, int nvb) {
    const KParams Pk = kparams();
    int tid = threadIdx.x; asm volatile("" : "+v"(tid));
    const int lane = tid & 63, w = __builtin_amdgcn_readfirstlane(tid >> 6);
    const int gw = vb * 8 + w, NGW = nvb * 8;
    unsigned char* ws = Pk->ws;
    LAS unsigned char* tile = lds + w * TTILE;
    if (kvcopy) {
        for (int g = 0; g < 3; ++g) {
            const int lb = 128 << (2 * g); const size_t per = (size_t)(lb - 1) * 256, tot = 8 * per;
            const f32x4* src = (const f32x4*)Pk->in[4 + g]; f32x4* dst = (f32x4*)(Pk->out + (g == 0 ? OUT_SKV0 : (g == 1 ? OUT_SKV1 : OUT_SKV2)));
            for (size_t i = (size_t)vb * 512 + tid; i < tot; i += (size_t)nvb * 512) { const size_t b = i / per, o = i - b * per; dst[b * (size_t)lb * 256 + o] = __builtin_nontemporal_load(src + b * (size_t)lb * 256 + 256 + o); }
        }
    }
    for (int it = lo + gw; it < hi; it += NGW) {
        int r = it;
        if (r < 2 * I_AIN) { const int l = r / I_AIN; transpose_item(Pk->in[8] + (size_t)l * 4096 * 8192, 4096, 8192, (bf16_t*)(ws + O_BT1) + (size_t)l * 8192 * 4096, Pk->in[7] + l * 4096, r % I_AIN, lane, tile); continue; } r -= 2 * I_AIN;
        if (r < 2 * I_AOUT) { const int l = r / I_AOUT; transpose_item(Pk->in[16] + (size_t)l * 4096 * 4096, 4096, 4096, (bf16_t*)(ws + O_BT2) + (size_t)l * 4096 * 4096, nullptr, r % I_AOUT, lane, tile); continue; } r -= 2 * I_AOUT;
        if (r < I_AIN) { transpose_item(Pk->in[22], 4096, 8192, (bf16_t*)(ws + O_BT3), Pk->in[21], r, lane, tile); continue; } r -= I_AIN;
        if (r < I_KV) { transpose_item(Pk->in[19], 4096, 3072, (bf16_t*)(ws + O_BT3) + (size_t)8192 * 4096, Pk->in[18], r, lane, tile); continue; } r -= I_KV;
        if (r < I_AIN) { transpose_item(Pk->in[22] + (size_t)4096 * 8192, 4096, 8192, (bf16_t*)(ws + O_BT4), Pk->in[21] + 4096, r, lane, tile); continue; } r -= I_AIN;
        if (r < 64 * I_G) { const int mat = r / I_G, gate = mat & 1, lh = mat >> 1;
            transpose_item((gate ? Pk->in[13] : Pk->in[11]) + (size_t)lh * 65536, 256, 256, (bf16_t*)(ws + O_WG) + (size_t)(lh * 2 + gate) * 65536, nullptr, r % I_G, lane, tile); continue; } r -= 64 * I_G;
        { const int l = r / I_BOUT; transpose_item(Pk->in[23] + (size_t)l * 2048 * 4096, 2048, 4096, (bf16_t*)(ws + O_BT5) + (size_t)l * 4096 * 2048, nullptr, r % I_BOUT, lane, tile); }
    }
}

__device__ __forceinline__ void prep_phase(const Params& P, LAS unsigned char* lds) {
    const KParams Pk = kparams();
    int tid = threadIdx.x; asm volatile("" : "+v"(tid));
    const int lane = tid & 63, w = __builtin_amdgcn_readfirstlane(tid >> 6);
    const int gw = blockIdx.x * 8 + w, NGW = gridDim.x * 8;
    unsigned char* ws = Pk->ws;
    { u64* gr = (u64*)(ws + O_GRAN); const size_t n = (8 * MiB) / 8; for (size_t i = (size_t)blockIdx.x * 512 + tid; i < n; i += (size_t)gridDim.x * 512) gr[i] = 0ull; }
    { bf16_t* XBF = (bf16_t*)(ws + O_XBF); float* RS = (float*)(ws + O_RS);
      for (int row = gw; row < TP + 8; row += NGW) {
          const float* xr = row < TP ? Pk->in[0] + (size_t)row * DM : Pk->in[1] + (size_t)(row - TP) * DM;
          const f32x4* x4 = (const f32x4*)xr + lane; f32x4 v[16]; float s = 0.f;
#pragma unroll
          for (int j = 0; j < 16; ++j) { v[j] = x4[64 * j]; s += (v[j].x * v[j].x + v[j].y * v[j].y) + (v[j].z * v[j].z + v[j].w * v[j].w); }
          s = wave_sum(s);
          const float rs = rsqrtf(s * (1.0f / DM) + EPSN);
          u32x2* o = (u32x2*)(XBF + (size_t)row * DM) + lane;
#pragma unroll
          for (int j = 0; j < 16; ++j) { u32x2 q; q.x = pk2(v[j].x * rs, v[j].y * rs); q.y = pk2(v[j].z * rs, v[j].w * rs); o[64 * j] = q; }
          if (lane == 0) RS[row] = rs;
      } }
}

template <int KSTEPS>
__device__ __forceinline__ void skinny_phase(const bf16_t* A, const bf16_t* Bt, int N, int K, float* sout, LAS unsigned char* lds) {
    int tid = threadIdx.x; asm volatile("" : "+v"(tid));
    const int lane = tid & 63, w = __builtin_amdgcn_readfirstlane(tid >> 6), fr = lane & 15, fq = lane >> 4;
    LAS float* red = (LAS float*)lds;
    const int ngroups = N / 16, k0 = w * (KSTEPS * 32);
    for (int grp = blockIdx.x; grp < ngroups; grp += gridDim.x) {
        const int n0 = grp * 16;
        const bf16_t* ap = A + (size_t)(fr & 7) * K + k0 + fq * 8; const bf16_t* bp = Bt + (size_t)(n0 + fr) * K + k0 + fq * 8;
        bf16x8 a[KSTEPS], b[KSTEPS];
#pragma unroll
        for (int s = 0; s < KSTEPS; ++s) { b[s] = __builtin_nontemporal_load((const bf16x8*)(bp + s * 32)); a[s] = *(const bf16x8*)(ap + s * 32); }
        f32x4 acc = {0.f, 0.f, 0.f, 0.f};
#pragma unroll
        for (int s = 0; s < KSTEPS; ++s) { if (fr >= 8) a[s] = (bf16x8){0, 0, 0, 0, 0, 0, 0, 0}; acc = __builtin_amdgcn_mfma_f32_16x16x32_bf16(a[s], b[s], acc, 0, 0, 0); }
        __syncthreads();
        if (fq < 2) {
#pragma unroll
            for (int i = 0; i < 4; ++i) red[(w * 8 + fq * 4 + i) * 16 + fr] = acc[i];
        }
        __syncthreads();
        if (tid < 128) { float s = 0.f;
#pragma unroll
            for (int ww = 0; ww < 8; ++ww) s += red[ww * 128 + tid];
            sout[(size_t)(tid >> 4) * N + n0 + (tid & 15)] = s; }
    }
}
__device__ __forceinline__ float part_sum(const float* sout, int N, int b, int col) { return sout[(size_t)b * N + col]; }

constexpr int SROW = 528;
__device__ __forceinline__ void scan_phase(const Params& P, LAS unsigned char* lds, int l) {
    const KParams Pk = kparams();
    const int tid0 = threadIdx.x;
    LAS unsigned char* RAW = lds;
    LAS unsigned char* AT = lds + 69632;
    unsigned char* ws = Pk->ws;
    const bf16_t* XB = (const bf16_t*)(ws + P_XB); const bf16_t* SG = (const bf16_t*)(ws + P_SG); bf16_t* HG = (bf16_t*)(ws + P_HG);
    const float* SOUT = (const float*)(ws + O_PART); const float* RS = (const float*)(ws + O_RS);
    const float* cwp = Pk->in[9] + (size_t)l * 4 * 4096; const float* cbp = Pk->in[10] + (size_t)l * 4096;
    bf16x8 bR[8], bI[8]; int cur = -1;
    for (int t = blockIdx.x; t < 32 + 2048; t += gridDim.x) {
        int tid = tid0; asm volatile("" : "+v"(tid));
        const int lane = tid & 63, w = __builtin_amdgcn_readfirstlane(tid >> 6), fr = lane & 15, fq = lane >> 4;
        const bool is_s = t < 32;
        int hh2, n = 0, sp = 0;
        if (is_s) hh2 = t; else { const int idx = t - 32; hh2 = idx & 31; n = (idx >> 5) & 3; sp = idx >> 7; }
        const int head = hh2 >> 1, half = hh2 & 1, gc0 = head * 256, hc = half * 128 + w * 16 + fr, gch = gc0 + hc, r0 = n * 2048 + sp * 128;
        if (hh2 != cur) {
            const bf16_t* wp = (const bf16_t*)(ws + O_WG) + (size_t)((l * 16 + head) * 2) * 65536 + (size_t)hc * 256 + fq * 8;
#pragma unroll
            for (int ks = 0; ks < 8; ++ks) { bR[ks] = *(const bf16x8*)(wp + ks * 32); bI[ks] = *(const bf16x8*)(wp + 65536 + ks * 32); }
            cur = hh2;
        }
        __syncthreads();
        if (is_s) {
            const int b = tid >> 6, ch = (tid & 63) * 4;
            float xc[4][4];
#pragma unroll
            for (int e = 0; e < 4; ++e) {
                const int gc = gc0 + ch + e;
#pragma unroll
                for (int k = 0; k < 3; ++k) xc[k][e] = Pk->in[2][((size_t)(l * 8 + b) * 3 + k) * 4096 + gc];
                xc[3][e] = SOUT[(size_t)b * 8192 + gc];
            }
            float o[4];
#pragma unroll
            for (int e = 0; e < 4; ++e) {
                const int gc = gc0 + ch + e; float v = cbp[gc];
#pragma unroll
                for (int k = 0; k < 4; ++k) v += xc[k][e] * cwp[k * 4096 + gc];
                o[e] = v;
                if (half == 0) {
#pragma unroll
                    for (int k = 0; k < 3; ++k) Pk->out[OUT_SCONV + ((size_t)(l * 8 + b) * 3 + k) * 4096 + gc] = xc[k + 1][e];
                }
            }
            u32x2 q; q.x = pk2(o[0], o[1]); q.y = pk2(o[2], o[3]);
            *(LAS u32x2*)(AT + b * SROW + ch * 2) = q;
        } else {
#pragma unroll
            for (int j = 0; j < 9; ++j) {
                const int id = tid + 512 * j, i = id >> 5, c8 = id & 31;
                if (i < 131) {
                    u32x4 v = {0u, 0u, 0u, 0u};
                    if (!(sp == 0 && i < 3)) v = *(const u32x4*)(XB + (size_t)(r0 - 3 + i) * 4096 + gc0 + c8 * 8);
                    *(LAS u32x4*)(RAW + i * SROW + c8 * 16) = v;
                }
            }
            __syncthreads();
            const int c8 = tid & 31; float wk[4][8], bb[8];
#pragma unroll
            for (int e = 0; e < 8; ++e) { bb[e] = cbp[gc0 + c8 * 8 + e];
#pragma unroll
                for (int k = 0; k < 4; ++k) wk[k][e] = cwp[k * 4096 + gc0 + c8 * 8 + e]; }
#pragma unroll
            for (int j = 0; j < 8; ++j) {
                const int i = (tid >> 5) + 16 * j;
                float o[8];
#pragma unroll
                for (int e = 0; e < 8; ++e) o[e] = bb[e];
                u32x4 last;
#pragma unroll
                for (int k = 0; k < 4; ++k) {
                    const u32x4 v = *(const LAS u32x4*)(RAW + (i + k) * SROW + c8 * 16); last = v;
                    o[0] += bflo(v.x) * wk[k][0]; o[1] += bfhi(v.x) * wk[k][1]; o[2] += bflo(v.y) * wk[k][2]; o[3] += bfhi(v.y) * wk[k][3];
                    o[4] += bflo(v.z) * wk[k][4]; o[5] += bfhi(v.z) * wk[k][5]; o[6] += bflo(v.w) * wk[k][6]; o[7] += bfhi(v.w) * wk[k][7];
                }
                u32x4 q; q.x = pk2(o[0], o[1]); q.y = pk2(o[2], o[3]); q.z = pk2(o[4], o[5]); q.w = pk2(o[6], o[7]);
                *(LAS u32x4*)(AT + i * SROW + c8 * 16) = q;
                if (sp == 15 && i >= 125 && half == 0) {
                    float* d = Pk->out + OUT_PCONV + ((size_t)(l * 4 + n) * 3 + (i - 125)) * 4096 + gc0 + c8 * 8;
                    f32x4 a = {bflo(last.x), bfhi(last.x), bflo(last.y), bfhi(last.y)}, b = {bflo(last.z), bfhi(last.z), bflo(last.w), bfhi(last.w)};
                    *(f32x4*)d = a; *(f32x4*)(d + 4) = b;
                }
            }
        }
        __syncthreads();
        f32x4 aR[8], aI[8];
#pragma unroll
        for (int mt = 0; mt < 8; ++mt) { aR[mt] = (f32x4){0.f, 0.f, 0.f, 0.f}; aI[mt] = (f32x4){0.f, 0.f, 0.f, 0.f}; }
#pragma unroll
        for (int ks = 0; ks < 8; ++ks) {
#pragma unroll
            for (int mt = 0; mt < 8; ++mt) {
                const bf16x8 a = *(const LAS bf16x8*)(AT + (mt * 16 + fr) * SROW + (ks * 32 + fq * 8) * 2);
                aR[mt] = __builtin_amdgcn_mfma_f32_16x16x32_bf16(a, bR[ks], aR[mt], 0, 0, 0);
                aI[mt] = __builtin_amdgcn_mfma_f32_16x16x32_bf16(a, bI[ks], aI[mt], 0, 0, 0);
            }
            __builtin_amdgcn_sched_barrier(0);
        }
        const float bga = Pk->in[12][(size_t)l * 4096 + gch], bgx = Pk->in[14][(size_t)l * 4096 + gch];
        const float lamc = -8.0f * log1pf(expf(-Pk->in[15][(size_t)l * 4096 + gch]));
#pragma unroll
        for (int mt = 0; mt < 8; ++mt)
#pragma unroll
            for (int i = 0; i < 4; ++i) {
                const int row = mt * 16 + 4 * fq + i;
                const float r = sigm_f(aR[mt][i] + bga), ig = sigm_f(aI[mt][i] + bgx);
                const float la = lamc * r, a = __expf(la);
                const float em = fmaf(-a, a, 1.0f);
                const float xf = bf2f(*(const LAS bf16_t*)(AT + row * SROW + hc * 2));
                aR[mt][i] = a; aI[mt][i] = __builtin_amdgcn_sqrtf(em) * ig * xf;
            }
        if (is_s) {
            if (fq < 2) {
#pragma unroll
                for (int i = 0; i < 4; ++i) {
                    const int b = 4 * fq + i;
                    const float h0 = Pk->in[3][(size_t)(l * 8 + b) * 4096 + gch];
                    const float h = aR[0][i] * h0 + aI[0][i];
                    Pk->out[OUT_SH + (size_t)(l * 8 + b) * 4096 + gch] = h;
                    const float sg = silu_f(SOUT[(size_t)b * 8192 + 4096 + gch]);
                    HG[(size_t)(TP + b) * 4096 + gch] = (bf16_t)(pk2(h * sg, 0.f) & 0xffffu);
                }
            }
            continue;
        }
        float Pp = 1.f, Cc = 0.f;
#pragma unroll
        for (int mt = 0; mt < 8; ++mt) {
            float A = aR[mt][0], H = aI[mt][0];
#pragma unroll
            for (int i = 1; i < 4; ++i) { const float a = aR[mt][i], b = aI[mt][i]; H = a * H + b; A = A * a; aR[mt][i] = A; aI[mt][i] = H; }
            float Pm = 1.f, Cm = 0.f;
#pragma unroll
            for (int q = 0; q < 4; ++q) {
                const float qA = __shfl(A, fr + 16 * q), qH = __shfl(H, fr + 16 * q);
                if (q == fq) { Pm = Pp; Cm = Cc; }
                Cc = qA * Cc + qH; Pp = Pp * qA;
            }
#pragma unroll
            for (int i = 0; i < 4; ++i) { aI[mt][i] += aR[mt][i] * Cm; aR[mt][i] *= Pm; }
        }
        u64* gr = (u64*)(ws + O_GRAN) + (((size_t)l * 4 + n) * 16 + sp) * 4096 + gch;
        const unsigned tag = 1u + (unsigned)l;
        float H0 = 0.f;
        if (sp > 0) {
            const u64* pg = gr - 4096; u64 x = 0; unsigned spins = 0;
            for (;;) {
                x = __hip_atomic_load(pg, __ATOMIC_RELAXED, __HIP_MEMORY_SCOPE_AGENT);
                if (__all((unsigned)(x >> 32) == tag)) break;
                if (++spins > (1u << 22)) break;
                __builtin_amdgcn_s_sleep(1);
            }
            H0 = __uint_as_float((unsigned)x);
        }
        const float hend = Cc + Pp * H0;
        if (fq == 0) {
            __hip_atomic_store(gr, ((u64)tag << 32) | (u64)__float_as_uint(hend), __ATOMIC_RELAXED, __HIP_MEMORY_SCOPE_AGENT);
            if (sp == 15) Pk->out[OUT_PH + (size_t)(l * 4 + n) * 4096 + gch] = hend;
        }
        __syncthreads();
#pragma unroll
        for (int mt = 0; mt < 8; ++mt)
#pragma unroll
            for (int i = 0; i < 4; ++i) {
                const int row = mt * 16 + 4 * fq + i;
                const float h = aI[mt][i] + aR[mt][i] * H0;
                *(LAS bf16_t*)(AT + row * SROW + hc * 2) = (bf16_t)(pk2(h, 0.f) & 0xffffu);
            }
        __syncthreads();
        {
            const int c8 = tid & 15;
#pragma unroll
            for (int j = 0; j < 4; ++j) {
                const int i = (tid >> 4) + 32 * j;
                const u32x4 hv = *(const LAS u32x4*)(AT + i * SROW + (half * 128 + c8 * 8) * 2);
                const size_t go = (size_t)(r0 + i) * 4096 + gc0 + half * 128 + c8 * 8;
                const u32x4 sv = *(const u32x4*)(SG + go);
                u32x4 q; q.x = pk2(bflo(hv.x) * bflo(sv.x), bfhi(hv.x) * bfhi(sv.x)); q.y = pk2(bflo(hv.y) * bflo(sv.y), bfhi(hv.y) * bfhi(sv.y));
                q.z = pk2(bflo(hv.z) * bflo(sv.z), bfhi(hv.z) * bfhi(sv.z)); q.w = pk2(bflo(hv.w) * bflo(sv.w), bfhi(hv.w) * bfhi(sv.w));
                *(u32x4*)(HG + go) = q;
            }
        }
    }
}

__device__ __forceinline__ void post_phase(const Params& P, int L) {
    const KParams Pk = kparams();
    int tid = threadIdx.x; asm volatile("" : "+v"(tid));
    const int lane = tid & 63, w = __builtin_amdgcn_readfirstlane(tid >> 6);
    const int gw = blockIdx.x * 8 + w, NGW = gridDim.x * 8;
    unsigned char* ws = Pk->ws;
    const float* gain = L < 2 ? Pk->in[17] + (size_t)L * 4096 : Pk->in[24] + (size_t)(L - 2) * 4096;
    const bf16_t* Y = (const bf16_t*)(ws + O_Y); const float* SSQP = (const float*)(ws + O_SSQP); const float* SOUT = (const float*)(ws + O_PART);
    bf16_t* XBF = (bf16_t*)(ws + O_XBF); float* RS = (float*)(ws + O_RS);
    for (int row = gw; row < TP + 8; row += NGW) {
        const bool smp = row >= TP; const int b = row - TP;
        float ssq; f32x4 y0[8], y1[8], x0[8], x1[8];
        if (!smp) {
            ssq = SSQP[(size_t)row * 64 + lane];
#pragma unroll
            for (int j = 0; j < 8; ++j) { const u32x4 yv = *(const u32x4*)(Y + (size_t)row * 4096 + j * 512 + lane * 8);
                y0[j] = (f32x4){bflo(yv.x), bfhi(yv.x), bflo(yv.y), bfhi(yv.y)}; y1[j] = (f32x4){bflo(yv.z), bfhi(yv.z), bflo(yv.w), bfhi(yv.w)}; }
        } else {
            ssq = 0.f;
#pragma unroll
            for (int j = 0; j < 8; ++j) { const float* sp = SOUT + (size_t)b * 4096 + j * 512 + lane * 8; y0[j] = *(const f32x4*)sp; y1[j] = *(const f32x4*)(sp + 4);
                ssq += (y0[j].x * y0[j].x + y0[j].y * y0[j].y) + (y0[j].z * y0[j].z + y0[j].w * y0[j].w) + (y1[j].x * y1[j].x + y1[j].y * y1[j].y) + (y1[j].z * y1[j].z + y1[j].w * y1[j].w); }
        }
        if (L == 0) {
            const float* xin = (smp ? Pk->in[1] + (size_t)b * 4096 : Pk->in[0] + (size_t)row * 4096);
#pragma unroll
            for (int j = 0; j < 8; ++j) { x0[j] = *(const f32x4*)(xin + j * 512 + lane * 8); x1[j] = *(const f32x4*)(xin + j * 512 + lane * 8 + 4); }
        } else {
            const float irs = 1.0f / RS[row];
#pragma unroll
            for (int j = 0; j < 8; ++j) { const u32x4 xv = *(const u32x4*)(XBF + (size_t)row * 4096 + j * 512 + lane * 8);
                x0[j] = (f32x4){bflo(xv.x), bfhi(xv.x), bflo(xv.y), bfhi(xv.y)} * irs; x1[j] = (f32x4){bflo(xv.z), bfhi(xv.z), bflo(xv.w), bfhi(xv.w)} * irs; }
        }
        const float rsn = rsqrtf(wave_sum(ssq) * (1.0f / 4096.0f) + EPSN);
        float acc = 0.f;
        float* xout = Pk->out + (smp ? OUT_YS + (size_t)b * 4096 : OUT_YP + (size_t)row * 4096);
#pragma unroll
        for (int j = 0; j < 8; ++j) {
            const int col = j * 512 + lane * 8;
            const f32x4 g0 = *(const f32x4*)(gain + col), g1 = *(const f32x4*)(gain + col + 4);
            const f32x4 n0 = x0[j] + y0[j] * rsn * g0, n1 = x1[j] + y1[j] * rsn * g1;
            acc += (n0.x * n0.x + n0.y * n0.y) + (n0.z * n0.z + n0.w * n0.w) + (n1.x * n1.x + n1.y * n1.y) + (n1.z * n1.z + n1.w * n1.w);
            if (L == 3) { *(f32x4*)(xout + col) = n0; *(f32x4*)(xout + col + 4) = n1; }
            x0[j] = n0; x1[j] = n1;
        }
        acc = wave_sum(acc);
        const float rsx = rsqrtf(acc * (1.0f / 4096.0f) + EPSN);
        if (L < 3) {
#pragma unroll
            for (int j = 0; j < 8; ++j) { const int col = j * 512 + lane * 8; const f32x4 n0 = x0[j] * rsx, n1 = x1[j] * rsx;
                u32x4 q; q.x = pk2(n0.x, n0.y); q.y = pk2(n0.z, n0.w); q.z = pk2(n1.x, n1.y); q.w = pk2(n1.z, n1.w); *(u32x4*)(XBF + (size_t)row * 4096 + col) = q; }
        }
        if (lane == 0) RS[row] = rsx;
    }
}

constexpr int KROW = 272, VROW = 320, OFF_VS = 69632, OFF_BI = OFF_VS + 81920, OFF_SW = OFF_BI + 2112;
__device__ __forceinline__ void attn_item(const Params& P, LAS unsigned char* lds, int item) {
    const KParams Pk = kparams();
    int tid = threadIdx.x; asm volatile("" : "+v"(tid));
    const int lane = tid & 63, w = __builtin_amdgcn_readfirstlane(tid >> 6), hh = lane >> 5, l32 = lane & 31;
    unsigned char* ws = Pk->ws;
    const bf16_t* Q = (const bf16_t*)(ws + P_Q); const bf16_t* KVB = (const bf16_t*)(ws + O_KVB); bf16_t* ON = (bf16_t*)(ws + P_ON); float* LSE = (float*)(ws + O_LSE);
    const int g = item >> 8, rem = item & 255, n = rem >> 6, kvh = rem & 3, cb = (rem >> 2) & 15;
    const int r = 1 << (2 * g), nb = 16 >> (2 * g), c = cb / nb, nbi = cb % nb;
    LAS unsigned char* Ks = lds; LAS unsigned char* Vs = lds + OFF_VS; LAS float* BI = (LAS float*)(lds + OFF_BI);
    __syncthreads();
#pragma unroll
    for (int j = 0; j < 8; ++j) {
        const int id = tid + 512 * j, kk = id >> 4, chk = id & 15, pos = (nbi - 1) * 128 + kk;
        u32x4 kv = {0u, 0u, 0u, 0u}, vv = {0u, 0u, 0u, 0u};
        if (pos >= 0) { const bf16_t* src = KVB + (size_t)(n * 2048 + pos * r + c) * 3072 + g * 1024 + kvh * 128 + chk * 8; kv = *(const u32x4*)src; vv = *(const u32x4*)(src + 512); }
        *(LAS u32x4*)(Ks + kk * KROW + chk * 16) = kv; *(LAS u32x4*)(Vs + kk * VROW + chk * 16) = vv;
    }
    for (int e = tid; e < 516; e += 512) { const int hl = e / 129, dist = e % 129; BI[hl * 132 + dist] = 1.4426950408889634f * Pk->in[20][rel_bucket(dist * r) * 48 + g * 16 + kvh * 4 + hl]; }
    __syncthreads();
    const float scale2 = 0.08838834764831845f * 1.4426950408889634f;
    const int qc = w & 3, qq = qc * 32 + l32, qrow = n * 2048 + (nbi * 128 + qq) * r + c;
    bf16x8 Qf[8];
    { const bf16_t* qp = Q + (size_t)qrow * 6144 + g * 2048 + (kvh * 4 + (w >> 2)) * 128 + hh * 8;
#pragma unroll
      for (int s = 0; s < 8; ++s) Qf[s] = *(const bf16x8*)(qp + s * 16); }
    for (int pp = 0; pp < 2; ++pp) {
        const int hl = (w >> 2) + 2 * pp, slot = kvh * 4 + hl;
        f32x16 S[5];
#pragma unroll
        for (int kt = 0; kt < 5; ++kt) {
#pragma unroll
            for (int e = 0; e < 16; ++e) S[kt][e] = 0.f;
            if (nbi > 0 || qc + kt >= 4) {
#pragma unroll
                for (int s = 0; s < 8; ++s) {
                    const bf16x8 a = *(const LAS bf16x8*)(Ks + (qc * 32 + kt * 32 + l32) * KROW + (s * 16 + hh * 8) * 2);
                    S[kt] = MFMA32(a, Qf[s], S[kt]);
                }
            }
            __builtin_amdgcn_sched_barrier(0);
        }
        if (pp == 0) {
            const bf16_t* qp = Q + (size_t)qrow * 6144 + g * 2048 + (slot + 2) * 128 + hh * 8;
#pragma unroll
            for (int s = 0; s < 8; ++s) Qf[s] = *(const bf16x8*)(qp + s * 16);
        }
        float m = -INFINITY;
#pragma unroll
        for (int kt = 0; kt < 5; ++kt) {
            const bool on = nbi > 0 || qc + kt >= 4;
            const LAS float* bp = BI + hl * 132 + (128 - 32 * kt - 27 - 4 * hh) + l32;
#pragma unroll
            for (int reg = 0; reg < 16; ++reg) {
                const int kc = (reg & 3) + 8 * (reg >> 2);
                float sv = S[kt][reg] * scale2 + bp[27 - kc];
                if (kt == 0) sv = (kc + 4 * hh >= l32) ? sv : -INFINITY;
                if (kt == 4) sv = (kc + 4 * hh <= l32) ? sv : -INFINITY;
                if (!on) sv = -INFINITY;
                S[kt][reg] = sv; m = fmaxf(m, sv);
            }
            __builtin_amdgcn_sched_barrier(0);
        }
        m = fmaxf(m, __shfl_xor(m, 32));
        float den = 0.f;
#pragma unroll
        for (int kt = 0; kt < 5; ++kt)
#pragma unroll
            for (int reg = 0; reg < 16; ++reg) { const float p = __builtin_amdgcn_exp2f(S[kt][reg] - m); S[kt][reg] = p; den += p; }
        den += __shfl_xor(den, 32);
        f32x16 O[4];
#pragma unroll
        for (int dt = 0; dt < 4; ++dt)
#pragma unroll
            for (int e = 0; e < 16; ++e) O[dt][e] = 0.f;
        const int q_ = (lane & 15) >> 2, p_ = lane & 3, cg16 = (lane >> 4) & 1;
#pragma unroll
        for (int kt = 0; kt < 5; ++kt) {
            if (nbi > 0 || qc + kt >= 4) {
#pragma unroll
                for (int s2 = 0; s2 < 2; ++s2) {
                    u32x4 pw; pw.x = pk2(S[kt][8 * s2 + 0], S[kt][8 * s2 + 1]); pw.y = pk2(S[kt][8 * s2 + 2], S[kt][8 * s2 + 3]); pw.z = pk2(S[kt][8 * s2 + 4], S[kt][8 * s2 + 5]); pw.w = pk2(S[kt][8 * s2 + 6], S[kt][8 * s2 + 7]);
                    const bf16x8 pf = __builtin_bit_cast(bf16x8, pw);
                    const int R0 = qc * 32 + kt * 32 + 16 * s2 + 4 * hh;
#pragma unroll
                    for (int dt = 0; dt < 4; ++dt) {
                        LAS unsigned char* ad = Vs + (R0 + q_) * VROW + (dt * 32 + 16 * cg16 + 4 * p_) * 2;
                        const s16x4 lo = __builtin_amdgcn_ds_read_tr16_b64_v4i16((LAS s16x4*)ad), hi = __builtin_amdgcn_ds_read_tr16_b64_v4i16((LAS s16x4*)(ad + 8 * VROW));
                        bf16x8 a; a[0] = lo[0]; a[1] = lo[1]; a[2] = lo[2]; a[3] = lo[3]; a[4] = hi[0]; a[5] = hi[1]; a[6] = hi[2]; a[7] = hi[3];
                        O[dt] = MFMA32(a, pf, O[dt]);
                    }
                    __builtin_amdgcn_sched_barrier(0);
                }
            }
        }
        const float inv = __builtin_amdgcn_rcpf(den);
        bf16_t* op = ON + ((size_t)g * RP + qrow) * 2048 + slot * 128 + 4 * hh;
#pragma unroll
        for (int dt = 0; dt < 4; ++dt)
#pragma unroll
            for (int g4 = 0; g4 < 4; ++g4) {
                u32x2 q; q.x = pk2(O[dt][4 * g4] * inv, O[dt][4 * g4 + 1] * inv); q.y = pk2(O[dt][4 * g4 + 2] * inv, O[dt][4 * g4 + 3] * inv);
                *(u32x2*)(op + dt * 32 + 8 * g4) = q;
            }
        if (hh == 0) LSE[((size_t)g * RP + qrow) * 16 + slot] = (m + __builtin_amdgcn_logf(den)) * 0.6931471805599453f;
    }
}

__device__ __forceinline__ void sample_attn(const Params& P, LAS unsigned char* lds, int si, int lbi, int wv) {
    const KParams Pk = kparams();
    int tid = threadIdx.x; asm volatile("" : "+v"(tid));
    const int lane = tid & 63;
    unsigned char* ws = Pk->ws;
    const float* PART = (const float*)(ws + O_PART); const float* RS = (const float*)(ws + O_RS); bf16_t* ON = (bf16_t*)(ws + P_ON); float* LSE = (float*)(ws + O_LSE);
    const int b = si / 48, rem = si % 48, g = rem >> 4, slot = rem & 15, kvh = slot >> 2, r = 1 << (2 * g), lbuf = 128 << (2 * g);
    const int N = lbi == 0 ? 11264 : 8192;
    const float* state = Pk->in[4 + g]; float* skv = Pk->out + (g == 0 ? OUT_SKV0 : (g == 1 ? OUT_SKV1 : OUT_SKV2));
    LAS float* qs = (LAS float*)(lds + OFF_SW + wv * 2064); LAS float* pw = qs + 128; LAS float* kn = qs + 260; LAS float* vn = qs + 388;
#pragma unroll
    for (int e = 0; e < 2; ++e) {
        const int d = lane * 2 + e;
        qs[d] = part_sum(PART, N, b, g * 2048 + slot * 128 + d);
        float kvl, vvl;
        if (lbi == 0) { kvl = part_sum(PART, N, b, 8192 + g * 1024 + kvh * 128 + d); vvl = part_sum(PART, N, b, 8192 + g * 1024 + 512 + kvh * 128 + d);
            if ((slot & 3) == 0) { float* dst = skv + ((size_t)(b * lbuf + lbuf - 1) * 2) * 512 + kvh * 128 + d; dst[0] = kvl; dst[512] = vvl; } }
        else { const float* srcp = skv + ((size_t)(b * lbuf + lbuf - 1) * 2) * 512 + kvh * 128 + d; kvl = srcp[0]; vvl = srcp[512]; }
        kn[d] = kvl; vn[d] = vvl;
    }
    LDS_WAIT();
    const float scale = 0.08838834764831845f;
    float m = -INFINITY;
#pragma unroll 1
    for (int rd = 0; rd < 3; ++rd) {
        const int step = lane + 64 * rd; float s = -INFINITY;
        if (step <= 128) {
            float dot = 0.f;
            if (step == 0) {
#pragma unroll 8
                for (int d = 0; d < 128; ++d) dot += qs[d] * kn[d]; }
            else { const f32x4* kr = (const f32x4*)(state + ((size_t)(b * lbuf + lbuf - step * r) * 2) * 512 + kvh * 128);
                f32x4 kv[32];
#pragma unroll
                for (int d4 = 0; d4 < 32; ++d4) kv[d4] = kr[d4];
#pragma unroll
                for (int d4 = 0; d4 < 32; ++d4) { const f32x4 qv = *(const LAS f32x4*)(qs + d4 * 4); dot += (kv[d4].x * qv.x + kv[d4].y * qv.y) + (kv[d4].z * qv.z + kv[d4].w * qv.w); } }
            s = dot * scale + Pk->in[20][rel_bucket(step * r) * 48 + g * 16 + slot];
            pw[step] = s;
        }
        m = fmaxf(m, s);
    }
    m = wave_max(m);
    LDS_WAIT();
    float den = 0.f;
#pragma unroll
    for (int rd = 0; rd < 3; ++rd) { const int step = lane + 64 * rd; if (step <= 128) { const float p = __expf(pw[step] - m); den += p; pw[step] = p; } }
    den = wave_sum(den);
    LDS_WAIT();
    float o0 = pw[0] * vn[lane * 2], o1 = pw[0] * vn[lane * 2 + 1];
#pragma unroll 1
    for (int s0 = 1; s0 <= 128; s0 += 32) {
        f32x2 v[32];
#pragma unroll
        for (int j = 0; j < 32; ++j) v[j] = *(const f32x2*)(state + ((size_t)(b * lbuf + lbuf - (s0 + j) * r) * 2 + 1) * 512 + kvh * 128 + lane * 2);
#pragma unroll
        for (int j = 0; j < 32; ++j) { const float p = pw[s0 + j]; o0 += p * v[j].x; o1 += p * v[j].y; }
    }
    const float inv = 1.0f / den;
    *(unsigned*)(ON + ((size_t)g * RP + TP + b) * 2048 + slot * 128 + lane * 2) = pk2(o0 * inv, o1 * inv);
    if (lane == 0) LSE[((size_t)g * RP + TP + b) * 16 + slot] = m + __logf(den);
    LDS_WAIT();
}

__device__ __forceinline__ void combine_phase(const Params& P, int lbi) {
    const KParams Pk = kparams();
    int tid = threadIdx.x; asm volatile("" : "+v"(tid));
    const int lane = tid & 63, w = __builtin_amdgcn_readfirstlane(tid >> 6);
    const int gw = blockIdx.x * 8 + w, NGW = gridDim.x * 8;
    unsigned char* ws = Pk->ws;
    const bf16_t* ON = (const bf16_t*)(ws + P_ON); const float* LSE = (const float*)(ws + O_LSE); const bf16_t* SG2 = (const bf16_t*)(ws + O_SG2); bf16_t* OG = (bf16_t*)(ws + O_OG);
    const float* PART = (const float*)(ws + O_PART); const float* RS = (const float*)(ws + O_RS);
    const int N = lbi == 0 ? 11264 : 8192;
    for (int row = gw; row < TP + 8; row += NGW) {
#pragma unroll
        for (int cch = 0; cch < 4; ++cch) {
            const int col = cch * 512 + lane * 8, slot = col >> 7;
            const float l0 = LSE[((size_t)0 * RP + row) * 16 + slot], l1 = LSE[((size_t)1 * RP + row) * 16 + slot], l2 = LSE[((size_t)2 * RP + row) * 16 + slot];
            const float mx = fmaxf(l0, fmaxf(l1, l2)); float w0 = __expf(l0 - mx), w1 = __expf(l1 - mx), w2 = __expf(l2 - mx);
            const float iw = 1.0f / (w0 + w1 + w2); w0 *= iw; w1 *= iw; w2 *= iw;
            const u32x4 a0 = *(const u32x4*)(ON + ((size_t)0 * RP + row) * 2048 + col), a1 = *(const u32x4*)(ON + ((size_t)1 * RP + row) * 2048 + col), a2 = *(const u32x4*)(ON + ((size_t)2 * RP + row) * 2048 + col);
            float gt[8];
            if (row < TP) { const u32x4 sv = *(const u32x4*)(SG2 + (size_t)row * 2048 + col);
                gt[0] = bflo(sv.x); gt[1] = bfhi(sv.x); gt[2] = bflo(sv.y); gt[3] = bfhi(sv.y); gt[4] = bflo(sv.z); gt[5] = bfhi(sv.z); gt[6] = bflo(sv.w); gt[7] = bfhi(sv.w); }
            else { const int b = row - TP;
#pragma unroll
                for (int e = 0; e < 8; ++e) gt[e] = silu_f(part_sum(PART, N, b, 6144 + col + e)); }
            float o[8];
            o[0] = w0 * bflo(a0.x) + w1 * bflo(a1.x) + w2 * bflo(a2.x); o[1] = w0 * bfhi(a0.x) + w1 * bfhi(a1.x) + w2 * bfhi(a2.x);
            o[2] = w0 * bflo(a0.y) + w1 * bflo(a1.y) + w2 * bflo(a2.y); o[3] = w0 * bfhi(a0.y) + w1 * bfhi(a1.y) + w2 * bfhi(a2.y);
            o[4] = w0 * bflo(a0.z) + w1 * bflo(a1.z) + w2 * bflo(a2.z); o[5] = w0 * bfhi(a0.z) + w1 * bfhi(a1.z) + w2 * bfhi(a2.z);
            o[6] = w0 * bflo(a0.w) + w1 * bflo(a1.w) + w2 * bflo(a2.w); o[7] = w0 * bfhi(a0.w) + w1 * bfhi(a1.w) + w2 * bfhi(a2.w);
            u32x4 q; q.x = pk2(o[0] * gt[0], o[1] * gt[1]); q.y = pk2(o[2] * gt[2], o[3] * gt[3]); q.z = pk2(o[4] * gt[4], o[5] * gt[5]); q.w = pk2(o[6] * gt[6], o[7] * gt[7]);
            *(u32x4*)(OG + (size_t)row * 2048 + col) = q;
        }
    }
}

__global__ __launch_bounds__(512, 2) void yoco_mega(Params P) {
    extern __shared__ __attribute__((aligned(16))) unsigned char shm[];
    LAS unsigned char* lds = (LAS unsigned char*)shm;
    cg::grid_group grid = cg::this_grid();
    const KParams Pk = kparams();
    unsigned char* ws = Pk->ws;
    const int w = threadIdx.x >> 6;
    if (threadIdx.x == 0) { *(LAS u32x4*)(lds + OFF_XB) = (u32x4){0u, 0u, 0u, 0u}; }
    __syncthreads();
    const XcdBarrier xb = xcd_barrier_post((unsigned*)(ws + O_BAR), (volatile LAS unsigned*)(lds + OFF_XB));
    prep_phase(P, lds);
    convert_work(P, lds, 0, N_PREP_ITEMS, false, (int)blockIdx.x, (int)gridDim.x);
    grid.sync();
    for (int L = 0; L < 4; ++L) {
        for (int half = 0; half < 2; ++half) {
            pg8::Gemm gm; Epi E; gm.M = TP;
            E.rs = (const float*)(ws + O_RS); E.ssqp = (float*)(ws + O_SSQP); E.outp = Pk->out; E.o2 = (bf16_t*)(ws + O_KVB);
            if (half == 0) {
                gm.A = (const bf16_t*)(ws + O_XBF); gm.K = 4096;
                if (L < 2) { gm.Bt = (const bf16_t*)(ws + O_BT1) + (size_t)L * 8192 * 4096; gm.N = 8192; E.mode = 0; E.o0 = (bf16_t*)(ws + P_XB); E.o1 = (bf16_t*)(ws + P_SG); }
                else { gm.Bt = (const bf16_t*)(ws + (L == 2 ? O_BT3 : O_BT4)); gm.N = L == 2 ? 11264 : 8192; E.mode = 2; E.o0 = (bf16_t*)(ws + P_Q); E.o1 = (bf16_t*)(ws + O_SG2); }
            } else {
                E.mode = 1; E.o0 = (bf16_t*)(ws + O_Y); E.o1 = E.o0; gm.N = 4096;
                if (L < 2) { gm.A = (const bf16_t*)(ws + P_HG); gm.Bt = (const bf16_t*)(ws + O_BT2) + (size_t)L * 4096 * 4096; gm.K = 4096; }
                else { gm.A = (const bf16_t*)(ws + O_OG); gm.Bt = (const bf16_t*)(ws + O_BT5) + (size_t)(L - 2) * 4096 * 2048; gm.K = 2048; }
            }
            pg8::StaticOrder S; S.init(gm.M, gm.N, (int)gridDim.x, (int)blockIdx.x);
            pg8::gemm_phase<Epi, pg8::StaticOrder, false>(lds, gm, S, E, nullptr);
            if (L == 2 && half == 0) {
                const int nwg = (gm.M / 256) * (gm.N / 256), G = (int)gridDim.x, fi = nwg - ((nwg - 1) / G) * G;
                int vb = (int)blockIdx.x, nvb = G;
                if (fi < G) { vb = (int)blockIdx.x - fi; nvb = vb >= 0 ? G - fi : 0; }
                __syncthreads();
                if (nvb > 0) convert_work(P, lds, N_PREP_ITEMS, N_ALL_ITEMS, true, vb, nvb);
            }
            __syncthreads();
            if (gm.K == 4096) skinny_phase<16>(gm.A + (size_t)TP * gm.K, gm.Bt, gm.N, gm.K, (float*)(ws + O_PART), lds);
            else skinny_phase<8>(gm.A + (size_t)TP * gm.K, gm.Bt, gm.N, gm.K, (float*)(ws + O_PART), lds);
            xcd_barrier(xb);
            if (half == 0) {
                if (L < 2) {
                    scan_phase(P, lds, L);
                } else {
                    for (int wv = 0; wv < 2; ++wv) { const int si = wv * 256 + (int)blockIdx.x; if (si < 384 && w == wv && gridDim.x >= 256) sample_attn(P, lds, si, L - 2, wv); }
                    if (gridDim.x < 256 && w < 2) for (int si = blockIdx.x * 2 + w; si < 384; si += gridDim.x * 2) sample_attn(P, lds, si, L - 2, w);
                    for (int it = blockIdx.x; it < 768; it += gridDim.x) attn_item(P, lds, it);
                    xcd_barrier(xb);
                    combine_phase(P, L - 2);
                }
            } else {
                post_phase(P, L);
            }
            if (!(L == 3 && half == 1)) xcd_barrier(xb);
        }
    }
}

extern "C" void kernel_launch(void* const* d_in, const int* in_sizes, int n_in, void* d_out, int out_size, void* d_ws, size_t ws_size, hipStream_t stream) {
    static int grid_blocks = 0;
    if (!grid_blocks) {
        int dev = 0, cus = 0, per_cu = 0;
        hipGetDevice(&dev);
        hipDeviceGetAttribute(&cus, hipDeviceAttributeMultiprocessorCount, dev);
        hipFuncSetAttribute((const void*)yoco_mega, hipFuncAttributeMaxDynamicSharedMemorySize, LDS_BYTES);
        if (hipOccupancyMaxActiveBlocksPerMultiprocessor(&per_cu, (const void*)yoco_mega, 512, LDS_BYTES) != hipSuccess || per_cu < 1) per_cu = 1;
        (void)hipGetLastError();
        grid_blocks = cus * per_cu;
        if (ws_size < O_END) fprintf(stderr, "kernel_launch: workspace too small: %zu < %zu\n", ws_size, (size_t)O_END);
    }
    (void)hipMemsetAsync((unsigned char*)d_ws + O_BAR, 0, XCD_BAR_WORDS * sizeof(unsigned), stream);
    Params p{};
    for (int i = 0; i < 25; ++i) p.in[i] = (const float*)d_in[i];
    p.out = (float*)d_out; p.ws = (unsigned char*)d_ws;
    void* args[] = {&p};
    hipError_t e = hipLaunchCooperativeKernel((const void*)yoco_mega, dim3(grid_blocks), dim3(512), args, LDS_BYTES, stream);
    if (e != hipSuccess) fprintf(stderr, "cooperative launch failed: %s (grid %d)\n", hipGetErrorString(e), grid_blocks);
}
```

```cpp
#include <hip/hip_runtime.h>
#include <hip/hip_cooperative_groups.h>
#include <cstdio>
namespace cg = cooperative_groups;

namespace pg8 {
#define PG8_LAS __attribute__((address_space(3)))
typedef unsigned short bf16_t;
typedef short bf16x8 __attribute__((ext_vector_type(8)));
typedef float f32x4 __attribute__((ext_vector_type(4)));
typedef unsigned u32x4 __attribute__((ext_vector_type(4)));
constexpr int BM = 256, BK = 64, HALF = 128, HTB = HALF * BK * 2, STAGE_BYTES = 8 * HTB, NXCD = 8, WGM = 8;

__host__ __device__ __forceinline__ int lds_byte(int r, int c) { const int st = (r >> 4) * 2 + (c >> 5), rr = r & 15, cc = c & 31, ob = rr * 64 + cc * 2; return st * 1024 + (ob ^ (((ob >> 9) & 1) << 5)); }
__host__ __device__ __forceinline__ void stage_rc(int b, int& R, int& C) { const int st = b / 1024, sb = b % 1024, swz = sb ^ (((sb >> 9) & 1) << 5); R = (st >> 1) * 16 + swz / 64; C = (st & 1) * 32 + (swz % 64) / 2; }
__host__ __device__ __forceinline__ int perm32(int rho) { const int n = rho >> 4, i = rho & 15; return 8 * (i >> 2) + 4 * n + (i & 3); }

struct Unit { int pm, pn; };
struct Gemm { const bf16_t* A; const bf16_t* Bt; int M, N, K; };

struct StaticOrder {
    int nM, nN, nwg, G, c;
    __host__ __device__ void init(int M, int N, int G_, int c_) { nM = M / BM; nN = N / BM; nwg = nM * nN; G = G_; c = c_; }
    __host__ __device__ bool next(int i, Unit& u) const {
        const long L = (long)i * G + c; if (L >= nwg) return false;
        int wgid = (int)L; { const int q = nwg / NXCD, r = nwg % NXCD, xcd = wgid % NXCD, off = wgid / NXCD; wgid = (xcd < r ? xcd * (q + 1) : r * (q + 1) + (xcd - r) * q) + off; }
        const int nig = WGM * nN, gid = wgid / nig, fm = gid * WGM, gsz = (nM - fm) < WGM ? (nM - fm) : WGM;
        u.pm = fm + ((wgid % nig) % gsz); u.pn = (wgid % nig) / gsz; return true;
    }
    __device__ __forceinline__ void a_ready(const Unit&) const {}
    __device__ __forceinline__ void done(const Unit&) const {}
};
template <class Epi, class Sched, bool STAMP = false>
__device__ __forceinline__ void gemm_phase(PG8_LAS unsigned char* lds, const Gemm g, const Sched& S, const Epi& E, unsigned long long* stamps) {
    int tid = threadIdx.x; asm volatile("" : "+v"(tid));
    const int wid = __builtin_amdgcn_readfirstlane(tid >> 6), lane = tid & 63, wr = wid >> 2, wc = wid & 3, fr = lane & 15, fq = lane >> 4;
    const int K = g.K, nt = K / BK;
    int ts_lo = 0, ts_hi = 0, nts = 0; const unsigned long long rt_entry = STAMP ? (unsigned long long)wall_clock64() : 0ull;
#define PG8_STAMP() do { if (STAMP && wid == 0 && nts < 64) { const unsigned long long _c = (unsigned long long)clock64(); \
        ts_lo = (lane == nts) ? (int)(unsigned)_c : ts_lo; ts_hi = (lane == nts) ? (int)(unsigned)(_c >> 32) : ts_hi; ++nts; } } while (0)
    PG8_STAMP();
    unsigned voffA[2], voffB[2];
#pragma unroll
    for (int i = 0; i < 2; ++i) { int R, C; stage_rc(tid * 16 + i * 8192, R, C); const int Rb = Epi::PERM ? ((R & ~31) + perm32(R & 31)) : R;
        voffA[i] = (unsigned)(R * K + C) * 2u; voffB[i] = (unsigned)(Rb * K + C) * 2u; }
    const size_t kstep = (size_t)(BK * 2);
    const size_t hstep = (size_t)HALF * K * 2;
    const size_t tstep = 2 * hstep;
    const unsigned ldsw = (unsigned)wid * 1024u;
    const int aoff = lds_byte(wr * 64 + fr, fq * 8), boff = lds_byte(wc * 32 + fr, fq * 8);
#define PG8_SA(b, h) (((b) * 2 + (h)) * HTB)
#define PG8_SB(b, h) ((4 + (b) * 2 + (h)) * HTB)
#define PG8_STAGE(bufoff, gbase, voff) do { _Pragma("unroll") for (int _i = 0; _i < 2; ++_i) \
        __builtin_amdgcn_global_load_lds((const unsigned*)((const char*)(gbase) + (voff)[_i]), (PG8_LAS unsigned*)(lds + (bufoff) + ldsw + _i * 8192), 16, 0, 0); } while (0)
#define PG8_LDA(dst, b, h) do { _Pragma("unroll") for (int m = 0; m < 4; ++m) _Pragma("unroll") for (int k = 0; k < 2; ++k) dst[m][k] = *(const PG8_LAS bf16x8*)(lds + PG8_SA(b, h) + aoff + m * 2048 + k * 1024); } while (0)
#define PG8_LDB(dst, b, h) do { _Pragma("unroll") for (int n = 0; n < 2; ++n) _Pragma("unroll") for (int k = 0; k < 2; ++k) dst[n][k] = *(const PG8_LAS bf16x8*)(lds + PG8_SB(b, h) + boff + n * 2048 + k * 1024); } while (0)
#define PG8_MMA(ai, bj, At, Bt) do { __builtin_amdgcn_s_setprio(1); _Pragma("unroll") for (int m = 0; m < 4; ++m) _Pragma("unroll") for (int n = 0; n < 2; ++n) _Pragma("unroll") for (int k = 0; k < 2; ++k) \
        acc[ai][bj][m][n] = __builtin_amdgcn_mfma_f32_16x16x32_bf16(Bt[n][k], At[m][k], acc[ai][bj][m][n], 0, 0, 0); __builtin_amdgcn_s_setprio(0); } while (0)
#define PG8_WAIT_V(n) asm volatile("s_waitcnt vmcnt(" #n ")" ::: "memory")
#define PG8_WAIT_L(n) asm volatile("s_waitcnt lgkmcnt(" #n ")" ::: "memory")
#define PG8_BAR __builtin_amdgcn_s_barrier()
#define PG8_SCHED __builtin_amdgcn_sched_barrier(0)
    Unit cur, nxt; int ui = 0;
    if (!S.next(0, cur)) return;
    f32x4 acc[2][2][4][2];
#pragma unroll
    for (int a = 0; a < 2; ++a)
#pragma unroll
        for (int b = 0; b < 2; ++b)
#pragma unroll
            for (int m = 0; m < 4; ++m)
#pragma unroll
                for (int n = 0; n < 2; ++n) acc[a][b][m][n] = (f32x4){0.f, 0.f, 0.f, 0.f};
    bf16x8 At[4][2], B0[2][2], B1[2][2];
    const char* cA = (const char*)g.A + (size_t)cur.pm * tstep; const char* cB = (const char*)g.Bt + (size_t)cur.pn * tstep;
    S.a_ready(cur);
    PG8_STAGE(PG8_SB(0, 0), cB, voffB); PG8_STAGE(PG8_SB(0, 1), cB + hstep, voffB); PG8_STAGE(PG8_SA(0, 0), cA, voffA); PG8_STAGE(PG8_SA(0, 1), cA + hstep, voffA);
    if (wr == 1) PG8_BAR;
    PG8_WAIT_V(2); PG8_BAR;
    PG8_STAGE(PG8_SB(1, 0), cB + kstep, voffB); PG8_STAGE(PG8_SA(1, 0), cA + kstep, voffA); PG8_STAGE(PG8_SB(1, 1), cB + hstep + kstep, voffB);
    PG8_WAIT_V(6); PG8_BAR;
    PG8_STAMP();
    for (;;) {
        const bool has_next = S.next(ui + 1, nxt);
        const char* nA = has_next ? (const char*)g.A + (size_t)nxt.pm * tstep : cA; const char* nB = has_next ? (const char*)g.Bt + (size_t)nxt.pn * tstep : cB;
        for (int t = 0; t < nt; t += 2) {
            const bool last = (t == nt - 2);
            const char* a1 = cA + (size_t)(t + 1) * kstep;
            const char* a2 = last ? nA : cA + (size_t)(t + 2) * kstep; const char* b2 = last ? nB : cB + (size_t)(t + 2) * kstep;
            const char* a3 = a2 + kstep; const char* b3 = b2 + kstep;
            if (last && has_next) S.a_ready(nxt);
            PG8_LDB(B0, 0, 0); PG8_LDB(B1, 0, 1); PG8_SCHED; PG8_LDA(At, 0, 0); PG8_STAGE(PG8_SA(1, 1), a1 + hstep, voffA);
            PG8_WAIT_V(8); PG8_WAIT_L(0); PG8_BAR; PG8_MMA(0, 0, At, B0); PG8_MMA(0, 1, At, B1); PG8_BAR; PG8_SCHED;
            PG8_LDA(At, 0, 1); PG8_STAGE(PG8_SB(0, 0), b2, voffB); PG8_STAGE(PG8_SB(0, 1), b2 + hstep, voffB); PG8_STAGE(PG8_SA(0, 0), a2, voffA);
            PG8_WAIT_V(8); PG8_WAIT_L(0); PG8_BAR; PG8_MMA(1, 0, At, B0); PG8_MMA(1, 1, At, B1); PG8_BAR; PG8_SCHED;
            PG8_LDB(B0, 1, 0); PG8_LDB(B1, 1, 1); PG8_SCHED; PG8_LDA(At, 1, 0); PG8_STAGE(PG8_SA(0, 1), a2 + hstep, voffA);
            PG8_WAIT_V(8); PG8_WAIT_L(0); PG8_BAR; PG8_MMA(0, 0, At, B0); PG8_MMA(0, 1, At, B1); PG8_BAR; PG8_SCHED;
            PG8_LDA(At, 1, 1); PG8_STAGE(PG8_SB(1, 0), b3, voffB); PG8_STAGE(PG8_SB(1, 1), b3 + hstep, voffB); PG8_STAGE(PG8_SA(1, 0), a3, voffA);
            PG8_WAIT_V(8); PG8_WAIT_L(0); PG8_BAR; PG8_MMA(1, 0, At, B0); PG8_MMA(1, 1, At, B1); PG8_BAR; PG8_SCHED;
        }
        PG8_STAMP();
        if (wr == 0) PG8_BAR;
        if constexpr (!Epi::AFTER_DRAIN) { E(acc, cur, wr, wc, fr, fq); S.done(cur); }
        PG8_STAMP();
        if (!has_next) break;
#pragma unroll
        for (int a = 0; a < 2; ++a)
#pragma unroll
            for (int b = 0; b < 2; ++b)
#pragma unroll
                for (int m = 0; m < 4; ++m)
#pragma unroll
                    for (int n = 0; n < 2; ++n) acc[a][b][m][n] = (f32x4){0.f, 0.f, 0.f, 0.f};
        cur = nxt; cA = nA; cB = nB; ++ui;
        if (wr == 1) PG8_BAR;
    }
    PG8_WAIT_V(0);
    PG8_BAR;
    if constexpr (Epi::AFTER_DRAIN) { E.fused(acc, cur, wr, wc, fr, fq, lds, wid, lane); S.done(cur); }
    PG8_STAMP();
    if (STAMP && wid == 0) { stamps[lane] = lane < nts ? (((unsigned long long)(unsigned)ts_hi << 32) | (unsigned)ts_lo) : 0ull;
        if (lane == 62) stamps[62] = rt_entry; if (lane == 63) stamps[63] = (unsigned long long)wall_clock64(); }
#undef PG8_STAMP
#undef PG8_SA
#undef PG8_SB
#undef PG8_STAGE
#undef PG8_LDA
#undef PG8_LDB
#undef PG8_MMA
#undef PG8_WAIT_V
#undef PG8_WAIT_L
#undef PG8_BAR
#undef PG8_SCHED
}}

using pg8::bf16_t; using pg8::bf16x8; using pg8::f32x4; using pg8::u32x4;
typedef short s16x4 __attribute__((ext_vector_type(4)));
typedef float f32x16 __attribute__((ext_vector_type(16)));
typedef float f32x2 __attribute__((ext_vector_type(2)));
typedef unsigned u32x2 __attribute__((ext_vector_type(2)));
typedef unsigned long long u64;
#define LAS __attribute__((address_space(3)))
#define LDS_WAIT() asm volatile("s_waitcnt lgkmcnt(0)" ::: "memory")
#define XB_TMO      128
#define XB_XCNT(j)  (256  + 64 * (j))
#define XB_XSUB(j)  (1280 + 64 * (j))
#define XB_XGEN(j)  (2304 + 64 * (j))
#define XB_TOP      3328
#define XB_TOPGEN   3392
#define XCD_BAR_WORDS 3456
#define XB_SPIN_CAP (1u << 18)

__device__ __forceinline__ unsigned xb_ld(unsigned* p)              { return __hip_atomic_load(p, __ATOMIC_RELAXED, __HIP_MEMORY_SCOPE_AGENT); }
__device__ __forceinline__ unsigned xb_add(unsigned* p, unsigned v) { return __hip_atomic_fetch_add(p, v, __ATOMIC_RELAXED, __HIP_MEMORY_SCOPE_AGENT); }
__device__ __forceinline__ unsigned xb_xcc_id() { return (unsigned)__builtin_amdgcn_s_getreg((3 << 11) | 20) & 0xFu; }
#define XB_SPIN(cond, bar) do { unsigned _sp = 0; while (cond) { __builtin_amdgcn_s_sleep(1); \
    if ((++_sp & 255u) == 0u) { if (xb_ld(&(bar)[XB_TMO])) break; if (_sp > XB_SPIN_CAP) { atomicAdd(&(bar)[XB_TMO], 1u); break; } } } } while (0)

struct XcdBarrier {
    unsigned* bar; unsigned x;
    volatile LAS unsigned* st;
};

__device__ __forceinline__ XcdBarrier xcd_barrier_post(unsigned* bar, volatile LAS unsigned* st) {
    XcdBarrier b; b.bar = bar; b.x = xb_xcc_id(); b.st = st;
    if (threadIdx.x == 0) (void)xb_add(&bar[XB_XCNT(b.x)], 1u);
    return b;
}
__device__ __forceinline__ void xcd_barrier_complete(unsigned* bar, unsigned x, unsigned& nloc, unsigned& nx) {
    const unsigned G = gridDim.x * gridDim.y * gridDim.z;
    unsigned sum, cnt, mine, sp = 0u;
    for (;;) {
        sum = 0u; cnt = 0u; mine = 0u;
#pragma unroll
        for (unsigned j = 0; j < 16; ++j) { const unsigned c = xb_ld(&bar[XB_XCNT(j)]); sum += c; cnt += (c > 0u) ? 1u : 0u; mine = (j == x) ? c : mine; }
        if (sum == G) break;
        __builtin_amdgcn_s_sleep(1);
        if ((++sp & 255u) == 0u) { if (xb_ld(&bar[XB_TMO])) break; if (sp > XB_SPIN_CAP) { atomicAdd(&bar[XB_TMO], 1u); break; } }
    }
    nloc = mine > 0u ? mine : 1u; nx = cnt > 0u ? cnt : 1u;
}

__device__ __forceinline__ void xcd_barrier(const XcdBarrier& b) {
    asm volatile("s_waitcnt vmcnt(0)" ::: "memory");
    __syncthreads();
    if (threadIdx.x == 0) {
        unsigned* bar = b.bar;
        __builtin_amdgcn_s_waitcnt(0);
        unsigned nloc = b.st[0], nx = b.st[1];
        if (nloc == 0u) { xcd_barrier_complete(bar, b.x, nloc, nx); b.st[0] = nloc; b.st[1] = nx; }
        const unsigned old = xb_add(&bar[XB_XSUB(b.x)], 1u);
        const unsigned gen = old / nloc;
        if (old + 1u == (gen + 1u) * nloc) {
            __builtin_amdgcn_fence(__ATOMIC_RELEASE, "agent");
            asm volatile("s_waitcnt vmcnt(0)" ::: "memory");
            const unsigned og = xb_add(&bar[XB_TOP], 1u);
            const unsigned tg = og / nx;
            if (og + 1u == (tg + 1u) * nx) xb_add(&bar[XB_TOPGEN], 1u);
            else XB_SPIN(xb_ld(&bar[XB_TOPGEN]) == tg, bar);
            __builtin_amdgcn_fence(__ATOMIC_ACQUIRE, "agent");
            xb_add(&bar[XB_XGEN(b.x)], 1u);
            asm volatile("s_waitcnt vmcnt(0)" ::: "memory");
        } else {
            XB_SPIN(xb_ld(&bar[XB_XGEN(b.x)]) == gen, bar);
            __builtin_amdgcn_fence(__ATOMIC_ACQUIRE, "agent");
            asm volatile("s_waitcnt vmcnt(0)" ::: "memory");
        }
    }
    __syncthreads();
}


constexpr int DM = 4096, SEQ = 2048, TP = 8192, RP = 8448;
constexpr size_t MiB = (size_t)1 << 20;
constexpr size_t O_BT1 = 0, O_BT2 = O_BT1 + 128 * MiB, O_BT3 = O_BT2 + 64 * MiB, O_BT4 = O_BT3 + 88 * MiB, O_BT5 = O_BT4 + 64 * MiB, O_WG = O_BT5 + 32 * MiB,
                 O_XBF = O_WG + 8 * MiB, O_POOL = O_XBF + 66 * MiB, O_Y = O_POOL + 198 * MiB, O_SG2 = O_Y + 66 * MiB, O_OG = O_SG2 + 33 * MiB, O_KVB = O_OG + 33 * MiB,
                 O_RS = O_KVB + 48 * MiB, O_SSQP = O_RS + 1 * MiB, O_LSE = O_SSQP + 2 * MiB, O_GRAN = O_LSE + 2 * MiB, O_PART = O_GRAN + 8 * MiB, O_BAR = O_PART + 3 * MiB, O_END = O_BAR + 1 * MiB;
constexpr size_t P_XB = O_POOL, P_SG = O_POOL + 66 * MiB, P_HG = O_POOL + 132 * MiB, P_Q = O_POOL, P_ON = O_POOL + 99 * MiB;
constexpr size_t OUT_YP = 0, OUT_YS = 33554432, OUT_PCONV = OUT_YS + 32768, OUT_PH = OUT_PCONV + 98304, OUT_PKV0 = OUT_PH + 32768, OUT_PKV1 = OUT_PKV0 + 524288, OUT_PKV2 = OUT_PKV1 + 2097152,
                 OUT_SCONV = OUT_PKV2 + 8388608, OUT_SH = OUT_SCONV + 196608, OUT_SKV0 = OUT_SH + 65536, OUT_SKV1 = OUT_SKV0 + 1048576, OUT_SKV2 = OUT_SKV1 + 4194304;
constexpr int LDS_BYTES = 159744, OFF_XB = 157824;
constexpr float EPSN = 1e-6f;

struct Params { const float* in[25]; float* out; unsigned char* ws; };
typedef const Params __attribute__((address_space(4))) * KParams;
__device__ __forceinline__ KParams kparams() { KParams p = (KParams)__builtin_amdgcn_kernarg_segment_ptr(); asm volatile("" : "+s"(p)); return p; }
#define PLOCAL const KParams Pk = kparams(); (void)P;


__device__ __forceinline__ unsigned pk2(float a, float b) { typedef __bf16 bf2 __attribute__((ext_vector_type(2))); bf2 v; v[0] = (__bf16)a; v[1] = (__bf16)b; return __builtin_bit_cast(unsigned, v); }
__device__ __forceinline__ float bflo(unsigned u) { return __uint_as_float(u << 16); }
__device__ __forceinline__ float bfhi(unsigned u) { return __uint_as_float(u & 0xffff0000u); }
__device__ __forceinline__ float bf2f(bf16_t h) { return __uint_as_float(((unsigned)h) << 16); }
__device__ __forceinline__ float silu_f(float v) { return v * __builtin_amdgcn_rcpf(1.0f + __expf(-v)); }
__device__ __forceinline__ float sigm_f(float v) { return __builtin_amdgcn_rcpf(1.0f + __expf(-v)); }
__device__ __forceinline__ float wave_sum(float v) {
#pragma unroll
    for (int o = 1; o < 64; o <<= 1) v += __shfl_xor(v, o);
    return v;
}
__device__ __forceinline__ float wave_max(float v) {
#pragma unroll
    for (int o = 1; o < 64; o <<= 1) v = fmaxf(v, __shfl_xor(v, o));
    return v;
}
__device__ __forceinline__ int crow(int reg, int h) { return (reg & 3) + 8 * (reg >> 2) + 4 * h; }
__device__ __forceinline__ int rel_bucket(int dd) {
    if (dd < 16) return dd;
    const float d = (float)dd;
    int large = 16 + (int)(logf(d * (1.0f / 16.0f)) / logf(128.0f) * 16.0f);
    return large < 31 ? large : 31;
}
#define MFMA32(a, b, c) __builtin_amdgcn_mfma_f32_32x32x16_bf16((a), (b), (c), 0, 0, 0)

struct Epi {
    static constexpr bool PERM = true, AFTER_DRAIN = false;
    int mode;
    const float* rs; bf16_t* o0; bf16_t* o1; bf16_t* o2; float* ssqp; float* outp;
    __device__ __forceinline__ void operator()(const f32x4 (&acc)[2][2][4][2], const pg8::Unit& u, int wr, int wc, int fr, int fq) const {
        const int row0 = u.pm * 256 + wr * 64 + fr, colt = u.pn * 256, cw = wc * 32 + 8 * fq;
        if (mode == 1) {
#pragma unroll
            for (int ai = 0; ai < 2; ++ai)
#pragma unroll
                for (int m = 0; m < 4; ++m) {
                    const int row = row0 + ai * 128 + m * 16; float ss = 0.f;
#pragma unroll
                    for (int bj = 0; bj < 2; ++bj) {
                        const f32x4 v0 = acc[ai][bj][m][0], v1 = acc[ai][bj][m][1];
                        ss += (v0[0] * v0[0] + v0[1] * v0[1]) + (v0[2] * v0[2] + v0[3] * v0[3]) + (v1[0] * v1[0] + v1[1] * v1[1]) + (v1[2] * v1[2] + v1[3] * v1[3]);
                        u32x4 w; w.x = pk2(v0[0], v0[1]); w.y = pk2(v0[2], v0[3]); w.z = pk2(v1[0], v1[1]); w.w = pk2(v1[2], v1[3]);
                        *(u32x4*)(o0 + (size_t)row * 4096 + colt + bj * 128 + cw) = w;
                    }
                    ss += __shfl_xor(ss, 16); ss += __shfl_xor(ss, 32);
                    if (fq == 0) ssqp[(size_t)row * 64 + u.pn * 4 + wc] = ss;
                }
            return;
        }
        bf16_t* dst; int ld, col; bool act = false, kv = false;
        if (mode == 0) { ld = 4096; if (colt < 4096) { dst = o0; col = colt; } else { dst = o1; col = colt - 4096; act = true; } }
        else { if (colt < 6144) { dst = o0; ld = 6144; col = colt; } else if (colt < 8192) { dst = o1; ld = 2048; col = colt - 6144; act = true; } else { dst = o2; ld = 3072; col = colt - 8192; kv = true; } }
#pragma unroll
        for (int ai = 0; ai < 2; ++ai)
#pragma unroll
            for (int m = 0; m < 4; ++m) {
                const int row = row0 + ai * 128 + m * 16;
#pragma unroll
                for (int bj = 0; bj < 2; ++bj) {
                    f32x4 v0 = acc[ai][bj][m][0], v1 = acc[ai][bj][m][1];
                    if (act) {
#pragma unroll
                        for (int j = 0; j < 4; ++j) { v0[j] = silu_f(v0[j]); v1[j] = silu_f(v1[j]); }
                    }
                    u32x4 w; w.x = pk2(v0[0], v0[1]); w.y = pk2(v0[2], v0[3]); w.z = pk2(v1[0], v1[1]); w.w = pk2(v1[2], v1[3]);
                    const int cc = col + bj * 128 + cw;
                    *(u32x4*)(dst + (size_t)row * ld + cc) = w;
                    if (kv) {
                        const int g = cc >> 10, rem = cc & 1023, keep = 128 << (2 * g), n = row >> 11, t = row & 2047;
                        if (t >= 2048 - keep) {
                            const size_t ob = (g == 0 ? OUT_PKV0 : (g == 1 ? OUT_PKV1 : OUT_PKV2)) + ((size_t)(n * keep + (t - (2048 - keep))) * 1024 + rem);
                            *(f32x4*)(outp + ob) = v0; *(f32x4*)(outp + ob + 4) = v1;
                        }
                    }
                }
            }
    }
};

constexpr int TPITCH = 144, TTILE = 128 * TPITCH;
__device__ __forceinline__ void transpose_item(const float* W, int K, int N, bf16_t* WT, const float* gain, int item, int lane, LAS unsigned char* tile) {
    const int nblk = N / 128, kb = item / nblk, nb = item % nblk, k0 = 64 * kb, n0 = 128 * nb;
    f32x2 v[64];
    const float* src = W + (size_t)k0 * N + n0 + lane * 2;
#pragma unroll
    for (int kk = 0; kk < 64; ++kk) v[kk] = __builtin_nontemporal_load((const f32x2*)(src + (size_t)kk * N));
    if (gain) {
#pragma unroll
        for (int kk = 0; kk < 64; ++kk) v[kk] = v[kk] * gain[k0 + kk];
    }
#pragma unroll
    for (int i = 0; i < 2; ++i) {
        LAS unsigned char* row = tile + (lane * 2 + i) * TPITCH;
#pragma unroll
        for (int c = 0; c < 8; ++c) {
            u32x4 o; o.x = pk2(v[8 * c][i], v[8 * c + 1][i]); o.y = pk2(v[8 * c + 2][i], v[8 * c + 3][i]); o.z = pk2(v[8 * c + 4][i], v[8 * c + 5][i]); o.w = pk2(v[8 * c + 6][i], v[8 * c + 7][i]);
            *(LAS u32x4*)(row + c * 16) = o;
        }
    }
    LDS_WAIT();
    const int chunk = lane & 7, r8 = lane >> 3;
#pragma unroll
    for (int j = 0; j < 16; ++j) {
        const int rowi = r8 + 8 * j;
        const u32x4 o = *(const LAS u32x4*)(tile + rowi * TPITCH + chunk * 16);
        *(u32x4*)(WT + (size_t)(n0 + rowi) * K + k0 + chunk * 8) = o;
    }
    LDS_WAIT();
}

constexpr int I_AIN = 64 * 64, I_AOUT = 64 * 32, I_KV = 64 * 24, I_BOUT = 32 * 32, I_G = 4 * 2;
constexpr int N_PREP_ITEMS = 2 * I_AIN + 2 * I_AOUT + I_AIN + I_KV + I_AIN + 64 * I_G, N_ALL_ITEMS = N_PREP_ITEMS + 2 * I_BOUT;
__device__ __forceinline__ void convert_work(const Params& P, LAS unsigned char* lds, int lo, int hi, bool kvcopy, int vb, int nvb) {
    const KParams Pk = kparams();
    int tid = threadIdx.x; asm volatile("" : "+v"(tid));
    const int lane = tid & 63, w = __builtin_amdgcn_readfirstlane(tid >> 6);
    const int gw = vb * 8 + w, NGW = nvb * 8;
    unsigned char* ws = Pk->ws;
    LAS unsigned char* tile = lds + w * TTILE;
    if (kvcopy) {
        for (int g = 0; g < 3; ++g) {
            const int lb = 128 << (2 * g); const size_t per = (size_t)(lb - 1) * 256, tot = 8 * per;
            const f32x4* src = (const f32x4*)Pk->in[4 + g]; f32x4* dst = (f32x4*)(Pk->out + (g == 0 ? OUT_SKV0 : (g == 1 ? OUT_SKV1 : OUT_SKV2)));
            for (size_t i = (size_t)vb * 512 + tid; i < tot; i += (size_t)nvb * 512) { const size_t b = i / per, o = i - b * per; dst[b * (size_t)lb * 256 + o] = __builtin_nontemporal_load(src + b * (size_t)lb * 256 + 256 + o); }
        }
    }
    for (int it = lo + gw; it < hi; it += NGW) {
        int r = it;
        if (r < 2 * I_AIN) { const int l = r / I_AIN; transpose_item(Pk->in[8] + (size_t)l * 4096 * 8192, 4096, 8192, (bf16_t*)(ws + O_BT1) + (size_t)l * 8192 * 4096, Pk->in[7] + l * 4096, r % I_AIN, lane, tile); continue; } r -= 2 * I_AIN;
        if (r < 2 * I_AOUT) { const int l = r / I_AOUT; transpose_item(Pk->in[16] + (size_t)l * 4096 * 4096, 4096, 4096, (bf16_t*)(ws + O_BT2) + (size_t)l * 4096 * 4096, nullptr, r % I_AOUT, lane, tile); continue; } r -= 2 * I_AOUT;
        if (r < I_AIN) { transpose_item(Pk->in[22], 4096, 8192, (bf16_t*)(ws + O_BT3), Pk->in[21], r, lane, tile); continue; } r -= I_AIN;
        if (r < I_KV) { transpose_item(Pk->in[19], 4096, 3072, (bf16_t*)(ws + O_BT3) + (size_t)8192 * 4096, Pk->in[18], r, lane, tile); continue; } r -= I_KV;
        if (r < I_AIN) { transpose_item(Pk->in[22] + (size_t)4096 * 8192, 4096, 8192, (bf16_t*)(ws + O_BT4), Pk->in[21] + 4096, r, lane, tile); continue; } r -= I_AIN;
        if (r < 64 * I_G) { const int mat = r / I_G, gate = mat & 1, lh = mat >> 1;
            transpose_item((gate ? Pk->in[13] : Pk->in[11]) + (size_t)lh * 65536, 256, 256, (bf16_t*)(ws + O_WG) + (size_t)(lh * 2 + gate) * 65536, nullptr, r % I_G, lane, tile); continue; } r -= 64 * I_G;
        { const int l = r / I_BOUT; transpose_item(Pk->in[23] + (size_t)l * 2048 * 4096, 2048, 4096, (bf16_t*)(ws + O_BT5) + (size_t)l * 4096 * 2048, nullptr, r % I_BOUT, lane, tile); }
    }
}

__device__ __forceinline__ void prep_phase(const Params& P, LAS unsigned char* lds) {
    const KParams Pk = kparams();
    int tid = threadIdx.x; asm volatile("" : "+v"(tid));
    const int lane = tid & 63, w = __builtin_amdgcn_readfirstlane(tid >> 6);
    const int gw = blockIdx.x * 8 + w, NGW = gridDim.x * 8;
    unsigned char* ws = Pk->ws;
    { u64* gr = (u64*)(ws + O_GRAN); const size_t n = (8 * MiB) / 8; for (size_t i = (size_t)blockIdx.x * 512 + tid; i < n; i += (size_t)gridDim.x * 512) gr[i] = 0ull; }
    { bf16_t* XBF = (bf16_t*)(ws + O_XBF); float* RS = (float*)(ws + O_RS);
      for (int row = gw; row < TP + 8; row += NGW) {
          const float* xr = row < TP ? Pk->in[0] + (size_t)row * DM : Pk->in[1] + (size_t)(row - TP) * DM;
          const f32x4* x4 = (const f32x4*)xr + lane; f32x4 v[16]; float s = 0.f;
#pragma unroll
          for (int j = 0; j < 16; ++j) { v[j] = x4[64 * j]; s += (v[j].x * v[j].x + v[j].y * v[j].y) + (v[j].z * v[j].z + v[j].w * v[j].w); }
          s = wave_sum(s);
          const float rs = rsqrtf(s * (1.0f / DM) + EPSN);
          u32x2* o = (u32x2*)(XBF + (size_t)row * DM) + lane;
#pragma unroll
          for (int j = 0; j < 16; ++j) { u32x2 q; q.x = pk2(v[j].x * rs, v[j].y * rs); q.y = pk2(v[j].z * rs, v[j].w * rs); o[64 * j] = q; }
          if (lane == 0) RS[row] = rs;
      } }
}

template <int KSTEPS>
__device__ __forceinline__ void skinny_phase(const bf16_t* A, const bf16_t* Bt, int N, int K, float* sout, LAS unsigned char* lds) {
    int tid = threadIdx.x; asm volatile("" : "+v"(tid));
    const int lane = tid & 63, w = __builtin_amdgcn_readfirstlane(tid >> 6), fr = lane & 15, fq = lane >> 4;
    LAS float* red = (LAS float*)lds;
    const int ngroups = N / 16, k0 = w * (KSTEPS * 32);
    for (int grp = blockIdx.x; grp < ngroups; grp += gridDim.x) {
        const int n0 = grp * 16;
        const bf16_t* ap = A + (size_t)(fr & 7) * K + k0 + fq * 8; const bf16_t* bp = Bt + (size_t)(n0 + fr) * K + k0 + fq * 8;
        bf16x8 a[KSTEPS], b[KSTEPS];
#pragma unroll
        for (int s = 0; s < KSTEPS; ++s) { b[s] = __builtin_nontemporal_load((const bf16x8*)(bp + s * 32)); a[s] = *(const bf16x8*)(ap + s * 32); }
        f32x4 acc = {0.f, 0.f, 0.f, 0.f};
#pragma unroll
        for (int s = 0; s < KSTEPS; ++s) { if (fr >= 8) a[s] = (bf16x8){0, 0, 0, 0, 0, 0, 0, 0}; acc = __builtin_amdgcn_mfma_f32_16x16x32_bf16(a[s], b[s], acc, 0, 0, 0); }
        __syncthreads();
        if (fq < 2) {
#pragma unroll
            for (int i = 0; i < 4; ++i) red[(w * 8 + fq * 4 + i) * 16 + fr] = acc[i];
        }
        __syncthreads();
        if (tid < 128) { float s = 0.f;
#pragma unroll
            for (int ww = 0; ww < 8; ++ww) s += red[ww * 128 + tid];
            sout[(size_t)(tid >> 4) * N + n0 + (tid & 15)] = s; }
    }
}
__device__ __forceinline__ float part_sum(const float* sout, int N, int b, int col) { return sout[(size_t)b * N + col]; }

constexpr int SROW = 528;
__device__ __forceinline__ void scan_phase(const Params& P, LAS unsigned char* lds, int l) {
    const KParams Pk = kparams();
    const int tid0 = threadIdx.x;
    LAS unsigned char* RAW = lds;
    LAS unsigned char* AT = lds + 69632;
    unsigned char* ws = Pk->ws;
    const bf16_t* XB = (const bf16_t*)(ws + P_XB); const bf16_t* SG = (const bf16_t*)(ws + P_SG); bf16_t* HG = (bf16_t*)(ws + P_HG);
    const float* SOUT = (const float*)(ws + O_PART); const float* RS = (const float*)(ws + O_RS);
    const float* cwp = Pk->in[9] + (size_t)l * 4 * 4096; const float* cbp = Pk->in[10] + (size_t)l * 4096;
    bf16x8 bR[8], bI[8]; int cur = -1;
    for (int t = blockIdx.x; t < 32 + 2048; t += gridDim.x) {
        int tid = tid0; asm volatile("" : "+v"(tid));
        const int lane = tid & 63, w = __builtin_amdgcn_readfirstlane(tid >> 6), fr = lane & 15, fq = lane >> 4;
        const bool is_s = t < 32;
        int hh2, n = 0, sp = 0;
        if (is_s) hh2 = t; else { const int idx = t - 32; hh2 = idx & 31; n = (idx >> 5) & 3; sp = idx >> 7; }
        const int head = hh2 >> 1, half = hh2 & 1, gc0 = head * 256, hc = half * 128 + w * 16 + fr, gch = gc0 + hc, r0 = n * 2048 + sp * 128;
        if (hh2 != cur) {
            const bf16_t* wp = (const bf16_t*)(ws + O_WG) + (size_t)((l * 16 + head) * 2) * 65536 + (size_t)hc * 256 + fq * 8;
#pragma unroll
            for (int ks = 0; ks < 8; ++ks) { bR[ks] = *(const bf16x8*)(wp + ks * 32); bI[ks] = *(const bf16x8*)(wp + 65536 + ks * 32); }
            cur = hh2;
        }
        __syncthreads();
        if (is_s) {
            const int b = tid >> 6, ch = (tid & 63) * 4;
            float xc[4][4];
#pragma unroll
            for (int e = 0; e < 4; ++e) {
                const int gc = gc0 + ch + e;
#pragma unroll
                for (int k = 0; k < 3; ++k) xc[k][e] = Pk->in[2][((size_t)(l * 8 + b) * 3 + k) * 4096 + gc];
                xc[3][e] = SOUT[(size_t)b * 8192 + gc];
            }
            float o[4];
#pragma unroll
            for (int e = 0; e < 4; ++e) {
                const int gc = gc0 + ch + e; float v = cbp[gc];
#pragma unroll
                for (int k = 0; k < 4; ++k) v += xc[k][e] * cwp[k * 4096 + gc];
                o[e] = v;
                if (half == 0) {
#pragma unroll
                    for (int k = 0; k < 3; ++k) Pk->out[OUT_SCONV + ((size_t)(l * 8 + b) * 3 + k) * 4096 + gc] = xc[k + 1][e];
                }
            }
            u32x2 q; q.x = pk2(o[0], o[1]); q.y = pk2(o[2], o[3]);
            *(LAS u32x2*)(AT + b * SROW + ch * 2) = q;
        } else {
#pragma unroll
            for (int j = 0; j < 9; ++j) {
                const int id = tid + 512 * j, i = id >> 5, c8 = id & 31;
                if (i < 131) {
                    u32x4 v = {0u, 0u, 0u, 0u};
                    if (!(sp == 0 && i < 3)) v = *(const u32x4*)(XB + (size_t)(r0 - 3 + i) * 4096 + gc0 + c8 * 8);
                    *(LAS u32x4*)(RAW + i * SROW + c8 * 16) = v;
                }
            }
            __syncthreads();
            const int c8 = tid & 31; float wk[4][8], bb[8];
#pragma unroll
            for (int e = 0; e < 8; ++e) { bb[e] = cbp[gc0 + c8 * 8 + e];
#pragma unroll
                for (int k = 0; k < 4; ++k) wk[k][e] = cwp[k * 4096 + gc0 + c8 * 8 + e]; }
#pragma unroll
            for (int j = 0; j < 8; ++j) {
                const int i = (tid >> 5) + 16 * j;
                float o[8];
#pragma unroll
                for (int e = 0; e < 8; ++e) o[e] = bb[e];
                u32x4 last;
#pragma unroll
                for (int k = 0; k < 4; ++k) {
                    const u32x4 v = *(const LAS u32x4*)(RAW + (i + k) * SROW + c8 * 16); last = v;
                    o[0] += bflo(v.x) * wk[k][0]; o[1] += bfhi(v.x) * wk[k][1]; o[2] += bflo(v.y) * wk[k][2]; o[3] += bfhi(v.y) * wk[k][3];
                    o[4] += bflo(v.z) * wk[k][4]; o[5] += bfhi(v.z) * wk[k][5]; o[6] += bflo(v.w) * wk[k][6]; o[7] += bfhi(v.w) * wk[k][7];
                }
                u32x4 q; q.x = pk2(o[0], o[1]); q.y = pk2(o[2], o[3]); q.z = pk2(o[4], o[5]); q.w = pk2(o[6], o[7]);
                *(LAS u32x4*)(AT + i * SROW + c8 * 16) = q;
                if (sp == 15 && i >= 125 && half == 0) {
                    float* d = Pk->out + OUT_PCONV + ((size_t)(l * 4 + n) * 3 + (i - 125)) * 4096 + gc0 + c8 * 8;
                    f32x4 a = {bflo(last.x), bfhi(last.x), bflo(last.y), bfhi(last.y)}, b = {bflo(last.z), bfhi(last.z), bflo(last.w), bfhi(last.w)};
                    *(f32x4*)d = a; *(f32x4*)(d + 4) = b;
                }
            }
        }
        __syncthreads();
        f32x4 aR[8], aI[8];
#pragma unroll
        for (int mt = 0; mt < 8; ++mt) { aR[mt] = (f32x4){0.f, 0.f, 0.f, 0.f}; aI[mt] = (f32x4){0.f, 0.f, 0.f, 0.f}; }
#pragma unroll
        for (int ks = 0; ks < 8; ++ks) {
#pragma unroll
            for (int mt = 0; mt < 8; ++mt) {
                const bf16x8 a = *(const LAS bf16x8*)(AT + (mt * 16 + fr) * SROW + (ks * 32 + fq * 8) * 2);
                aR[mt] = __builtin_amdgcn_mfma_f32_16x16x32_bf16(a, bR[ks], aR[mt], 0, 0, 0);
                aI[mt] = __builtin_amdgcn_mfma_f32_16x16x32_bf16(a, bI[ks], aI[mt], 0, 0, 0);
            }
            __builtin_amdgcn_sched_barrier(0);
        }
        const float bga = Pk->in[12][(size_t)l * 4096 + gch], bgx = Pk->in[14][(size_t)l * 4096 + gch];
        const float lamc = -8.0f * log1pf(expf(-Pk->in[15][(size_t)l * 4096 + gch]));
#pragma unroll
        for (int mt = 0; mt < 8; ++mt)
#pragma unroll
            for (int i = 0; i < 4; ++i) {
                const int row = mt * 16 + 4 * fq + i;
                const float r = sigm_f(aR[mt][i] + bga), ig = sigm_f(aI[mt][i] + bgx);
                const float la = lamc * r, a = __expf(la);
                const float em = fmaf(-a, a, 1.0f);
                const float xf = bf2f(*(const LAS bf16_t*)(AT + row * SROW + hc * 2));
                aR[mt][i] = a; aI[mt][i] = __builtin_amdgcn_sqrtf(em) * ig * xf;
            }
        if (is_s) {
            if (fq < 2) {
#pragma unroll
                for (int i = 0; i < 4; ++i) {
                    const int b = 4 * fq + i;
                    const float h0 = Pk->in[3][(size_t)(l * 8 + b) * 4096 + gch];
                    const float h = aR[0][i] * h0 + aI[0][i];
                    Pk->out[OUT_SH + (size_t)(l * 8 + b) * 4096 + gch] = h;
                    const float sg = silu_f(SOUT[(size_t)b * 8192 + 4096 + gch]);
                    HG[(size_t)(TP + b) * 4096 + gch] = (bf16_t)(pk2(h * sg, 0.f) & 0xffffu);
                }
            }
            continue;
        }
        float Pp = 1.f, Cc = 0.f;
#pragma unroll
        for (int mt = 0; mt < 8; ++mt) {
            float A = aR[mt][0], H = aI[mt][0];
#pragma unroll
            for (int i = 1; i < 4; ++i) { const float a = aR[mt][i], b = aI[mt][i]; H = a * H + b; A = A * a; aR[mt][i] = A; aI[mt][i] = H; }
            float Pm = 1.f, Cm = 0.f;
#pragma unroll
            for (int q = 0; q < 4; ++q) {
                const float qA = __shfl(A, fr + 16 * q), qH = __shfl(H, fr + 16 * q);
                if (q == fq) { Pm = Pp; Cm = Cc; }
                Cc = qA * Cc + qH; Pp = Pp * qA;
            }
#pragma unroll
            for (int i = 0; i < 4; ++i) { aI[mt][i] += aR[mt][i] * Cm; aR[mt][i] *= Pm; }
        }
        u64* gr = (u64*)(ws + O_GRAN) + (((size_t)l * 4 + n) * 16 + sp) * 4096 + gch;
        const unsigned tag = 1u + (unsigned)l;
        float H0 = 0.f;
        if (sp > 0) {
            const u64* pg = gr - 4096; u64 x = 0; unsigned spins = 0;
            for (;;) {
                x = __hip_atomic_load(pg, __ATOMIC_RELAXED, __HIP_MEMORY_SCOPE_AGENT);
                if (__all((unsigned)(x >> 32) == tag)) break;
                if (++spins > (1u << 22)) break;
                __builtin_amdgcn_s_sleep(1);
            }
            H0 = __uint_as_float((unsigned)x);
        }
        const float hend = Cc + Pp * H0;
        if (fq == 0) {
            __hip_atomic_store(gr, ((u64)tag << 32) | (u64)__float_as_uint(hend), __ATOMIC_RELAXED, __HIP_MEMORY_SCOPE_AGENT);
            if (sp == 15) Pk->out[OUT_PH + (size_t)(l * 4 + n) * 4096 + gch] = hend;
        }
        __syncthreads();
#pragma unroll
        for (int mt = 0; mt < 8; ++mt)
#pragma unroll
            for (int i = 0; i < 4; ++i) {
                const int row = mt * 16 + 4 * fq + i;
                const float h = aI[mt][i] + aR[mt][i] * H0;
                *(LAS bf16_t*)(AT + row * SROW + hc * 2) = (bf16_t)(pk2(h, 0.f) & 0xffffu);
            }
        __syncthreads();
        {
            const int c8 = tid & 15;
#pragma unroll
            for (int j = 0; j < 4; ++j) {
                const int i = (tid >> 4) + 32 * j;
                const u32x4 hv = *(const LAS u32x4*)(AT + i * SROW + (half * 128 + c8 * 8) * 2);
                const size_t go = (size_t)(r0 + i) * 4096 + gc0 + half * 128 + c8 * 8;
                const u32x4 sv = *(const u32x4*)(SG + go);
                u32x4 q; q.x = pk2(bflo(hv.x) * bflo(sv.x), bfhi(hv.x) * bfhi(sv.x)); q.y = pk2(bflo(hv.y) * bflo(sv.y), bfhi(hv.y) * bfhi(sv.y));
                q.z = pk2(bflo(hv.z) * bflo(sv.z), bfhi(hv.z) * bfhi(sv.z)); q.w = pk2(bflo(hv.w) * bflo(sv.w), bfhi(hv.w) * bfhi(sv.w));
                *(u32x4*)(HG + go) = q;
            }
        }
    }
}

__device__ __forceinline__ void post_phase(const Params& P, int L) {
    const KParams Pk = kparams();
    int tid = threadIdx.x; asm volatile("" : "+v"(tid));
    const int lane = tid & 63, w = __builtin_amdgcn_readfirstlane(tid >> 6);
    const int gw = blockIdx.x * 8 + w, NGW = gridDim.x * 8;
    unsigned char* ws = Pk->ws;
    const float* gain = L < 2 ? Pk->in[17] + (size_t)L * 4096 : Pk->in[24] + (size_t)(L - 2) * 4096;
    const bf16_t* Y = (const bf16_t*)(ws + O_Y); const float* SSQP = (const float*)(ws + O_SSQP); const float* SOUT = (const float*)(ws + O_PART);
    bf16_t* XBF = (bf16_t*)(ws + O_XBF); float* RS = (float*)(ws + O_RS);
    for (int row = gw; row < TP + 8; row += NGW) {
        const bool smp = row >= TP; const int b = row - TP;
        float ssq; f32x4 y0[8], y1[8], x0[8], x1[8];
        if (!smp) {
            ssq = SSQP[(size_t)row * 64 + lane];
#pragma unroll
            for (int j = 0; j < 8; ++j) { const u32x4 yv = *(const u32x4*)(Y + (size_t)row * 4096 + j * 512 + lane * 8);
                y0[j] = (f32x4){bflo(yv.x), bfhi(yv.x), bflo(yv.y), bfhi(yv.y)}; y1[j] = (f32x4){bflo(yv.z), bfhi(yv.z), bflo(yv.w), bfhi(yv.w)}; }
        } else {
            ssq = 0.f;
#pragma unroll
            for (int j = 0; j < 8; ++j) { const float* sp = SOUT + (size_t)b * 4096 + j * 512 + lane * 8; y0[j] = *(const f32x4*)sp; y1[j] = *(const f32x4*)(sp + 4);
                ssq += (y0[j].x * y0[j].x + y0[j].y * y0[j].y) + (y0[j].z * y0[j].z + y0[j].w * y0[j].w) + (y1[j].x * y1[j].x + y1[j].y * y1[j].y) + (y1[j].z * y1[j].z + y1[j].w * y1[j].w); }
        }
        if (L == 0) {
            const float* xin = (smp ? Pk->in[1] + (size_t)b * 4096 : Pk->in[0] + (size_t)row * 4096);
#pragma unroll
            for (int j = 0; j < 8; ++j) { x0[j] = *(const f32x4*)(xin + j * 512 + lane * 8); x1[j] = *(const f32x4*)(xin + j * 512 + lane * 8 + 4); }
        } else {
            const float irs = 1.0f / RS[row];
#pragma unroll
            for (int j = 0; j < 8; ++j) { const u32x4 xv = *(const u32x4*)(XBF + (size_t)row * 4096 + j * 512 + lane * 8);
                x0[j] = (f32x4){bflo(xv.x), bfhi(xv.x), bflo(xv.y), bfhi(xv.y)} * irs; x1[j] = (f32x4){bflo(xv.z), bfhi(xv.z), bflo(xv.w), bfhi(xv.w)} * irs; }
        }
        const float rsn = rsqrtf(wave_sum(ssq) * (1.0f / 4096.0f) + EPSN);
        float acc = 0.f;
        float* xout = Pk->out + (smp ? OUT_YS + (size_t)b * 4096 : OUT_YP + (size_t)row * 4096);
#pragma unroll
        for (int j = 0; j < 8; ++j) {
            const int col = j * 512 + lane * 8;
            const f32x4 g0 = *(const f32x4*)(gain + col), g1 = *(const f32x4*)(gain + col + 4);
            const f32x4 n0 = x0[j] + y0[j] * rsn * g0, n1 = x1[j] + y1[j] * rsn * g1;
            acc += (n0.x * n0.x + n0.y * n0.y) + (n0.z * n0.z + n0.w * n0.w) + (n1.x * n1.x + n1.y * n1.y) + (n1.z * n1.z + n1.w * n1.w);
            if (L == 3) { *(f32x4*)(xout + col) = n0; *(f32x4*)(xout + col + 4) = n1; }
            x0[j] = n0; x1[j] = n1;
        }
        acc = wave_sum(acc);
        const float rsx = rsqrtf(acc * (1.0f / 4096.0f) + EPSN);
        if (L < 3) {
#pragma unroll
            for (int j = 0; j < 8; ++j) { const int col = j * 512 + lane * 8; const f32x4 n0 = x0[j] * rsx, n1 = x1[j] * rsx;
                u32x4 q; q.x = pk2(n0.x, n0.y); q.y = pk2(n0.z, n0.w); q.z = pk2(n1.x, n1.y); q.w = pk2(n1.z, n1.w); *(u32x4*)(XBF + (size_t)row * 4096 + col) = q; }
        }
        if (lane == 0) RS[row] = rsx;
    }
}

constexpr int KROW = 272, VROW = 320, OFF_VS = 69632, OFF_BI = OFF_VS + 81920, OFF_SW = OFF_BI + 2112;
__device__ __forceinline__ void attn_item(const Params& P, LAS unsigned char* lds, int item) {
    const KParams Pk = kparams();
    int tid = threadIdx.x; asm volatile("" : "+v"(tid));
    const int lane = tid & 63, w = __builtin_amdgcn_readfirstlane(tid >> 6), hh = lane >> 5, l32 = lane & 31;
    unsigned char* ws = Pk->ws;
    const bf16_t* Q = (const bf16_t*)(ws + P_Q); const bf16_t* KVB = (const bf16_t*)(ws + O_KVB); bf16_t* ON = (bf16_t*)(ws + P_ON); float* LSE = (float*)(ws + O_LSE);
    const int g = item >> 8, rem = item & 255, n = rem >> 6, kvh = rem & 3, cb = (rem >> 2) & 15;
    const int r = 1 << (2 * g), nb = 16 >> (2 * g), c = cb / nb, nbi = cb % nb;
    LAS unsigned char* Ks = lds; LAS unsigned char* Vs = lds + OFF_VS; LAS float* BI = (LAS float*)(lds + OFF_BI);
    __syncthreads();
#pragma unroll
    for (int j = 0; j < 8; ++j) {
        const int id = tid + 512 * j, kk = id >> 4, chk = id & 15, pos = (nbi - 1) * 128 + kk;
        u32x4 kv = {0u, 0u, 0u, 0u}, vv = {0u, 0u, 0u, 0u};
        if (pos >= 0) { const bf16_t* src = KVB + (size_t)(n * 2048 + pos * r + c) * 3072 + g * 1024 + kvh * 128 + chk * 8; kv = *(const u32x4*)src; vv = *(const u32x4*)(src + 512); }
        *(LAS u32x4*)(Ks + kk * KROW + chk * 16) = kv; *(LAS u32x4*)(Vs + kk * VROW + chk * 16) = vv;
    }
    for (int e = tid; e < 516; e += 512) { const int hl = e / 129, dist = e % 129; BI[hl * 132 + dist] = 1.4426950408889634f * Pk->in[20][rel_bucket(dist * r) * 48 + g * 16 + kvh * 4 + hl]; }
    __syncthreads();
    const float scale2 = 0.08838834764831845f * 1.4426950408889634f;
    const int qc = w & 3, qq = qc * 32 + l32, qrow = n * 2048 + (nbi * 128 + qq) * r + c;
    bf16x8 Qf[8];
    { const bf16_t* qp = Q + (size_t)qrow * 6144 + g * 2048 + (kvh * 4 + (w >> 2)) * 128 + hh * 8;
#pragma unroll
      for (int s = 0; s < 8; ++s) Qf[s] = *(const bf16x8*)(qp + s * 16); }
    for (int pp = 0; pp < 2; ++pp) {
        const int hl = (w >> 2) + 2 * pp, slot = kvh * 4 + hl;
        f32x16 S[5];
#pragma unroll
        for (int kt = 0; kt < 5; ++kt) {
#pragma unroll
            for (int e = 0; e < 16; ++e) S[kt][e] = 0.f;
            if (nbi > 0 || qc + kt >= 4) {
#pragma unroll
                for (int s = 0; s < 8; ++s) {
                    const bf16x8 a = *(const LAS bf16x8*)(Ks + (qc * 32 + kt * 32 + l32) * KROW + (s * 16 + hh * 8) * 2);
                    S[kt] = MFMA32(a, Qf[s], S[kt]);
                }
            }
            __builtin_amdgcn_sched_barrier(0);
        }
        if (pp == 0) {
            const bf16_t* qp = Q + (size_t)qrow * 6144 + g * 2048 + (slot + 2) * 128 + hh * 8;
#pragma unroll
            for (int s = 0; s < 8; ++s) Qf[s] = *(const bf16x8*)(qp + s * 16);
        }
        float m = -INFINITY;
#pragma unroll
        for (int kt = 0; kt < 5; ++kt) {
            const bool on = nbi > 0 || qc + kt >= 4;
            const LAS float* bp = BI + hl * 132 + (128 - 32 * kt - 27 - 4 * hh) + l32;
#pragma unroll
            for (int reg = 0; reg < 16; ++reg) {
                const int kc = (reg & 3) + 8 * (reg >> 2);
                float sv = S[kt][reg] * scale2 + bp[27 - kc];
                if (kt == 0) sv = (kc + 4 * hh >= l32) ? sv : -INFINITY;
                if (kt == 4) sv = (kc + 4 * hh <= l32) ? sv : -INFINITY;
                if (!on) sv = -INFINITY;
                S[kt][reg] = sv; m = fmaxf(m, sv);
            }
            __builtin_amdgcn_sched_barrier(0);
        }
        m = fmaxf(m, __shfl_xor(m, 32));
        float den = 0.f;
#pragma unroll
        for (int kt = 0; kt < 5; ++kt)
#pragma unroll
            for (int reg = 0; reg < 16; ++reg) { const float p = __builtin_amdgcn_exp2f(S[kt][reg] - m); S[kt][reg] = p; den += p; }
        den += __shfl_xor(den, 32);
        f32x16 O[4];
#pragma unroll
        for (int dt = 0; dt < 4; ++dt)
#pragma unroll
            for (int e = 0; e < 16; ++e) O[dt][e] = 0.f;
        const int q_ = (lane & 15) >> 2, p_ = lane & 3, cg16 = (lane >> 4) & 1;
#pragma unroll
        for (int kt = 0; kt < 5; ++kt) {
            if (nbi > 0 || qc + kt >= 4) {
#pragma unroll
                for (int s2 = 0; s2 < 2; ++s2) {
                    u32x4 pw; pw.x = pk2(S[kt][8 * s2 + 0], S[kt][8 * s2 + 1]); pw.y = pk2(S[kt][8 * s2 + 2], S[kt][8 * s2 + 3]); pw.z = pk2(S[kt][8 * s2 + 4], S[kt][8 * s2 + 5]); pw.w = pk2(S[kt][8 * s2 + 6], S[kt][8 * s2 + 7]);
                    const bf16x8 pf = __builtin_bit_cast(bf16x8, pw);
                    const int R0 = qc * 32 + kt * 32 + 16 * s2 + 4 * hh;
#pragma unroll
                    for (int dt = 0; dt < 4; ++dt) {
                        LAS unsigned char* ad = Vs + (R0 + q_) * VROW + (dt * 32 + 16 * cg16 + 4 * p_) * 2;
                        const s16x4 lo = __builtin_amdgcn_ds_read_tr16_b64_v4i16((LAS s16x4*)ad), hi = __builtin_amdgcn_ds_read_tr16_b64_v4i16((LAS s16x4*)(ad + 8 * VROW));
                        bf16x8 a; a[0] = lo[0]; a[1] = lo[1]; a[2] = lo[2]; a[3] = lo[3]; a[4] = hi[0]; a[5] = hi[1]; a[6] = hi[2]; a[7] = hi[3];
                        O[dt] = MFMA32(a, pf, O[dt]);
                    }
                    __builtin_amdgcn_sched_barrier(0);
                }
            }
        }
        const float inv = __builtin_amdgcn_rcpf(den);
        bf16_t* op = ON + ((size_t)g * RP + qrow) * 2048 + slot * 128 + 4 * hh;
#pragma unroll
        for (int dt = 0; dt < 4; ++dt)
#pragma unroll
            for (int g4 = 0; g4 < 4; ++g4) {
                u32x2 q; q.x = pk2(O[dt][4 * g4] * inv, O[dt][4 * g4 + 1] * inv); q.y = pk2(O[dt][4 * g4 + 2] * inv, O[dt][4 * g4 + 3] * inv);
                *(u32x2*)(op + dt * 32 + 8 * g4) = q;
            }
        if (hh == 0) LSE[((size_t)g * RP + qrow) * 16 + slot] = (m + __builtin_amdgcn_logf(den)) * 0.6931471805599453f;
    }
}

__device__ __forceinline__ void sample_attn(const Params& P, LAS unsigned char* lds, int si, int lbi, int wv) {
    const KParams Pk = kparams();
    int tid = threadIdx.x; asm volatile("" : "+v"(tid));
    const int lane = tid & 63;
    unsigned char* ws = Pk->ws;
    const float* PART = (const float*)(ws + O_PART); const float* RS = (const float*)(ws + O_RS); bf16_t* ON = (bf16_t*)(ws + P_ON); float* LSE = (float*)(ws + O_LSE);
    const int b = si / 48, rem = si % 48, g = rem >> 4, slot = rem & 15, kvh = slot >> 2, r = 1 << (2 * g), lbuf = 128 << (2 * g);
    const int N = lbi == 0 ? 11264 : 8192;
    const float* state = Pk->in[4 + g]; float* skv = Pk->out + (g == 0 ? OUT_SKV0 : (g == 1 ? OUT_SKV1 : OUT_SKV2));
    LAS float* qs = (LAS float*)(lds + OFF_SW + wv * 2064); LAS float* pw = qs + 128; LAS float* kn = qs + 260; LAS float* vn = qs + 388;
#pragma unroll
    for (int e = 0; e < 2; ++e) {
        const int d = lane * 2 + e;
        qs[d] = part_sum(PART, N, b, g * 2048 + slot * 128 + d);
        float kvl, vvl;
        if (lbi == 0) { kvl = part_sum(PART, N, b, 8192 + g * 1024 + kvh * 128 + d); vvl = part_sum(PART, N, b, 8192 + g * 1024 + 512 + kvh * 128 + d);
            if ((slot & 3) == 0) { float* dst = skv + ((size_t)(b * lbuf + lbuf - 1) * 2) * 512 + kvh * 128 + d; dst[0] = kvl; dst[512] = vvl; } }
        else { const float* srcp = skv + ((size_t)(b * lbuf + lbuf - 1) * 2) * 512 + kvh * 128 + d; kvl = srcp[0]; vvl = srcp[512]; }
        kn[d] = kvl; vn[d] = vvl;
    }
    LDS_WAIT();
    const float scale = 0.08838834764831845f;
    float m = -INFINITY;
#pragma unroll 1
    for (int rd = 0; rd < 3; ++rd) {
        const int step = lane + 64 * rd; float s = -INFINITY;
        if (step <= 128) {
            float dot = 0.f;
            if (step == 0) {
#pragma unroll 8
                for (int d = 0; d < 128; ++d) dot += qs[d] * kn[d]; }
            else { const f32x4* kr = (const f32x4*)(state + ((size_t)(b * lbuf + lbuf - step * r) * 2) * 512 + kvh * 128);
                f32x4 kv[32];
#pragma unroll
                for (int d4 = 0; d4 < 32; ++d4) kv[d4] = kr[d4];
#pragma unroll
                for (int d4 = 0; d4 < 32; ++d4) { const f32x4 qv = *(const LAS f32x4*)(qs + d4 * 4); dot += (kv[d4].x * qv.x + kv[d4].y * qv.y) + (kv[d4].z * qv.z + kv[d4].w * qv.w); } }
            s = dot * scale + Pk->in[20][rel_bucket(step * r) * 48 + g * 16 + slot];
            pw[step] = s;
        }
        m = fmaxf(m, s);
    }
    m = wave_max(m);
    LDS_WAIT();
    float den = 0.f;
#pragma unroll
    for (int rd = 0; rd < 3; ++rd) { const int step = lane + 64 * rd; if (step <= 128) { const float p = __expf(pw[step] - m); den += p; pw[step] = p; } }
    den = wave_sum(den);
    LDS_WAIT();
    float o0 = pw[0] * vn[lane * 2], o1 = pw[0] * vn[lane * 2 + 1];
#pragma unroll 1
    for (int s0 = 1; s0 <= 128; s0 += 32) {
        f32x2 v[32];
#pragma unroll
        for (int j = 0; j < 32; ++j) v[j] = *(const f32x2*)(state + ((size_t)(b * lbuf + lbuf - (s0 + j) * r) * 2 + 1) * 512 + kvh * 128 + lane * 2);
#pragma unroll
        for (int j = 0; j < 32; ++j) { const float p = pw[s0 + j]; o0 += p * v[j].x; o1 += p * v[j].y; }
    }
    const float inv = 1.0f / den;
    *(unsigned*)(ON + ((size_t)g * RP + TP + b) * 2048 + slot * 128 + lane * 2) = pk2(o0 * inv, o1 * inv);
    if (lane == 0) LSE[((size_t)g * RP + TP + b) * 16 + slot] = m + __logf(den);
    LDS_WAIT();
}

__device__ __forceinline__ void combine_phase(const Params& P, int lbi) {
    const KParams Pk = kparams();
    int tid = threadIdx.x; asm volatile("" : "+v"(tid));
    const int lane = tid & 63, w = __builtin_amdgcn_readfirstlane(tid >> 6);
    const int gw = blockIdx.x * 8 + w, NGW = gridDim.x * 8;
    unsigned char* ws = Pk->ws;
    const bf16_t* ON = (const bf16_t*)(ws + P_ON); const float* LSE = (const float*)(ws + O_LSE); const bf16_t* SG2 = (const bf16_t*)(ws + O_SG2); bf16_t* OG = (bf16_t*)(ws + O_OG);
    const float* PART = (const float*)(ws + O_PART); const float* RS = (const float*)(ws + O_RS);
    const int N = lbi == 0 ? 11264 : 8192;
    for (int row = gw; row < TP + 8; row += NGW) {
#pragma unroll
        for (int cch = 0; cch < 4; ++cch) {
            const int col = cch * 512 + lane * 8, slot = col >> 7;
            const float l0 = LSE[((size_t)0 * RP + row) * 16 + slot], l1 = LSE[((size_t)1 * RP + row) * 16 + slot], l2 = LSE[((size_t)2 * RP + row) * 16 + slot];
            const float mx = fmaxf(l0, fmaxf(l1, l2)); float w0 = __expf(l0 - mx), w1 = __expf(l1 - mx), w2 = __expf(l2 - mx);
            const float iw = 1.0f / (w0 + w1 + w2); w0 *= iw; w1 *= iw; w2 *= iw;
            const u32x4 a0 = *(const u32x4*)(ON + ((size_t)0 * RP + row) * 2048 + col), a1 = *(const u32x4*)(ON + ((size_t)1 * RP + row) * 2048 + col), a2 = *(const u32x4*)(ON + ((size_t)2 * RP + row) * 2048 + col);
            float gt[8];
            if (row < TP) { const u32x4 sv = *(const u32x4*)(SG2 + (size_t)row * 2048 + col);
                gt[0] = bflo(sv.x); gt[1] = bfhi(sv.x); gt[2] = bflo(sv.y); gt[3] = bfhi(sv.y); gt[4] = bflo(sv.z); gt[5] = bfhi(sv.z); gt[6] = bflo(sv.w); gt[7] = bfhi(sv.w); }
            else { const int b = row - TP;
#pragma unroll
                for (int e = 0; e < 8; ++e) gt[e] = silu_f(part_sum(PART, N, b, 6144 + col + e)); }
            float o[8];
            o[0] = w0 * bflo(a0.x) + w1 * bflo(a1.x) + w2 * bflo(a2.x); o[1] = w0 * bfhi(a0.x) + w1 * bfhi(a1.x) + w2 * bfhi(a2.x);
            o[2] = w0 * bflo(a0.y) + w1 * bflo(a1.y) + w2 * bflo(a2.y); o[3] = w0 * bfhi(a0.y) + w1 * bfhi(a1.y) + w2 * bfhi(a2.y);
            o[4] = w0 * bflo(a0.z) + w1 * bflo(a1.z) + w2 * bflo(a2.z); o[5] = w0 * bfhi(a0.z) + w1 * bfhi(a1.z) + w2 * bfhi(a2.z);
            o[6] = w0 * bflo(a0.w) + w1 * bflo(a1.w) + w2 * bflo(a2.w); o[7] = w0 * bfhi(a0.w) + w1 * bfhi(a1.w) + w2 * bfhi(a2.w);
            u32x4 q; q.x = pk2(o[0] * gt[0], o[1] * gt[1]); q.y = pk2(o[2] * gt[2], o[3] * gt[3]); q.z = pk2(o[4] * gt[4], o[5] * gt[5]); q.w = pk2(o[6] * gt[6], o[7] * gt[7]);
            *(u32x4*)(OG + (size_t)row * 2048 + col) = q;
        }
    }
}

__global__ __launch_bounds__(512, 2) void yoco_mega(Params P) {
    extern __shared__ __attribute__((aligned(16))) unsigned char shm[];
    LAS unsigned char* lds = (LAS unsigned char*)shm;
    cg::grid_group grid = cg::this_grid();
    const KParams Pk = kparams();
    unsigned char* ws = Pk->ws;
    const int w = threadIdx.x >> 6;
    if (threadIdx.x == 0) { *(LAS u32x4*)(lds + OFF_XB) = (u32x4){0u, 0u, 0u, 0u}; }
    __syncthreads();
    const XcdBarrier xb = xcd_barrier_post((unsigned*)(ws + O_BAR), (volatile LAS unsigned*)(lds + OFF_XB));
    prep_phase(P, lds);
    convert_work(P, lds, 0, N_PREP_ITEMS, false, (int)blockIdx.x, (int)gridDim.x);
    grid.sync();
    for (int L = 0; L < 4; ++L) {
        for (int half = 0; half < 2; ++half) {
            pg8::Gemm gm; Epi E; gm.M = TP;
            E.rs = (const float*)(ws + O_RS); E.ssqp = (float*)(ws + O_SSQP); E.outp = Pk->out; E.o2 = (bf16_t*)(ws + O_KVB);
            if (half == 0) {
                gm.A = (const bf16_t*)(ws + O_XBF); gm.K = 4096;
                if (L < 2) { gm.Bt = (const bf16_t*)(ws + O_BT1) + (size_t)L * 8192 * 4096; gm.N = 8192; E.mode = 0; E.o0 = (bf16_t*)(ws + P_XB); E.o1 = (bf16_t*)(ws + P_SG); }
                else { gm.Bt = (const bf16_t*)(ws + (L == 2 ? O_BT3 : O_BT4)); gm.N = L == 2 ? 11264 : 8192; E.mode = 2; E.o0 = (bf16_t*)(ws + P_Q); E.o1 = (bf16_t*)(ws + O_SG2); }
            } else {
                E.mode = 1; E.o0 = (bf16_t*)(ws + O_Y); E.o1 = E.o0; gm.N = 4096;
                if (L < 2) { gm.A = (const bf16_t*)(ws + P_HG); gm.Bt = (const bf16_t*)(ws + O_BT2) + (size_t)L * 4096 * 4096; gm.K = 4096; }
                else { gm.A = (const bf16_t*)(ws + O_OG); gm.Bt = (const bf16_t*)(ws + O_BT5) + (size_t)(L - 2) * 4096 * 2048; gm.K = 2048; }
            }
            pg8::StaticOrder S; S.init(gm.M, gm.N, (int)gridDim.x, (int)blockIdx.x);
            pg8::gemm_phase<Epi, pg8::StaticOrder, false>(lds, gm, S, E, nullptr);
            if (L == 2 && half == 0) {
                const int nwg = (gm.M / 256) * (gm.N / 256), G = (int)gridDim.x, fi = nwg - ((nwg - 1) / G) * G;
                int vb = (int)blockIdx.x, nvb = G;
                if (fi < G) { vb = (int)blockIdx.x - fi; nvb = vb >= 0 ? G - fi : 0; }
                __syncthreads();
                if (nvb > 0) convert_work(P, lds, N_PREP_ITEMS, N_ALL_ITEMS, true, vb, nvb);
            }
            __syncthreads();
            if (gm.K == 4096) skinny_phase<16>(gm.A + (size_t)TP * gm.K, gm.Bt, gm.N, gm.K, (float*)(ws + O_PART), lds);
            else skinny_phase<8>(gm.A + (size_t)TP * gm.K, gm.Bt, gm.N, gm.K, (float*)(ws + O_PART), lds);
            xcd_barrier(xb);
            if (half == 0) {
                if (L < 2) {
                    scan_phase(P, lds, L);
                } else {
                    for (int wv = 0; wv < 2; ++wv) { const int si = wv * 256 + (int)blockIdx.x; if (si < 384 && w == wv && gridDim.x >= 256) sample_attn(P, lds, si, L - 2, wv); }
                    if (gridDim.x < 256 && w < 2) for (int si = blockIdx.x * 2 + w; si < 384; si += gridDim.x * 2) sample_attn(P, lds, si, L - 2, w);
                    for (int it = blockIdx.x; it < 768; it += gridDim.x) attn_item(P, lds, it);
                    xcd_barrier(xb);
                    combine_phase(P, L - 2);
                }
            } else {
                post_phase(P, L);
            }
            if (!(L == 3 && half == 1)) xcd_barrier(xb);
        }
    }
}

extern "C" void kernel_launch(void* const* d_in, const int* in_sizes, int n_in, void* d_out, int out_size, void* d_ws, size_t ws_size, hipStream_t stream) {
    static int grid_blocks = 0;
    if (!grid_blocks) {
        int dev = 0, cus = 0, per_cu = 0;
        hipGetDevice(&dev);
        hipDeviceGetAttribute(&cus, hipDeviceAttributeMultiprocessorCount, dev);
        hipFuncSetAttribute((const void*)yoco_mega, hipFuncAttributeMaxDynamicSharedMemorySize, LDS_BYTES);
        if (hipOccupancyMaxActiveBlocksPerMultiprocessor(&per_cu, (const void*)yoco_mega, 512, LDS_BYTES) != hipSuccess || per_cu < 1) per_cu = 1;
        (void)hipGetLastError();
        grid_blocks = cus * per_cu;
        if (ws_size < O_END) fprintf(stderr, "kernel_launch: workspace too small: %zu < %zu\n", ws_size, (size_t)O_END);
    }
    (void)hipMemsetAsync((unsigned char*)d_ws + O_BAR, 0, XCD_BAR_WORDS * sizeof(unsigned), stream);
    Params p{};
    for (int i = 0; i < 25; ++i) p.in[i] = (const float*)d_in[i];
    p.out = (float*)d_out; p.ws = (unsigned char*)d_ws;
    void* args[] = {&p};
    hipError_t e = hipLaunchCooperativeKernel((const void*)yoco_mega, dim3(grid_blocks), dim3(512), args, LDS_BYTES, stream);
    if (e != hipSuccess) fprintf(stderr, "cooperative launch failed: %s (grid %d)\n", hipGetErrorString(e), grid_blocks);
}
```

```cpp
#include <hip/hip_runtime.h>
#include <hip/hip_cooperative_groups.h>
#include <cstdio>
namespace cg = cooperative_groups;

namespace pg8 {
#define PG8_LAS __attribute__((address_space(3)))
typedef unsigned short bf16_t;
typedef short bf16x8 __attribute__((ext_vector_type(8)));
typedef float f32x4 __attribute__((ext_vector_type(4)));
typedef unsigned u32x4 __attribute__((ext_vector_type(4)));
constexpr int BM = 256, BK = 64, HALF = 128, HTB = HALF * BK * 2, STAGE_BYTES = 8 * HTB, NXCD = 8, WGM = 8;

__host__ __device__ __forceinline__ int lds_byte(int r, int c) { const int st = (r >> 4) * 2 + (c >> 5), rr = r & 15, cc = c & 31, ob = rr * 64 + cc * 2; return st * 1024 + (ob ^ (((ob >> 9) & 1) << 5)); }
__host__ __device__ __forceinline__ void stage_rc(int b, int& R, int& C) { const int st = b / 1024, sb = b % 1024, swz = sb ^ (((sb >> 9) & 1) << 5); R = (st >> 1) * 16 + swz / 64; C = (st & 1) * 32 + (swz % 64) / 2; }
__host__ __device__ __forceinline__ int perm32(int rho) { const int n = rho >> 4, i = rho & 15; return 8 * (i >> 2) + 4 * n + (i & 3); }

struct Unit { int pm, pn; };
struct Gemm { const bf16_t* A; const bf16_t* Bt; int M, N, K; };

struct StaticOrder {
    int nM, nN, nwg, G, c;
    __host__ __device__ void init(int M, int N, int G_, int c_) { nM = M / BM; nN = N / BM; nwg = nM * nN; G = G_; c = c_; }
    __host__ __device__ bool next(int i, Unit& u) const {
        const long L = (long)i * G + c; if (L >= nwg) return false;
        int wgid = (int)L; { const int q = nwg / NXCD, r = nwg % NXCD, xcd = wgid % NXCD, off = wgid / NXCD; wgid = (xcd < r ? xcd * (q + 1) : r * (q + 1) + (xcd - r) * q) + off; }
        const int nig = WGM * nN, gid = wgid / nig, fm = gid * WGM, gsz = (nM - fm) < WGM ? (nM - fm) : WGM;
        u.pm = fm + ((wgid % nig) % gsz); u.pn = (wgid % nig) / gsz; return true;
    }
    __device__ __forceinline__ void a_ready(const Unit&) const {}
    __device__ __forceinline__ void done(const Unit&) const {}
};
template <class Epi, class Sched, bool STAMP = false>
__device__ __forceinline__ void gemm_phase(PG8_LAS unsigned char* lds, const Gemm g, const Sched& S, const Epi& E, unsigned long long* stamps) {
    int tid = threadIdx.x; asm volatile("" : "+v"(tid));
    const int wid = __builtin_amdgcn_readfirstlane(tid >> 6), lane = tid & 63, wr = wid >> 2, wc = wid & 3, fr = lane & 15, fq = lane >> 4;
    const int K = g.K, nt = K / BK;
    int ts_lo = 0, ts_hi = 0, nts = 0; const unsigned long long rt_entry = STAMP ? (unsigned long long)wall_clock64() : 0ull;
#define PG8_STAMP() do { if (STAMP && wid == 0 && nts < 64) { const unsigned long long _c = (unsigned long long)clock64(); \
        ts_lo = (lane == nts) ? (int)(unsigned)_c : ts_lo; ts_hi = (lane == nts) ? (int)(unsigned)(_c >> 32) : ts_hi; ++nts; } } while (0)
    PG8_STAMP();
    unsigned voffA[2], voffB[2];
#pragma unroll
    for (int i = 0; i < 2; ++i) { int R, C; stage_rc(tid * 16 + i * 8192, R, C); const int Rb = Epi::PERM ? ((R & ~31) + perm32(R & 31)) : R;
        voffA[i] = (unsigned)(R * K + C) * 2u; voffB[i] = (unsigned)(Rb * K + C) * 2u; }
    const size_t kstep = (size_t)(BK * 2);
    const size_t hstep = (size_t)HALF * K * 2;
    const size_t tstep = 2 * hstep;
    const unsigned ldsw = (unsigned)wid * 1024u;
    const int aoff = lds_byte(wr * 64 + fr, fq * 8), boff = lds_byte(wc * 32 + fr, fq * 8);
#define PG8_SA(b, h) (((b) * 2 + (h)) * HTB)
#define PG8_SB(b, h) ((4 + (b) * 2 + (h)) * HTB)
#define PG8_STAGE(bufoff, gbase, voff) do { _Pragma("unroll") for (int _i = 0; _i < 2; ++_i) \
        __builtin_amdgcn_global_load_lds((const unsigned*)((const char*)(gbase) + (voff)[_i]), (PG8_LAS unsigned*)(lds + (bufoff) + ldsw + _i * 8192), 16, 0, 0); } while (0)
#define PG8_LDA(dst, b, h) do { _Pragma("unroll") for (int m = 0; m < 4; ++m) _Pragma("unroll") for (int k = 0; k < 2; ++k) dst[m][k] = *(const PG8_LAS bf16x8*)(lds + PG8_SA(b, h) + aoff + m * 2048 + k * 1024); } while (0)
#define PG8_LDB(dst, b, h) do { _Pragma("unroll") for (int n = 0; n < 2; ++n) _Pragma("unroll") for (int k = 0; k < 2; ++k) dst[n][k] = *(const PG8_LAS bf16x8*)(lds + PG8_SB(b, h) + boff + n * 2048 + k * 1024); } while (0)
#define PG8_MMA(ai, bj, At, Bt) do { __builtin_amdgcn_s_setprio(1); _Pragma("unroll") for (int m = 0; m < 4; ++m) _Pragma("unroll") for (int n = 0; n < 2; ++n) _Pragma("unroll") for (int k = 0; k < 2; ++k) \
        acc[ai][bj][m][n] = __builtin_amdgcn_mfma_f32_16x16x32_bf16(Bt[n][k], At[m][k], acc[ai][bj][m][n], 0, 0, 0); __builtin_amdgcn_s_setprio(0); } while (0)
#define PG8_WAIT_V(n) asm volatile("s_waitcnt vmcnt(" #n ")" ::: "memory")
#define PG8_WAIT_L(n) asm volatile("s_waitcnt lgkmcnt(" #n ")" ::: "memory")
#define PG8_BAR __builtin_amdgcn_s_barrier()
#define PG8_SCHED __builtin_amdgcn_sched_barrier(0)
    Unit cur, nxt; int ui = 0;
    if (!S.next(0, cur)) return;
    f32x4 acc[2][2][4][2];
#pragma unroll
    for (int a = 0; a < 2; ++a)
#pragma unroll
        for (int b = 0; b < 2; ++b)
#pragma unroll
            for (int m = 0; m < 4; ++m)
#pragma unroll
                for (int n = 0; n < 2; ++n) acc[a][b][m][n] = (f32x4){0.f, 0.f, 0.f, 0.f};
    bf16x8 At[4][2], B0[2][2], B1[2][2];
    const char* cA = (const char*)g.A + (size_t)cur.pm * tstep; const char* cB = (const char*)g.Bt + (size_t)cur.pn * tstep;
    S.a_ready(cur);
    PG8_STAGE(PG8_SB(0, 0), cB, voffB); PG8_STAGE(PG8_SB(0, 1), cB + hstep, voffB); PG8_STAGE(PG8_SA(0, 0), cA, voffA); PG8_STAGE(PG8_SA(0, 1), cA + hstep, voffA);
    if (wr == 1) PG8_BAR;
    PG8_WAIT_V(2); PG8_BAR;
    PG8_STAGE(PG8_SB(1, 0), cB + kstep, voffB); PG8_STAGE(PG8_SA(1, 0), cA + kstep, voffA); PG8_STAGE(PG8_SB(1, 1), cB + hstep + kstep, voffB);
    PG8_WAIT_V(6); PG8_BAR;
    PG8_STAMP();
    for (;;) {
        const bool has_next = S.next(ui + 1, nxt);
        const char* nA = has_next ? (const char*)g.A + (size_t)nxt.pm * tstep : cA; const char* nB = has_next ? (const char*)g.Bt + (size_t)nxt.pn * tstep : cB;
        for (int t = 0; t < nt; t += 2) {
            const bool last = (t == nt - 2);
            const char* a1 = cA + (size_t)(t + 1) * kstep;
            const char* a2 = last ? nA : cA + (size_t)(t + 2) * kstep; const char* b2 = last ? nB : cB + (size_t)(t + 2) * kstep;
            const char* a3 = a2 + kstep; const char* b3 = b2 + kstep;
            if (last && has_next) S.a_ready(nxt);
            PG8_LDB(B0, 0, 0); PG8_LDB(B1, 0, 1); PG8_SCHED; PG8_LDA(At, 0, 0); PG8_STAGE(PG8_SA(1, 1), a1 + hstep, voffA);
            PG8_WAIT_V(8); PG8_WAIT_L(0); PG8_BAR; PG8_MMA(0, 0, At, B0); PG8_MMA(0, 1, At, B1); PG8_BAR; PG8_SCHED;
            PG8_LDA(At, 0, 1); PG8_STAGE(PG8_SB(0, 0), b2, voffB); PG8_STAGE(PG8_SB(0, 1), b2 + hstep, voffB); PG8_STAGE(PG8_SA(0, 0), a2, voffA);
            PG8_WAIT_V(8); PG8_WAIT_L(0); PG8_BAR; PG8_MMA(1, 0, At, B0); PG8_MMA(1, 1, At, B1); PG8_BAR; PG8_SCHED;
            PG8_LDB(B0, 1, 0); PG8_LDB(B1, 1, 1); PG8_SCHED; PG8_LDA(At, 1, 0); PG8_STAGE(PG8_SA(0, 1), a2 + hstep, voffA);
            PG8_WAIT_V(8); PG8_WAIT_L(0); PG8_BAR; PG8_MMA(0, 0, At, B0); PG8_MMA(0, 1, At, B1); PG8_BAR; PG8_SCHED;
            PG8_LDA(At, 1, 1); PG8_STAGE(PG8_SB(1, 0), b3, voffB); PG8_STAGE(PG8_SB(1, 1), b3 + hstep, voffB); PG8_STAGE(PG8_SA(1, 0), a3, voffA);
            PG8_WAIT_V(8); PG8_WAIT_L(0); PG8_BAR; PG8_MMA(1, 0, At, B0); PG8_MMA(1, 1, At, B1); PG8_BAR; PG8_SCHED;
        }
        PG8_STAMP();
        if (wr == 0) PG8_BAR;
        if constexpr (!Epi::AFTER_DRAIN) { E(acc, cur, wr, wc, fr, fq); S.done(cur); }
        PG8_STAMP();
        if (!has_next) break;
#pragma unroll
        for (int a = 0; a < 2; ++a)
#pragma unroll
            for (int b = 0; b < 2; ++b)
#pragma unroll
                for (int m = 0; m < 4; ++m)
#pragma unroll
                    for (int n = 0; n < 2; ++n) acc[a][b][m][n] = (f32x4){0.f, 0.f, 0.f, 0.f};
        cur = nxt; cA = nA; cB = nB; ++ui;
        if (wr == 1) PG8_BAR;
    }
    PG8_WAIT_V(0);
    PG8_BAR;
    if constexpr (Epi::AFTER_DRAIN) { E.fused(acc, cur, wr, wc, fr, fq, lds, wid, lane); S.done(cur); }
    PG8_STAMP();
    if (STAMP && wid == 0) { stamps[lane] = lane < nts ? (((unsigned long long)(unsigned)ts_hi << 32) | (unsigned)ts_lo) : 0ull;
        if (lane == 62) stamps[62] = rt_entry; if (lane == 63) stamps[63] = (unsigned long long)wall_clock64(); }
#undef PG8_STAMP
#undef PG8_SA
#undef PG8_SB
#undef PG8_STAGE
#undef PG8_LDA
#undef PG8_LDB
#undef PG8_MMA
#undef PG8_WAIT_V
#undef PG8_WAIT_L
#undef PG8_BAR
#undef PG8_SCHED
}}

using pg8::bf16_t; using pg8::bf16x8; using pg8::f32x4; using pg8::u32x4;
typedef short s16x4 __attribute__((ext_vector_type(4)));
typedef float f32x16 __attribute__((ext_vector_type(16)));
typedef float f32x2 __attribute__((ext_vector_type(2)));
typedef unsigned u32x2 __attribute__((ext_vector_type(2)));
typedef unsigned long long u64;
#define LAS __attribute__((address_space(3)))
#define LDS_WAIT() asm volatile("s_waitcnt lgkmcnt(0)" ::: "memory")
#define XB_TMO      128
#define XB_XCNT(j)  (256  + 64 * (j))
#define XB_XSUB(j)  (1280 + 64 * (j))
#define XB_XGEN(j)  (2304 + 64 * (j))
#define XB_TOP      3328
#define XB_TOPGEN   3392
#define XCD_BAR_WORDS 3456
#define XB_SPIN_CAP (1u << 18)

__device__ __forceinline__ unsigned xb_ld(unsigned* p)              { return __hip_atomic_load(p, __ATOMIC_RELAXED, __HIP_MEMORY_SCOPE_AGENT); }
__device__ __forceinline__ unsigned xb_add(unsigned* p, unsigned v) { return __hip_atomic_fetch_add(p, v, __ATOMIC_RELAXED, __HIP_MEMORY_SCOPE_AGENT); }
__device__ __forceinline__ unsigned xb_xcc_id() { return (unsigned)__builtin_amdgcn_s_getreg((3 << 11) | 20) & 0xFu; }
#define XB_SPIN(cond, bar) do { unsigned _sp = 0; while (cond) { __builtin_amdgcn_s_sleep(1); \
    if ((++_sp & 255u) == 0u) { if (xb_ld(&(bar)[XB_TMO])) break; if (_sp > XB_SPIN_CAP) { atomicAdd(&(bar)[XB_TMO], 1u); break; } } } } while (0)

struct XcdBarrier {
    unsigned* bar; unsigned x;
    volatile LAS unsigned* st;
};

__device__ __forceinline__ XcdBarrier xcd_barrier_post(unsigned* bar, volatile LAS unsigned* st) {
    XcdBarrier b; b.bar = bar; b.x = xb_xcc_id(); b.st = st;
    if (threadIdx.x == 0) (void)xb_add(&bar[XB_XCNT(b.x)], 1u);
    return b;
}
__device__ __forceinline__ void xcd_barrier_complete(unsigned* bar, unsigned x, unsigned& nloc, unsigned& nx) {
    const unsigned G = gridDim.x * gridDim.y * gridDim.z;
    unsigned sum, cnt, mine, sp = 0u;
    for (;;) {
        sum = 0u; cnt = 0u; mine = 0u;
#pragma unroll
        for (unsigned j = 0; j < 16; ++j) { const unsigned c = xb_ld(&bar[XB_XCNT(j)]); sum += c; cnt += (c > 0u) ? 1u : 0u; mine = (j == x) ? c : mine; }
        if (sum == G) break;
        __builtin_amdgcn_s_sleep(1);
        if ((++sp & 255u) == 0u) { if (xb_ld(&bar[XB_TMO])) break; if (sp > XB_SPIN_CAP) { atomicAdd(&bar[XB_TMO], 1u); break; } }
    }
    nloc = mine > 0u ? mine : 1u; nx = cnt > 0u ? cnt : 1u;
}

__device__ __forceinline__ void xcd_barrier(const XcdBarrier& b) {
    asm volatile("s_waitcnt vmcnt(0)" ::: "memory");
    __syncthreads();
    if (threadIdx.x == 0) {
        unsigned* bar = b.bar;
        __builtin_amdgcn_s_waitcnt(0);
        unsigned nloc = b.st[0], nx = b.st[1];
        if (nloc == 0u) { xcd_barrier_complete(bar, b.x, nloc, nx); b.st[0] = nloc; b.st[1] = nx; }
        const unsigned old = xb_add(&bar[XB_XSUB(b.x)], 1u);
        const unsigned gen = old / nloc;
        if (old + 1u == (gen + 1u) * nloc) {
            __builtin_amdgcn_fence(__ATOMIC_RELEASE, "agent");
            asm volatile("s_waitcnt vmcnt(0)" ::: "memory");
            const unsigned og = xb_add(&bar[XB_TOP], 1u);
            const unsigned tg = og / nx;
            if (og + 1u == (tg + 1u) * nx) xb_add(&bar[XB_TOPGEN], 1u);
            else XB_SPIN(xb_ld(&bar[XB_TOPGEN]) == tg, bar);
            __builtin_amdgcn_fence(__ATOMIC_ACQUIRE, "agent");
            xb_add(&bar[XB_XGEN(b.x)], 1u);
            asm volatile("s_waitcnt vmcnt(0)" ::: "memory");
        } else {
            XB_SPIN(xb_ld(&bar[XB_XGEN(b.x)]) == gen, bar);
            __builtin_amdgcn_fence(__ATOMIC_ACQUIRE, "agent");
            asm volatile("s_waitcnt vmcnt(0)" ::: "memory");
        }
    }
    __syncthreads();
}


constexpr int DM = 4096, SEQ = 2048, TP = 8192, RP = 8448;
constexpr size_t MiB = (size_t)1 << 20;
constexpr size_t O_BT1 = 0, O_BT2 = O_BT1 + 128 * MiB, O_BT3 = O_BT2 + 64 * MiB, O_BT4 = O_BT3 + 88 * MiB, O_BT5 = O_BT4 + 64 * MiB, O_WG = O_BT5 + 32 * MiB,
                 O_XBF = O_WG + 8 * MiB, O_POOL = O_XBF + 66 * MiB, O_Y = O_POOL + 198 * MiB, O_SG2 = O_Y + 66 * MiB, O_OG = O_SG2 + 33 * MiB, O_KVB = O_OG + 33 * MiB,
                 O_RS = O_KVB + 48 * MiB, O_SSQP = O_RS + 1 * MiB, O_LSE = O_SSQP + 2 * MiB, O_GRAN = O_LSE + 2 * MiB, O_PART = O_GRAN + 8 * MiB, O_BAR = O_PART + 3 * MiB, O_END = O_BAR + 1 * MiB;
constexpr size_t P_XB = O_POOL, P_SG = O_POOL + 66 * MiB, P_HG = O_POOL + 132 * MiB, P_Q = O_POOL, P_ON = O_POOL + 99 * MiB;
constexpr size_t OUT_YP = 0, OUT_YS = 33554432, OUT_PCONV = OUT_YS + 32768, OUT_PH = OUT_PCONV + 98304, OUT_PKV0 = OUT_PH + 32768, OUT_PKV1 = OUT_PKV0 + 524288, OUT_PKV2 = OUT_PKV1 + 2097152,
                 OUT_SCONV = OUT_PKV2 + 8388608, OUT_SH = OUT_SCONV + 196608, OUT_SKV0 = OUT_SH + 65536, OUT_SKV1 = OUT_SKV0 + 1048576, OUT_SKV2 = OUT_SKV1 + 4194304;
constexpr int LDS_BYTES = 159744, OFF_XB = 157824;
constexpr float EPSN = 1e-6f;

struct Params { const float* in[25]; float* out; unsigned char* ws; };
typedef const Params __attribute__((address_space(4))) * KParams;
__device__ __forceinline__ KParams kparams() { KParams p = (KParams)__builtin_amdgcn_kernarg_segment_ptr(); asm volatile("" : "+s"(p)); return p; }
#define PLOCAL const KParams Pk = kparams(); (void)P;


__device__ __forceinline__ unsigned pk2(float a, float b) { typedef __bf16 bf2 __attribute__((ext_vector_type(2))); bf2 v; v[0] = (__bf16)a; v[1] = (__bf16)b; return __builtin_bit_cast(unsigned, v); }
__device__ __forceinline__ float bflo(unsigned u) { return __uint_as_float(u << 16); }
__device__ __forceinline__ float bfhi(unsigned u) { return __uint_as_float(u & 0xffff0000u); }
__device__ __forceinline__ float bf2f(bf16_t h) { return __uint_as_float(((unsigned)h) << 16); }
__device__ __forceinline__ float silu_f(float v) { return v * __builtin_amdgcn_rcpf(1.0f + __expf(-v)); }
__device__ __forceinline__ float sigm_f(float v) { return __builtin_amdgcn_rcpf(1.0f + __expf(-v)); }
__device__ __forceinline__ float wave_sum(float v) {
#pragma unroll
    for (int o = 1; o < 64; o <<= 1) v += __shfl_xor(v, o);
    return v;
}
__device__ __forceinline__ float wave_max(float v) {
#pragma unroll
    for (int o = 1; o < 64; o <<= 1) v = fmaxf(v, __shfl_xor(v, o));
    return v;
}
__device__ __forceinline__ int crow(int reg, int h) { return (reg & 3) + 8 * (reg >> 2) + 4 * h; }
__device__ __forceinline__ int rel_bucket(int dd) {
    if (dd < 16) return dd;
    const float d = (float)dd;
    int large = 16 + (int)(logf(d * (1.0f / 16.0f)) / logf(128.0f) * 16.0f);
    return large < 31 ? large : 31;
}
#define MFMA32(a, b, c) __builtin_amdgcn_mfma_f32_32x32x16_bf16((a), (b), (c), 0, 0, 0)

struct Epi {
    static constexpr bool PERM = true, AFTER_DRAIN = false;
    int mode;
    const float* rs; bf16_t* o0; bf16_t* o1; bf16_t* o2; float* ssqp; float* outp;
    __device__ __forceinline__ void operator()(const f32x4 (&acc)[2][2][4][2], const pg8::Unit& u, int wr, int wc, int fr, int fq) const {
        const int row0 = u.pm * 256 + wr * 64 + fr, colt = u.pn * 256, cw = wc * 32 + 8 * fq;
        if (mode == 1) {
#pragma unroll
            for (int ai = 0; ai < 2; ++ai)
#pragma unroll
                for (int m = 0; m < 4; ++m) {
                    const int row = row0 + ai * 128 + m * 16; float ss = 0.f;
#pragma unroll
                    for (int bj = 0; bj < 2; ++bj) {
                        const f32x4 v0 = acc[ai][bj][m][0], v1 = acc[ai][bj][m][1];
                        ss += (v0[0] * v0[0] + v0[1] * v0[1]) + (v0[2] * v0[2] + v0[3] * v0[3]) + (v1[0] * v1[0] + v1[1] * v1[1]) + (v1[2] * v1[2] + v1[3] * v1[3]);
                        u32x4 w; w.x = pk2(v0[0], v0[1]); w.y = pk2(v0[2], v0[3]); w.z = pk2(v1[0], v1[1]); w.w = pk2(v1[2], v1[3]);
                        *(u32x4*)(o0 + (size_t)row * 4096 + colt + bj * 128 + cw) = w;
                    }
                    ss += __shfl_xor(ss, 16); ss += __shfl_xor(ss, 32);
                    if (fq == 0) ssqp[(size_t)row * 64 + u.pn * 4 + wc] = ss;
                }
            return;
        }
        bf16_t* dst; int ld, col; bool act = false, kv = false;
        if (mode == 0) { ld = 4096; if (colt < 4096) { dst = o0; col = colt; } else { dst = o1; col = colt - 4096; act = true; } }
        else { if (colt < 6144) { dst = o0; ld = 6144; col = colt; } else if (colt < 8192) { dst = o1; ld = 2048; col = colt - 6144; act = true; } else { dst = o2; ld = 3072; col = colt - 8192; kv = true; } }
#pragma unroll
        for (int ai = 0; ai < 2; ++ai)
#pragma unroll
            for (int m = 0; m < 4; ++m) {
                const int row = row0 + ai * 128 + m * 16;
#pragma unroll
                for (int bj = 0; bj < 2; ++bj) {
                    f32x4 v0 = acc[ai][bj][m][0], v1 = acc[ai][bj][m][1];
                    if (act) {
#pragma unroll
                        for (int j = 0; j < 4; ++j) { v0[j] = silu_f(v0[j]); v1[j] = silu_f(v1[j]); }
                    }
                    u32x4 w; w.x = pk2(v0[0], v0[1]); w.y = pk2(v0[2], v0[3]); w.z = pk2(v1[0], v1[1]); w.w = pk2(v1[2], v1[3]);
                    const int cc = col + bj * 128 + cw;
                    *(u32x4*)(dst + (size_t)row * ld + cc) = w;
                    if (kv) {
                        const int g = cc >> 10, rem = cc & 1023, keep = 128 << (2 * g), n = row >> 11, t = row & 2047;
                        if (t >= 2048 - keep) {
                            const size_t ob = (g == 0 ? OUT_PKV0 : (g == 1 ? OUT_PKV1 : OUT_PKV2)) + ((size_t)(n * keep + (t - (2048 - keep))) * 1024 + rem);
                            *(f32x4*)(outp + ob) = v0; *(f32x4*)(outp + ob + 4) = v1;
                        }
                    }
                }
            }
    }
};

constexpr int TPITCH = 144, TTILE = 128 * TPITCH;
__device__ __forceinline__ void transpose_item(const float* W, int K, int N, bf16_t* WT, const float* gain, int item, int lane, LAS unsigned char* tile) {
    const int nblk = N / 128, kb = item / nblk, nb = item % nblk, k0 = 64 * kb, n0 = 128 * nb;
    f32x2 v[64];
    const float* src = W + (size_t)k0 * N + n0 + lane * 2;
#pragma unroll
    for (int kk = 0; kk < 64; ++kk) v[kk] = __builtin_nontemporal_load((const f32x2*)(src + (size_t)kk * N));
    if (gain) {
#pragma unroll
        for (int kk = 0; kk < 64; ++kk) v[kk] = v[kk] * gain[k0 + kk];
    }
#pragma unroll
    for (int i = 0; i < 2; ++i) {
        LAS unsigned char* row = tile + (lane * 2 + i) * TPITCH;
#pragma unroll
        for (int c = 0; c < 8; ++c) {
            u32x4 o; o.x = pk2(v[8 * c][i], v[8 * c + 1][i]); o.y = pk2(v[8 * c + 2][i], v[8 * c + 3][i]); o.z = pk2(v[8 * c + 4][i], v[8 * c + 5][i]); o.w = pk2(v[8 * c + 6][i], v[8 * c + 7][i]);
            *(LAS u32x4*)(row + c * 16) = o;
        }
    }
    LDS_WAIT();
    const int chunk = lane & 7, r8 = lane >> 3;
#pragma unroll
    for (int j = 0; j < 16; ++j) {
        const int rowi = r8 + 8 * j;
        const u32x4 o = *(const LAS u32x4*)(tile + rowi * TPITCH + chunk * 16);
        *(u32x4*)(WT + (size_t)(n0 + rowi) * K + k0 + chunk * 8) = o;
    }
    LDS_WAIT();
}

constexpr int I_AIN = 64 * 64, I_AOUT = 64 * 32, I_KV = 64 * 24, I_BOUT = 32 * 32, I_G = 4 * 2;
constexpr int N_PREP_ITEMS = 2 * I_AIN + 2 * I_AOUT + I_AIN + I_KV + I_AIN + 64 * I_G, N_ALL_ITEMS = N_PREP_ITEMS + 2 * I_BOUT;
__device__ __forceinline__ void convert_work(const Params& P, LAS unsigned char* lds, int lo, int hi, bool kvcopy, int vb, int nvb) {
    const KParams Pk = kparams();
    int tid = threadIdx.x; asm volatile("" : "+v"(tid));
    const int lane = tid & 63, w = __builtin_amdgcn_readfirstlane(tid >> 6);
    const int gw = vb * 8 + w, NGW = nvb * 8;
    unsigned char* ws = Pk->ws;
    LAS unsigned char* tile = lds + w * TTILE;
    if (kvcopy) {
        for (int g = 0; g < 3; ++g) {
            const int lb = 128 << (2 * g); const size_t per = (size_t)(lb - 1) * 256, tot = 8 * per;
            const f32x4* src = (const f32x4*)Pk->in[4 + g]; f32x4* dst = (f32x4*)(Pk->out + (g == 0 ? OUT_SKV0 : (g == 1 ? OUT_SKV1 : OUT_SKV2)));
            for (size_t i = (size_t)vb * 512 + tid; i < tot; i += (size_t)nvb * 512) { const size_t b = i / per, o = i - b * per; dst[b * (size_t)lb * 256 + o] = __builtin_nontemporal_load(src + b * (size_t)lb * 256 + 256 + o); }
        }
    }
    for (int it = lo + gw; it < hi; it += NGW) {
        int r = it;
        if (r < 2 * I_AIN) { const int l = r / I_AIN; transpose_item(Pk->in[8] + (size_t)l * 4096 * 8192, 4096, 8192, (bf16_t*)(ws + O_BT1) + (size_t)l * 8192 * 4096, Pk->in[7] + l * 4096, r % I_AIN, lane, tile); continue; } r -= 2 * I_AIN;
        if (r < 2 * I_AOUT) { const int l = r / I_AOUT; transpose_item(Pk->in[16] + (size_t)l * 4096 * 4096, 4096, 4096, (bf16_t*)(ws + O_BT2) + (size_t)l * 4096 * 4096, nullptr, r % I_AOUT, lane, tile); continue; } r -= 2 * I_AOUT;
        if (r < I_AIN) { transpose_item(Pk->in[22], 4096, 8192, (bf16_t*)(ws + O_BT3), Pk->in[21], r, lane, tile); continue; } r -= I_AIN;
        if (r < I_KV) { transpose_item(Pk->in[19], 4096, 3072, (bf16_t*)(ws + O_BT3) + (size_t)8192 * 4096, Pk->in[18], r, lane, tile); continue; } r -= I_KV;
        if (r < I_AIN) { transpose_item(Pk->in[22] + (size_t)4096 * 8192, 4096, 8192, (bf16_t*)(ws + O_BT4), Pk->in[21] + 4096, r, lane, tile); continue; } r -= I_AIN;
        if (r < 64 * I_G) { const int mat = r / I_G, gate = mat & 1, lh = mat >> 1;
            transpose_item((gate ? Pk->in[13] : Pk->in[11]) + (size_t)lh * 65536, 256, 256, (bf16_t*)(ws + O_WG) + (size_t)(lh * 2 + gate) * 65536, nullptr, r % I_G, lane, tile); continue; } r -= 64 * I_G;
        { const int l = r / I_BOUT; transpose_item(Pk->in[23] + (size_t)l * 2048 * 4096, 2048, 4096, (bf16_t*)(ws + O_BT5) + (size_t)l * 4096 * 2048, nullptr, r % I_BOUT, lane, tile); }
    }
}

__device__ __forceinline__ void prep_phase(const Params& P, LAS unsigned char* lds) {
    const KParams Pk = kparams();
    int tid = threadIdx.x; asm volatile("" : "+v"(tid));
    const int lane = tid & 63, w = __builtin_amdgcn_readfirstlane(tid >> 6);
    const int gw = blockIdx.x * 8 + w, NGW = gridDim.x * 8;
    unsigned char* ws = Pk->ws;
    { u64* gr = (u64*)(ws + O_GRAN); const size_t n = (8 * MiB) / 8; for (size_t i = (size_t)blockIdx.x * 512 + tid; i < n; i += (size_t)gridDim.x * 512) gr[i] = 0ull; }
    { bf16_t* XBF = (bf16_t*)(ws + O_XBF); float* RS = (float*)(ws + O_RS);
      for (int row = gw; row < TP + 8; row += NGW) {
          const float* xr = row < TP ? Pk->in[0] + (size_t)row * DM : Pk->in[1] + (size_t)(row - TP) * DM;
          const f32x4* x4 = (const f32x4*)xr + lane; f32x4 v[16]; float s = 0.f;
#pragma unroll
          for (int j = 0; j < 16; ++j) { v[j] = x4[64 * j]; s += (v[j].x * v[j].x + v[j].y * v[j].y) + (v[j].z * v[j].z + v[j].w * v[j].w); }
          s = wave_sum(s);
          const float rs = rsqrtf(s * (1.0f / DM) + EPSN);
          u32x2* o = (u32x2*)(XBF + (size_t)row * DM) + lane;
#pragma unroll
          for (int j = 0; j < 16; ++j) { u32x2 q; q.x = pk2(v[j].x * rs, v[j].y * rs); q.y = pk2(v[j].z * rs, v[j].w * rs); o[64 * j] = q; }
          if (lane == 0) RS[row] = rs;
      } }
}

template <int KSTEPS>
__device__ __forceinline__ void skinny_phase(const bf16_t* A, const bf16_t* Bt, int N, int K, float* sout, LAS unsigned char* lds) {
    int tid = threadIdx.x; asm volatile("" : "+v"(tid));
    const int lane = tid & 63, w = __builtin_amdgcn_readfirstlane(tid >> 6), fr = lane & 15, fq = lane >> 4;
    LAS float* red = (LAS float*)lds;
    const int ngroups = N / 16, k0 = w * (KSTEPS * 32);
    for (int grp = blockIdx.x; grp < ngroups; grp += gridDim.x) {
        const int n0 = grp * 16;
        const bf16_t* ap = A + (size_t)(fr & 7) * K + k0 + fq * 8; const bf16_t* bp = Bt + (size_t)(n0 + fr) * K + k0 + fq * 8;
        bf16x8 a[KSTEPS], b[KSTEPS];
#pragma unroll
        for (int s = 0; s < KSTEPS; ++s) { b[s] = __builtin_nontemporal_load((const bf16x8*)(bp + s * 32)); a[s] = *(const bf16x8*)(ap + s * 32); }
        f32x4 acc = {0.f, 0.f, 0.f, 0.f};
#pragma unroll
        for (int s = 0; s < KSTEPS; ++s) { if (fr >= 8) a[s] = (bf16x8){0, 0, 0, 0, 0, 0, 0, 0}; acc = __builtin_amdgcn_mfma_f32_16x16x32_bf16(a[s], b[s], acc, 0, 0, 0); }
        __syncthreads();
        if (fq < 2) {
#pragma unroll
            for (int i = 0; i < 4; ++i) red[(w * 8 + fq * 4 + i) * 16 + fr] = acc[i];
        }
        __syncthreads();
        if (tid < 128) { float s = 0.f;
#pragma unroll
            for (int ww = 0; ww < 8; ++ww) s += red[ww * 128 + tid];
            sout[(size_t)(tid >> 4) * N + n0 + (tid & 15)] = s; }
    }
}
__device__ __forceinline__ float part_sum(const float* sout, int N, int b, int col) { return sout[(size_t)b * N + col]; }

constexpr int SROW = 528;
__device__ __forceinline__ void scan_phase(const Params& P, LAS unsigned char* lds, int l) {
    const KParams Pk = kparams();
    const int tid0 = threadIdx.x;
    LAS unsigned char* RAW = lds;
    LAS unsigned char* AT = lds + 69632;
    unsigned char* ws = Pk->ws;
    const bf16_t* XB = (const bf16_t*)(ws + P_XB); const bf16_t* SG = (const bf16_t*)(ws + P_SG); bf16_t* HG = (bf16_t*)(ws + P_HG);
    const float* SOUT = (const float*)(ws + O_PART); const float* RS = (const float*)(ws + O_RS);
    const float* cwp = Pk->in[9] + (size_t)l * 4 * 4096; const float* cbp = Pk->in[10] + (size_t)l * 4096;
    bf16x8 bR[8], bI[8]; int cur = -1;
    for (int t = blockIdx.x; t < 32 + 2048; t += gridDim.x) {
        int tid = tid0; asm volatile("" : "+v"(tid));
        const int lane = tid & 63, w = __builtin_amdgcn_readfirstlane(tid >> 6), fr = lane & 15, fq = lane >> 4;
        const bool is_s = t < 32;
        int hh2, n = 0, sp = 0;
        if (is_s) hh2 = t; else { const int idx = t - 32; hh2 = idx & 31; n = (idx >> 5) & 3; sp = idx >> 7; }
        const int head = hh2 >> 1, half = hh2 & 1, gc0 = head * 256, hc = half * 128 + w * 16 + fr, gch = gc0 + hc, r0 = n * 2048 + sp * 128;
        if (hh2 != cur) {
            const bf16_t* wp = (const bf16_t*)(ws + O_WG) + (size_t)((l * 16 + head) * 2) * 65536 + (size_t)hc * 256 + fq * 8;
#pragma unroll
            for (int ks = 0; ks < 8; ++ks) { bR[ks] = *(const bf16x8*)(wp + ks * 32); bI[ks] = *(const bf16x8*)(wp + 65536 + ks * 32); }
            cur = hh2;
        }
        __syncthreads();
        if (is_s) {
            const int b = tid >> 6, ch = (tid & 63) * 4;
            float xc[4][4];
#pragma unroll
            for (int e = 0; e < 4; ++e) {
                const int gc = gc0 + ch + e;
#pragma unroll
                for (int k = 0; k < 3; ++k) xc[k][e] = Pk->in[2][((size_t)(l * 8 + b) * 3 + k) * 4096 + gc];
                xc[3][e] = SOUT[(size_t)b * 8192 + gc];
            }
            float o[4];
#pragma unroll
            for (int e = 0; e < 4; ++e) {
                const int gc = gc0 + ch + e; float v = cbp[gc];
#pragma unroll
                for (int k = 0; k < 4; ++k) v += xc[k][e] * cwp[k * 4096 + gc];
                o[e] = v;
                if (half == 0) {
#pragma unroll
                    for (int k = 0; k < 3; ++k) Pk->out[OUT_SCONV + ((size_t)(l * 8 + b) * 3 + k) * 4096 + gc] = xc[k + 1][e];
                }
            }
            u32x2 q; q.x = pk2(o[0], o[1]); q.y = pk2(o[2], o[3]);
            *(LAS u32x2*)(AT + b * SROW + ch * 2) = q;
        } else {
#pragma unroll
            for (int j = 0; j < 9; ++j) {
                const int id = tid + 512 * j, i = id >> 5, c8 = id & 31;
                if (i < 131) {
                    u32x4 v = {0u, 0u, 0u, 0u};
                    if (!(sp == 0 && i < 3)) v = *(const u32x4*)(XB + (size_t)(r0 - 3 + i) * 4096 + gc0 + c8 * 8);
                    *(LAS u32x4*)(RAW + i * SROW + c8 * 16) = v;
                }
            }
            __syncthreads();
            const int c8 = tid & 31; float wk[4][8], bb[8];
#pragma unroll
            for (int e = 0; e < 8; ++e) { bb[e] = cbp[gc0 + c8 * 8 + e];
#pragma unroll
                for (int k = 0; k < 4; ++k) wk[k][e] = cwp[k * 4096 + gc0 + c8 * 8 + e]; }
#pragma unroll
            for (int j = 0; j < 8; ++j) {
                const int i = (tid >> 5) + 16 * j;
                float o[8];
#pragma unroll
                for (int e = 0; e < 8; ++e) o[e] = bb[e];
                u32x4 last;
#pragma unroll
                for (int k = 0; k < 4; ++k) {
                    const u32x4 v = *(const LAS u32x4*)(RAW + (i + k) * SROW + c8 * 16); last = v;
                    o[0] += bflo(v.x) * wk[k][0]; o[1] += bfhi(v.x) * wk[k][1]; o[2] += bflo(v.y) * wk[k][2]; o[3] += bfhi(v.y) * wk[k][3];
                    o[4] += bflo(v.z) * wk[k][4]; o[5] += bfhi(v.z) * wk[k][5]; o[6] += bflo(v.w) * wk[k][6]; o[7] += bfhi(v.w) * wk[k][7];
                }
                u32x4 q; q.x = pk2(o[0], o[1]); q.y = pk2(o[2], o[3]); q.z = pk2(o[4], o[5]); q.w = pk2(o[6], o[7]);
                *(LAS u32x4*)(AT + i * SROW + c8 * 16) = q;
                if (sp == 15 && i >= 125 && half == 0) {
                    float* d = Pk->out + OUT_PCONV + ((size_t)(l * 4 + n) * 3 + (i - 125)) * 4096 + gc0 + c8 * 8;
                    f32x4 a = {bflo(last.x), bfhi(last.x), bflo(last.y), bfhi(last.y)}, b = {bflo(last.z), bfhi(last.z), bflo(last.w), bfhi(last.w)};
                    *(f32x4*)d = a; *(f32x4*)(d + 4) = b;
                }
            }
        }
        __syncthreads();
        f32x4 aR[8], aI[8];
#pragma unroll
        for (int mt = 0; mt < 8; ++mt) { aR[mt] = (f32x4){0.f, 0.f, 0.f, 0.f}; aI[mt] = (f32x4){0.f, 0.f, 0.f, 0.f}; }
#pragma unroll
        for (int ks = 0; ks < 8; ++ks) {
#pragma unroll
            for (int mt = 0; mt < 8; ++mt) {
                const bf16x8 a = *(const LAS bf16x8*)(AT + (mt * 16 + fr) * SROW + (ks * 32 + fq * 8) * 2);
                aR[mt] = __builtin_amdgcn_mfma_f32_16x16x32_bf16(a, bR[ks], aR[mt], 0, 0, 0);
                aI[mt] = __builtin_amdgcn_mfma_f32_16x16x32_bf16(a, bI[ks], aI[mt], 0, 0, 0);
            }
            __builtin_amdgcn_sched_barrier(0);
        }
        const float bga = Pk->in[12][(size_t)l * 4096 + gch], bgx = Pk->in[14][(size_t)l * 4096 + gch];
        const float lamc = -8.0f * log1pf(expf(-Pk->in[15][(size_t)l * 4096 + gch]));
#pragma unroll
        for (int mt = 0; mt < 8; ++mt)
#pragma unroll
            for (int i = 0; i < 4; ++i) {
                const int row = mt * 16 + 4 * fq + i;
                const float r = sigm_f(aR[mt][i] + bga), ig = sigm_f(aI[mt][i] + bgx);
                const float la = lamc * r, a = __expf(la);
                const float em = fmaf(-a, a, 1.0f);
                const float xf = bf2f(*(const LAS bf16_t*)(AT + row * SROW + hc * 2));
                aR[mt][i] = a; aI[mt][i] = __builtin_amdgcn_sqrtf(em) * ig * xf;
            }
        if (is_s) {
            if (fq < 2) {
#pragma unroll
                for (int i = 0; i < 4; ++i) {
                    const int b = 4 * fq + i;
                    const float h0 = Pk->in[3][(size_t)(l * 8 + b) * 4096 + gch];
                    const float h = aR[0][i] * h0 + aI[0][i];
                    Pk->out[OUT_SH + (size_t)(l * 8 + b) * 4096 + gch] = h;
                    const float sg = silu_f(SOUT[(size_t)b * 8192 + 4096 + gch]);
                    HG[(size_t)(TP + b) * 4096 + gch] = (bf16_t)(pk2(h * sg, 0.f) & 0xffffu);
                }
            }
            continue;
        }
        float Pp = 1.f, Cc = 0.f;
#pragma unroll
        for (int mt = 0; mt < 8; ++mt) {
            float A = aR[mt][0], H = aI[mt][0];
#pragma unroll
            for (int i = 1; i < 4; ++i) { const float a = aR[mt][i], b = aI[mt][i]; H = a * H + b; A = A * a; aR[mt][i] = A; aI[mt][i] = H; }
            float Pm = 1.f, Cm = 0.f;
#pragma unroll
            for (int q = 0; q < 4; ++q) {
                const float qA = __shfl(A, fr + 16 * q), qH = __shfl(H, fr + 16 * q);
                if (q == fq) { Pm = Pp; Cm = Cc; }
                Cc = qA * Cc + qH; Pp = Pp * qA;
            }
#pragma unroll
            for (int i = 0; i < 4; ++i) { aI[mt][i] += aR[mt][i] * Cm; aR[mt][i] *= Pm; }
        }
        u64* gr = (u64*)(ws + O_GRAN) + (((size_t)l * 4 + n) * 16 + sp) * 4096 + gch;
        const unsigned tag = 1u + (unsigned)l;
        float H0 = 0.f;
        if (sp > 0) {
            const u64* pg = gr - 4096; u64 x = 0; unsigned spins = 0;
            for (;;) {
                x = __hip_atomic_load(pg, __ATOMIC_RELAXED, __HIP_MEMORY_SCOPE_AGENT);
                if (__all((unsigned)(x >> 32) == tag)) break;
                if (++spins > (1u << 22)) break;
                __builtin_amdgcn_s_sleep(1);
            }
            H0 = __uint_as_float((unsigned)x);
        }
        const float hend = Cc + Pp * H0;
        if (fq == 0) {
            __hip_atomic_store(gr, ((u64)tag << 32) | (u64)__float_as_uint(hend), __ATOMIC_RELAXED, __HIP_MEMORY_SCOPE_AGENT);
            if (sp == 15) Pk->out[OUT_PH + (size_t)(l * 4 + n) * 4096 + gch] = hend;
        }
        __syncthreads();
#pragma unroll
        for (int mt = 0; mt < 8; ++mt)
#pragma unroll
            for (int i = 0; i < 4; ++i) {
                const int row = mt * 16 + 4 * fq + i;
                const float h = aI[mt][i] + aR[mt][i] * H0;
                *(LAS bf16_t*)(AT + row * SROW + hc * 2) = (bf16_t)(pk2(h, 0.f) & 0xffffu);
            }
        __syncthreads();
        {
            const int c8 = tid & 15;
#pragma unroll
            for (int j = 0; j < 4; ++j) {
                const int i = (tid >> 4) + 32 * j;
                const u32x4 hv = *(const LAS u32x4*)(AT + i * SROW + (half * 128 + c8 * 8) * 2);
                const size_t go = (size_t)(r0 + i) * 4096 + gc0 + half * 128 + c8 * 8;
                const u32x4 sv = *(const u32x4*)(SG + go);
                u32x4 q; q.x = pk2(bflo(hv.x) * bflo(sv.x), bfhi(hv.x) * bfhi(sv.x)); q.y = pk2(bflo(hv.y) * bflo(sv.y), bfhi(hv.y) * bfhi(sv.y));
                q.z = pk2(bflo(hv.z) * bflo(sv.z), bfhi(hv.z) * bfhi(sv.z)); q.w = pk2(bflo(hv.w) * bflo(sv.w), bfhi(hv.w) * bfhi(sv.w));
                *(u32x4*)(HG + go) = q;
            }
        }
    }
}

__device__ __forceinline__ void post_phase(const Params& P, int L) {
    const KParams Pk = kparams();
    int tid = threadIdx.x; asm volatile("" : "+v"(tid));
    const int lane = tid & 63, w = __builtin_amdgcn_readfirstlane(tid >> 6);
    const int gw = blockIdx.x * 8 + w, NGW = gridDim.x * 8;
    unsigned char* ws = Pk->ws;
    const float* gain = L < 2 ? Pk->in[17] + (size_t)L * 4096 : Pk->in[24] + (size_t)(L - 2) * 4096;
    const bf16_t* Y = (const bf16_t*)(ws + O_Y); const float* SSQP = (const float*)(ws + O_SSQP); const float* SOUT = (const float*)(ws + O_PART);
    bf16_t* XBF = (bf16_t*)(ws + O_XBF); float* RS = (float*)(ws + O_RS);
    for (int row = gw; row < TP + 8; row += NGW) {
        const bool smp = row >= TP; const int b = row - TP;
        float ssq; f32x4 y0[8], y1[8], x0[8], x1[8];
        if (!smp) {
            ssq = SSQP[(size_t)row * 64 + lane];
#pragma unroll
            for (int j = 0; j < 8; ++j) { const u32x4 yv = *(const u32x4*)(Y + (size_t)row * 4096 + j * 512 + lane * 8);
                y0[j] = (f32x4){bflo(yv.x), bfhi(yv.x), bflo(yv.y), bfhi(yv.y)}; y1[j] = (f32x4){bflo(yv.z), bfhi(yv.z), bflo(yv.w), bfhi(yv.w)}; }
        } else {
            ssq = 0.f;
#pragma unroll
            for (int j = 0; j < 8; ++j) { const float* sp = SOUT + (size_t)b * 4096 + j * 512 + lane * 8; y0[j] = *(const f32x4*)sp; y1[j] = *(const f32x4*)(sp + 4);
                ssq += (y0[j].x * y0[j].x + y0[j].y * y0[j].y) + (y0[j].z * y0[j].z + y0[j].w * y0[j].w) + (y1[j].x * y1[j].x + y1[j].y * y1[j].y) + (y1[j].z * y1[j].z + y1[j].w * y1[j].w); }
        }
        if (L == 0) {
            const float* xin = (smp ? Pk->in[1] + (size_t)b * 4096 : Pk->in[0] + (size_t)row * 4096);
#pragma unroll
            for (int j = 0; j < 8; ++j) { x0[j] = *(const f32x4*)(xin + j * 512 + lane * 8); x1[j] = *(const f32x4*)(xin + j * 512 + lane * 8 + 4); }
        } else {
            const float irs = 1.0f / RS[row];
#pragma unroll
            for (int j = 0; j < 8; ++j) { const u32x4 xv = *(const u32x4*)(XBF + (size_t)row * 4096 + j * 512 + lane * 8);
                x0[j] = (f32x4){bflo(xv.x), bfhi(xv.x), bflo(xv.y), bfhi(xv.y)} * irs; x1[j] = (f32x4){bflo(xv.z), bfhi(xv.z), bflo(xv.w), bfhi(xv.w)} * irs; }
        }
        const float rsn = rsqrtf(wave_sum(ssq) * (1.0f / 4096.0f) + EPSN);
        float acc = 0.f;
        float* xout = Pk->out + (smp ? OUT_YS + (size_t)b * 4096 : OUT_YP + (size_t)row * 4096);
#pragma unroll
        for (int j = 0; j < 8; ++j) {
            const int col = j * 512 + lane * 8;
            const f32x4 g0 = *(const f32x4*)(gain + col), g1 = *(const f32x4*)(gain + col + 4);
            const f32x4 n0 = x0[j] + y0[j] * rsn * g0, n1 = x1[j] + y1[j] * rsn * g1;
            acc += (n0.x * n0.x + n0.y * n0.y) + (n0.z * n0.z + n0.w * n0.w) + (n1.x * n1.x + n1.y * n1.y) + (n1.z * n1.z + n1.w * n1.w);
            if (L == 3) { *(f32x4*)(xout + col) = n0; *(f32x4*)(xout + col + 4) = n1; }
            x0[j] = n0; x1[j] = n1;
        }
        acc = wave_sum(acc);
        const float rsx = rsqrtf(acc * (1.0f / 4096.0f) + EPSN);
        if (L < 3) {
#pragma unroll
            for (int j = 0; j < 8; ++j) { const int col = j * 512 + lane * 8; const f32x4 n0 = x0[j] * rsx, n1 = x1[j] * rsx;
                u32x4 q; q.x = pk2(n0.x, n0.y); q.y = pk2(n0.z, n0.w); q.z = pk2(n1.x, n1.y); q.w = pk2(n1.z, n1.w); *(u32x4*)(XBF + (size_t)row * 4096 + col) = q; }
        }
        if (lane == 0) RS[row] = rsx;
    }
}

constexpr int KROW = 272, VROW = 320, OFF_VS = 69632, OFF_BI = OFF_VS + 81920, OFF_SW = OFF_BI + 2112;
__device__ __forceinline__ void attn_item(const Params& P, LAS unsigned char* lds, int item) {
    const KParams Pk = kparams();
    int tid = threadIdx.x; asm volatile("" : "+v"(tid));
    const int lane = tid & 63, w = __builtin_amdgcn_readfirstlane(tid >> 6), hh = lane >> 5, l32 = lane & 31;
    unsigned char* ws = Pk->ws;
    const bf16_t* Q = (const bf16_t*)(ws + P_Q); const bf16_t* KVB = (const bf16_t*)(ws + O_KVB); bf16_t* ON = (bf16_t*)(ws + P_ON); float* LSE = (float*)(ws + O_LSE);
    const int g = item >> 8, rem = item & 255, n = rem >> 6, kvh = rem & 3, cb = (rem >> 2) & 15;
    const int r = 1 << (2 * g), nb = 16 >> (2 * g), c = cb / nb, nbi = cb % nb;
    LAS unsigned char* Ks = lds; LAS unsigned char* Vs = lds + OFF_VS; LAS float* BI = (LAS float*)(lds + OFF_BI);
    __syncthreads();
#pragma unroll
    for (int j = 0; j < 8; ++j) {
        const int id = tid + 512 * j, kk = id >> 4, chk = id & 15, pos = (nbi - 1) * 128 + kk;
        u32x4 kv = {0u, 0u, 0u, 0u}, vv = {0u, 0u, 0u, 0u};
        if (pos >= 0) { const bf16_t* src = KVB + (size_t)(n * 2048 + pos * r + c) * 3072 + g * 1024 + kvh * 128 + chk * 8; kv = *(const u32x4*)src; vv = *(const u32x4*)(src + 512); }
        *(LAS u32x4*)(Ks + kk * KROW + chk * 16) = kv; *(LAS u32x4*)(Vs + kk * VROW + chk * 16) = vv;
    }
    for (int e = tid; e < 516; e += 512) { const int hl = e / 129, dist = e % 129; BI[hl * 132 + dist] = 1.4426950408889634f * Pk->in[20][rel_bucket(dist * r) * 48 + g * 16 + kvh * 4 + hl]; }
    __syncthreads();
    const float scale2 = 0.08838834764831845f * 1.4426950408889634f;
    const int qc = w & 3, qq = qc * 32 + l32, qrow = n * 2048 + (nbi * 128 + qq) * r + c;
    bf16x8 Qf[8];
    { const bf16_t* qp = Q + (size_t)qrow * 6144 + g * 2048 + (kvh * 4 + (w >> 2)) * 128 + hh * 8;
#pragma unroll
      for (int s = 0; s < 8; ++s) Qf[s] = *(const bf16x8*)(qp + s * 16); }
    for (int pp = 0; pp < 2; ++pp) {
        const int hl = (w >> 2) + 2 * pp, slot = kvh * 4 + hl;
        f32x16 S[5];
#pragma unroll
        for (int kt = 0; kt < 5; ++kt) {
#pragma unroll
            for (int e = 0; e < 16; ++e) S[kt][e] = 0.f;
            if (nbi > 0 || qc + kt >= 4) {
#pragma unroll
                for (int s = 0; s < 8; ++s) {
                    const bf16x8 a = *(const LAS bf16x8*)(Ks + (qc * 32 + kt * 32 + l32) * KROW + (s * 16 + hh * 8) * 2);
                    S[kt] = MFMA32(a, Qf[s], S[kt]);
                }
            }
            __builtin_amdgcn_sched_barrier(0);
        }
        if (pp == 0) {
            const bf16_t* qp = Q + (size_t)qrow * 6144 + g * 2048 + (slot + 2) * 128 + hh * 8;
#pragma unroll
            for (int s = 0; s < 8; ++s) Qf[s] = *(const bf16x8*)(qp + s * 16);
        }
        float m = -INFINITY;
#pragma unroll
        for (int kt = 0; kt < 5; ++kt) {
            const bool on = nbi > 0 || qc + kt >= 4;
            const LAS float* bp = BI + hl * 132 + (128 - 32 * kt - 27 - 4 * hh) + l32;
#pragma unroll
            for (int reg = 0; reg < 16; ++reg) {
                const int kc = (reg & 3) + 8 * (reg >> 2);
                float sv = S[kt][reg] * scale2 + bp[27 - kc];
                if (kt == 0) sv = (kc + 4 * hh >= l32) ? sv : -INFINITY;
                if (kt == 4) sv = (kc + 4 * hh <= l32) ? sv : -INFINITY;
                if (!on) sv = -INFINITY;
                S[kt][reg] = sv; m = fmaxf(m, sv);
            }
            __builtin_amdgcn_sched_barrier(0);
        }
        m = fmaxf(m, __shfl_xor(m, 32));
        float den = 0.f;
#pragma unroll
        for (int kt = 0; kt < 5; ++kt)
#pragma unroll
            for (int reg = 0; reg < 16; ++reg) { const float p = __builtin_amdgcn_exp2f(S[kt][reg] - m); S[kt][reg] = p; den += p; }
        den += __shfl_xor(den, 32);
        f32x16 O[4];
#pragma unroll
        for (int dt = 0; dt < 4; ++dt)
#pragma unroll
            for (int e = 0; e < 16; ++e) O[dt][e] = 0.f;
        const int q_ = (lane & 15) >> 2, p_ = lane & 3, cg16 = (lane >> 4) & 1;
#pragma unroll
        for (int kt = 0; kt < 5; ++kt) {
            if (nbi > 0 || qc + kt >= 4) {
#pragma unroll
                for (int s2 = 0; s2 < 2; ++s2) {
                    u32x4 pw; pw.x = pk2(S[kt][8 * s2 + 0], S[kt][8 * s2 + 1]); pw.y = pk2(S[kt][8 * s2 + 2], S[kt][8 * s2 + 3]); pw.z = pk2(S[kt][8 * s2 + 4], S[kt][8 * s2 + 5]); pw.w = pk2(S[kt][8 * s2 + 6], S[kt][8 * s2 + 7]);
                    const bf16x8 pf = __builtin_bit_cast(bf16x8, pw);
                    const int R0 = qc * 32 + kt * 32 + 16 * s2 + 4 * hh;
#pragma unroll
                    for (int dt = 0; dt < 4; ++dt) {
                        LAS unsigned char* ad = Vs + (R0 + q_) * VROW + (dt * 32 + 16 * cg16 + 4 * p_) * 2;
                        const s16x4 lo = __builtin_amdgcn_ds_read_tr16_b64_v4i16((LAS s16x4*)ad), hi = __builtin_amdgcn_ds_read_tr16_b64_v4i16((LAS s16x4*)(ad + 8 * VROW));
                        bf16x8 a; a[0] = lo[0]; a[1] = lo[1]; a[2] = lo[2]; a[3] = lo[3]; a[4] = hi[0]; a[5] = hi[1]; a[6] = hi[2]; a[7] = hi[3];
                        O[dt] = MFMA32(a, pf, O[dt]);
                    }
                    __builtin_amdgcn_sched_barrier(0);
                }
            }
        }
        const float inv = __builtin_amdgcn_rcpf(den);
        bf16_t* op = ON + ((size_t)g * RP + qrow) * 2048 + slot * 128 + 8 * hh;
#pragma unroll
        for (int dt = 0; dt < 4; ++dt)
#pragma unroll
            for (int p2 = 0; p2 < 2; ++p2) {
                const unsigned a0 = pk2(O[dt][8 * p2 + 0] * inv, O[dt][8 * p2 + 1] * inv), a1 = pk2(O[dt][8 * p2 + 2] * inv, O[dt][8 * p2 + 3] * inv);
                const unsigned b0 = pk2(O[dt][8 * p2 + 4] * inv, O[dt][8 * p2 + 5] * inv), b1 = pk2(O[dt][8 * p2 + 6] * inv, O[dt][8 * p2 + 7] * inv);
                const auto s0 = __builtin_amdgcn_permlane32_swap(a0, b0, false, false), s1 = __builtin_amdgcn_permlane32_swap(a1, b1, false, false);
                u32x4 q; q.x = s0[0]; q.y = s1[0]; q.z = s0[1]; q.w = s1[1];
                *(u32x4*)(op + dt * 32 + 16 * p2) = q;
            }
        if (hh == 0) LSE[((size_t)g * RP + qrow) * 16 + slot] = (m + __builtin_amdgcn_logf(den)) * 0.6931471805599453f;
    }
}

__device__ __forceinline__ void sample_attn(const Params& P, LAS unsigned char* lds, int si, int lbi, int wv) {
    const KParams Pk = kparams();
    int tid = threadIdx.x; asm volatile("" : "+v"(tid));
    const int lane = tid & 63;
    unsigned char* ws = Pk->ws;
    const float* PART = (const float*)(ws + O_PART); const float* RS = (const float*)(ws + O_RS); bf16_t* ON = (bf16_t*)(ws + P_ON); float* LSE = (float*)(ws + O_LSE);
    const int b = si / 48, rem = si % 48, g = rem >> 4, slot = rem & 15, kvh = slot >> 2, r = 1 << (2 * g), lbuf = 128 << (2 * g);
    const int N = lbi == 0 ? 11264 : 8192;
    const float* state = Pk->in[4 + g]; float* skv = Pk->out + (g == 0 ? OUT_SKV0 : (g == 1 ? OUT_SKV1 : OUT_SKV2));
    LAS float* qs = (LAS float*)(lds + OFF_SW + wv * 2064); LAS float* pw = qs + 128; LAS float* kn = qs + 260; LAS float* vn = qs + 388;
#pragma unroll
    for (int e = 0; e < 2; ++e) {
        const int d = lane * 2 + e;
        qs[d] = part_sum(PART, N, b, g * 2048 + slot * 128 + d);
        float kvl, vvl;
        if (lbi == 0) { kvl = part_sum(PART, N, b, 8192 + g * 1024 + kvh * 128 + d); vvl = part_sum(PART, N, b, 8192 + g * 1024 + 512 + kvh * 128 + d);
            if ((slot & 3) == 0) { float* dst = skv + ((size_t)(b * lbuf + lbuf - 1) * 2) * 512 + kvh * 128 + d; dst[0] = kvl; dst[512] = vvl; } }
        else { const float* srcp = skv + ((size_t)(b * lbuf + lbuf - 1) * 2) * 512 + kvh * 128 + d; kvl = srcp[0]; vvl = srcp[512]; }
        kn[d] = kvl; vn[d] = vvl;
    }
    LDS_WAIT();
    const float scale = 0.08838834764831845f;
    float m = -INFINITY;
#pragma unroll 1
    for (int rd = 0; rd < 3; ++rd) {
        const int step = lane + 64 * rd; float s = -INFINITY;
        if (step <= 128) {
            float dot = 0.f;
            if (step == 0) {
#pragma unroll 8
                for (int d = 0; d < 128; ++d) dot += qs[d] * kn[d]; }
            else { const f32x4* kr = (const f32x4*)(state + ((size_t)(b * lbuf + lbuf - step * r) * 2) * 512 + kvh * 128);
                f32x4 kv[32];
#pragma unroll
                for (int d4 = 0; d4 < 32; ++d4) kv[d4] = kr[d4];
#pragma unroll
                for (int d4 = 0; d4 < 32; ++d4) { const f32x4 qv = *(const LAS f32x4*)(qs + d4 * 4); dot += (kv[d4].x * qv.x + kv[d4].y * qv.y) + (kv[d4].z * qv.z + kv[d4].w * qv.w); } }
            s = dot * scale + Pk->in[20][rel_bucket(step * r) * 48 + g * 16 + slot];
            pw[step] = s;
        }
        m = fmaxf(m, s);
    }
    m = wave_max(m);
    LDS_WAIT();
    float den = 0.f;
#pragma unroll
    for (int rd = 0; rd < 3; ++rd) { const int step = lane + 64 * rd; if (step <= 128) { const float p = __expf(pw[step] - m); den += p; pw[step] = p; } }
    den = wave_sum(den);
    LDS_WAIT();
    float o0 = pw[0] * vn[lane * 2], o1 = pw[0] * vn[lane * 2 + 1];
#pragma unroll 1
    for (int s0 = 1; s0 <= 128; s0 += 32) {
        f32x2 v[32];
#pragma unroll
        for (int j = 0; j < 32; ++j) v[j] = *(const f32x2*)(state + ((size_t)(b * lbuf + lbuf - (s0 + j) * r) * 2 + 1) * 512 + kvh * 128 + lane * 2);
#pragma unroll
        for (int j = 0; j < 32; ++j) { const float p = pw[s0 + j]; o0 += p * v[j].x; o1 += p * v[j].y; }
    }
    const float inv = 1.0f / den;
    *(unsigned*)(ON + ((size_t)g * RP + TP + b) * 2048 + slot * 128 + lane * 2) = pk2(o0 * inv, o1 * inv);
    if (lane == 0) LSE[((size_t)g * RP + TP + b) * 16 + slot] = m + __logf(den);
    LDS_WAIT();
}

__device__ __forceinline__ void combine_phase(const Params& P, int lbi) {
    const KParams Pk = kparams();
    int tid = threadIdx.x; asm volatile("" : "+v"(tid));
    const int lane = tid & 63, w = __builtin_amdgcn_readfirstlane(tid >> 6);
    const int gw = blockIdx.x * 8 + w, NGW = gridDim.x * 8;
    unsigned char* ws = Pk->ws;
    const bf16_t* ON = (const bf16_t*)(ws + P_ON); const float* LSE = (const float*)(ws + O_LSE); const bf16_t* SG2 = (const bf16_t*)(ws + O_SG2); bf16_t* OG = (bf16_t*)(ws + O_OG);
    const float* PART = (const float*)(ws + O_PART); const float* RS = (const float*)(ws + O_RS);
    const int N = lbi == 0 ? 11264 : 8192;
    for (int row = gw; row < TP + 8; row += NGW) {
#pragma unroll
        for (int cch = 0; cch < 4; ++cch) {
            const int col = cch * 512 + lane * 8, slot = col >> 7;
            const float l0 = LSE[((size_t)0 * RP + row) * 16 + slot], l1 = LSE[((size_t)1 * RP + row) * 16 + slot], l2 = LSE[((size_t)2 * RP + row) * 16 + slot];
            const float mx = fmaxf(l0, fmaxf(l1, l2)); float w0 = __expf(l0 - mx), w1 = __expf(l1 - mx), w2 = __expf(l2 - mx);
            const float iw = 1.0f / (w0 + w1 + w2); w0 *= iw; w1 *= iw; w2 *= iw;
            const u32x4 a0 = *(const u32x4*)(ON + ((size_t)0 * RP + row) * 2048 + col), a1 = *(const u32x4*)(ON + ((size_t)1 * RP + row) * 2048 + col), a2 = *(const u32x4*)(ON + ((size_t)2 * RP + row) * 2048 + col);
            float gt[8];
            if (row < TP) { const u32x4 sv = *(const u32x4*)(SG2 + (size_t)row * 2048 + col);
                gt[0] = bflo(sv.x); gt[1] = bfhi(sv.x); gt[2] = bflo(sv.y); gt[3] = bfhi(sv.y); gt[4] = bflo(sv.z); gt[5] = bfhi(sv.z); gt[6] = bflo(sv.w); gt[7] = bfhi(sv.w); }
            else { const int b = row - TP;
#pragma unroll
                for (int e = 0; e < 8; ++e) gt[e] = silu_f(part_sum(PART, N, b, 6144 + col + e)); }
            float o[8];
            o[0] = w0 * bflo(a0.x) + w1 * bflo(a1.x) + w2 * bflo(a2.x); o[1] = w0 * bfhi(a0.x) + w1 * bfhi(a1.x) + w2 * bfhi(a2.x);
            o[2] = w0 * bflo(a0.y) + w1 * bflo(a1.y) + w2 * bflo(a2.y); o[3] = w0 * bfhi(a0.y) + w1 * bfhi(a1.y) + w2 * bfhi(a2.y);
            o[4] = w0 * bflo(a0.z) + w1 * bflo(a1.z) + w2 * bflo(a2.z); o[5] = w0 * bfhi(a0.z) + w1 * bfhi(a1.z) + w2 * bfhi(a2.z);
            o[6] = w0 * bflo(a0.w) + w1 * bflo(a1.w) + w2 * bflo(a2.w); o[7] = w0 * bfhi(a0.w) + w1 * bfhi(a1.w) + w2 * bfhi(a2.w);
            u32x4 q; q.x = pk2(o[0] * gt[0], o[1] * gt[1]); q.y = pk2(o[2] * gt[2], o[3] * gt[3]); q.z = pk2(o[4] * gt[4], o[5] * gt[5]); q.w = pk2(o[6] * gt[6], o[7] * gt[7]);
            *(u32x4*)(OG + (size_t)row * 2048 + col) = q;
        }
    }
}

__global__ __launch_bounds__(512, 2) void yoco_mega(Params P) {
    extern __shared__ __attribute__((aligned(16))) unsigned char shm[];
    LAS unsigned char* lds = (LAS unsigned char*)shm;
    cg::grid_group grid = cg::this_grid();
    const KParams Pk = kparams();
    unsigned char* ws = Pk->ws;
    const int w = threadIdx.x >> 6;
    if (threadIdx.x == 0) { *(LAS u32x4*)(lds + OFF_XB) = (u32x4){0u, 0u, 0u, 0u}; }
    __syncthreads();
    const XcdBarrier xb = xcd_barrier_post((unsigned*)(ws + O_BAR), (volatile LAS unsigned*)(lds + OFF_XB));
    prep_phase(P, lds);
    convert_work(P, lds, 0, N_PREP_ITEMS, false, (int)blockIdx.x, (int)gridDim.x);
    grid.sync();
    for (int L = 0; L < 4; ++L) {
        for (int half = 0; half < 2; ++half) {
            pg8::Gemm gm; Epi E; gm.M = TP;
            E.rs = (const float*)(ws + O_RS); E.ssqp = (float*)(ws + O_SSQP); E.outp = Pk->out; E.o2 = (bf16_t*)(ws + O_KVB);
            if (half == 0) {
                gm.A = (const bf16_t*)(ws + O_XBF); gm.K = 4096;
                if (L < 2) { gm.Bt = (const bf16_t*)(ws + O_BT1) + (size_t)L * 8192 * 4096; gm.N = 8192; E.mode = 0; E.o0 = (bf16_t*)(ws + P_XB); E.o1 = (bf16_t*)(ws + P_SG); }
                else { gm.Bt = (const bf16_t*)(ws + (L == 2 ? O_BT3 : O_BT4)); gm.N = L == 2 ? 11264 : 8192; E.mode = 2; E.o0 = (bf16_t*)(ws + P_Q); E.o1 = (bf16_t*)(ws + O_SG2); }
            } else {
                E.mode = 1; E.o0 = (bf16_t*)(ws + O_Y); E.o1 = E.o0; gm.N = 4096;
                if (L < 2) { gm.A = (const bf16_t*)(ws + P_HG); gm.Bt = (const bf16_t*)(ws + O_BT2) + (size_t)L * 4096 * 4096; gm.K = 4096; }
                else { gm.A = (const bf16_t*)(ws + O_OG); gm.Bt = (const bf16_t*)(ws + O_BT5) + (size_t)(L - 2) * 4096 * 2048; gm.K = 2048; }
            }
            pg8::StaticOrder S; S.init(gm.M, gm.N, (int)gridDim.x, (int)blockIdx.x);
            pg8::gemm_phase<Epi, pg8::StaticOrder, false>(lds, gm, S, E, nullptr);
            if (L == 2 && half == 0) {
                const int nwg = (gm.M / 256) * (gm.N / 256), G = (int)gridDim.x, fi = nwg - ((nwg - 1) / G) * G;
                int vb = (int)blockIdx.x, nvb = G;
                if (fi < G) { vb = (int)blockIdx.x - fi; nvb = vb >= 0 ? G - fi : 0; }
                __syncthreads();
                if (nvb > 0) convert_work(P, lds, N_PREP_ITEMS, N_ALL_ITEMS, true, vb, nvb);
            }
            __syncthreads();
            if (gm.K == 4096) skinny_phase<16>(gm.A + (size_t)TP * gm.K, gm.Bt, gm.N, gm.K, (float*)(ws + O_PART), lds);
            else skinny_phase<8>(gm.A + (size_t)TP * gm.K, gm.Bt, gm.N, gm.K, (float*)(ws + O_PART), lds);
            xcd_barrier(xb);
            if (half == 0) {
                if (L < 2) {
                    scan_phase(P, lds, L);
                } else {
                    for (int wv = 0; wv < 2; ++wv) { const int si = wv * 256 + (int)blockIdx.x; if (si < 384 && w == wv && gridDim.x >= 256) sample_attn(P, lds, si, L - 2, wv); }
                    if (gridDim.x < 256 && w < 2) for (int si = blockIdx.x * 2 + w; si < 384; si += gridDim.x * 2) sample_attn(P, lds, si, L - 2, w);
                    for (int it = blockIdx.x; it < 768; it += gridDim.x) attn_item(P, lds, it);
                    xcd_barrier(xb);
                    combine_phase(P, L - 2);
                }
            } else {
                post_phase(P, L);
            }
            if (!(L == 3 && half == 1)) xcd_barrier(xb);
        }
    }
}

extern "C" void kernel_launch(void* const* d_in, const int* in_sizes, int n_in, void* d_out, int out_size, void* d_ws, size_t ws_size, hipStream_t stream) {
    static int grid_blocks = 0;
    if (!grid_blocks) {
        int dev = 0, cus = 0, per_cu = 0;
        hipGetDevice(&dev);
        hipDeviceGetAttribute(&cus, hipDeviceAttributeMultiprocessorCount, dev);
        hipFuncSetAttribute((const void*)yoco_mega, hipFuncAttributeMaxDynamicSharedMemorySize, LDS_BYTES);
        if (hipOccupancyMaxActiveBlocksPerMultiprocessor(&per_cu, (const void*)yoco_mega, 512, LDS_BYTES) != hipSuccess || per_cu < 1) per_cu = 1;
        (void)hipGetLastError();
        grid_blocks = cus * per_cu;
        if (ws_size < O_END) fprintf(stderr, "kernel_launch: workspace too small: %zu < %zu\n", ws_size, (size_t)O_END);
    }
    (void)hipMemsetAsync((unsigned char*)d_ws + O_BAR, 0, XCD_BAR_WORDS * sizeof(unsigned), stream);
    Params p{};
    for (int i = 0; i < 25; ++i) p.in[i] = (const float*)d_in[i];
    p.out = (float*)d_out; p.ws = (unsigned char*)d_ws;
    void* args[] = {&p};
    hipError_t e = hipLaunchCooperativeKernel((const void*)yoco_mega, dim3(grid_blocks), dim3(512), args, LDS_BYTES, stream);
    if (e != hipSuccess) fprintf(stderr, "cooperative launch failed: %s (grid %d)\n", hipGetErrorString(e), grid_blocks);
}
```
